# Optimizing an MI355X kernel written in HIP

```python
import math
import jax
import jax.numpy as jnp
from jax import lax
import numpy as np

D_MODEL = 1024
BATCH = 4
SEQ = 8192
DEPTH = 4

CTX_LEN = 256
GRID_W = 64
EPS = 1e-6
N_BRANCH = 3
F32 = jnp.float32

SSD_HEADS = 16
SSD_HEAD_DIM = 64
SSD_INNER = SSD_HEADS * SSD_HEAD_DIM
SSD_GROUPS = 2
SSD_STATE = 128
SSD_CONV = 5
SSD_CHUNK = 128
SSD_CONV_DIM = SSD_INNER + 2 * SSD_GROUPS * SSD_STATE

RET_HEADS = 4
RET_KEY_DIM = 64
RET_VAL_DIM = 128
RET_QK = RET_HEADS * RET_KEY_DIM
RET_INNER = RET_HEADS * RET_VAL_DIM
RET_CHUNK = 128
ROPE_BASE = 10000.0

RWKV_HEADS = 8
RWKV_HEAD_DIM = 64
RWKV_INNER = RWKV_HEADS * RWKV_HEAD_DIM
RWKV_DECAY_LORA = 64
RWKV_AAA_LORA = 64
RWKV_GATE_LORA = 128
RWKV_IN = 3 * RWKV_INNER + RWKV_DECAY_LORA + RWKV_AAA_LORA + RWKV_GATE_LORA
RWKV_LN_EPS = 64e-5

D_FF = 4 * D_MODEL

IN_SIZES = (N_BRANCH * D_MODEL, SSD_INNER, SSD_CONV_DIM, 2 * SSD_HEADS, RET_QK, RET_QK, RET_INNER, RET_INNER, RWKV_IN)
D_IN = N_BRANCH * D_MODEL + SSD_INNER + SSD_CONV_DIM + 2 * SSD_HEADS + 2 * RET_QK + 2 * RET_INNER + RWKV_IN

kernel_name = 'hybrid_ssd_retention_rwkv7_prefix_dit'


def split_last(u, sizes):
    idx = np.cumsum(np.array(sizes))[:-1].tolist()
    return jnp.split(u, idx, axis=-1)


def rmsnorm(x, w):
    xf = x.astype(F32)
    y = xf * lax.rsqrt(jnp.mean(xf * xf, axis=-1, keepdims=True) + EPS)
    return (y * w.astype(F32)).astype(x.dtype)


def head_layernorm(y, eps):
    yc = y - jnp.mean(y, axis=-1, keepdims=True)
    return yc * lax.rsqrt(jnp.mean(yc * yc, axis=-1, keepdims=True) + eps)


def flip_t(z):
    return jnp.flip(z, axis=1)


def modulation(cond, lp):
    m = jax.nn.silu(cond) @ lp['ada_w'] + lp['ada_b']
    return jnp.split(m, 6, axis=-1)


def modulate(h, shift, scale):
    return h * (1.0 + scale) + shift


def grid_rope(t):
    rows = t // GRID_W
    row = jnp.repeat(jnp.arange(rows), GRID_W).astype(F32)
    col = jnp.tile(jnp.arange(GRID_W), rows).astype(F32)
    n_freq = RET_KEY_DIM // 4
    inv = jnp.power(ROPE_BASE, -jnp.arange(n_freq, dtype=F32) / n_freq)
    ang = jnp.concatenate([row[:, None] * inv, col[:, None] * inv], axis=-1)
    return jnp.cos(ang), jnp.sin(ang)


def apply_rope(u, cos, sin):
    u2 = u.reshape(u.shape[:-1] + (u.shape[-1] // 2, 2))
    x1, x2 = u2[..., 0], u2[..., 1]
    cc, ss = cos[None, :, None, :], sin[None, :, None, :]
    return jnp.stack([x1 * cc - x2 * ss, x1 * ss + x2 * cc], axis=-1).reshape(u.shape)


def centred_dwconv(u, w, bias):
    k = w.shape[0]
    pad = k // 2
    t = u.shape[1]
    up = jnp.pad(u, ((0, 0), (pad, pad), (0, 0)))
    out = up[:, 0:t] * w[0]
    for j in range(1, k):
        out = out + up[:, j:j + t] * w[j]
    return out + bias


def chunked_scan(q, k, v, log_a, s0, chunk):
    b, t, g, n = q.shape
    hg, p = v.shape[-2], v.shape[-1]
    nc = t // chunk
    q = q.reshape(b, nc, chunk, g, n)
    k = k.reshape(b, nc, chunk, g, n)
    v = v.reshape(b, nc, chunk, g, hg, p)
    a_cum = jnp.cumsum(log_a.reshape(b, nc, chunk, g, hg), axis=2)
    seg = jnp.moveaxis(a_cum, 2, -1)
    lower = jnp.tril(jnp.ones((chunk, chunk), dtype=bool))
    decay_in = jnp.exp(jnp.where(lower, seg[..., :, None] - seg[..., None, :], -jnp.inf))
    scores = jnp.einsum('bclgn,bcsgn->bcgls', q, k)
    y_diag = jnp.einsum('bcghls,bcsghp->bclghp', scores[:, :, :, None] * decay_in, v)
    a_last = a_cum[:, :, -1]
    v_end = v * jnp.exp(a_last[:, :, None] - a_cum)[..., None]
    chunk_states = jnp.einsum('bclgn,bclghp->bcghnp', k, v_end)

    def carry(s, inp):
        st, dec = inp
        return s * dec[..., None, None] + st, s

    s_final, s_prev = lax.scan(carry, s0, (jnp.moveaxis(chunk_states, 1, 0), jnp.moveaxis(jnp.exp(a_last), 1, 0)))
    y_off = jnp.einsum('bclgn,cbghnp->bclghp', q, s_prev) * jnp.exp(a_cum)[..., None]
    return (y_diag + y_off).reshape(b, t, g, hg, p), s_final


def bidir_scan(q, k, v_f, v_b, la_f, la_b, s0, chunk):
    y_f, s_f = chunked_scan(q, k, v_f, la_f, s0[0], chunk)
    y_b, s_b = chunked_scan(flip_t(q), flip_t(k), flip_t(v_b), flip_t(la_b), s0[1], chunk)
    return y_f + flip_t(y_b), s_f, s_b


def ssd_branch(z, xbc, dt_raw, lp, s0):
    b, t, _ = z.shape
    hg = SSD_HEADS // SSD_GROUPS
    xbc = jax.nn.silu(centred_dwconv(xbc, lp['ssd_conv_w'], lp['ssd_conv_b'])).astype(F32)
    xs, bm, cm = split_last(xbc, (SSD_INNER, SSD_GROUPS * SSD_STATE, SSD_GROUPS * SSD_STATE))
    xs = xs.reshape(b, t, SSD_GROUPS, hg, SSD_HEAD_DIM)
    bm = bm.reshape(b, t, SSD_GROUPS, SSD_STATE)
    cm = cm.reshape(b, t, SSD_GROUPS, SSD_STATE)
    dt = jax.nn.softplus(dt_raw.astype(F32).reshape(b, t, 2, SSD_HEADS) + lp['ssd_dt_bias'].astype(F32))
    dt = dt.reshape(b, t, 2, SSD_GROUPS, hg)
    a = -jnp.exp(lp['ssd_a_log'].astype(F32)).reshape(2, SSD_GROUPS, hg)
    dt_f, dt_b = dt[:, :, 0], dt[:, :, 1]
    y, s_f, s_b = bidir_scan(cm, bm, xs * dt_f[..., None], xs * dt_b[..., None],
                             dt_f * a[0], dt_b * a[1], s0, SSD_CHUNK)
    y = y + xs * lp['ssd_d'].astype(F32).reshape(SSD_GROUPS, hg, 1)
    y = y.reshape(b, t, SSD_INNER) * jax.nn.silu(z.astype(F32))
    yg = y.reshape(b, t, SSD_GROUPS, SSD_INNER // SSD_GROUPS)
    yg = yg * lax.rsqrt(jnp.mean(yg * yg, axis=-1, keepdims=True) + EPS)
    y = yg.reshape(b, t, SSD_INNER) * lp['ssd_norm_w'].astype(F32)
    return y.astype(z.dtype), (s_f, s_b)


def retention_branch(q, k, v, g, lp, s0, rope):
    b, t, _ = q.shape
    q = q.astype(F32).reshape(b, t, RET_HEADS, RET_KEY_DIM)
    k = k.astype(F32).reshape(b, t, RET_HEADS, RET_KEY_DIM) * (RET_KEY_DIM ** -0.5)
    if rope is not None:
        q = apply_rope(q, rope[0], rope[1])
        k = apply_rope(k, rope[0], rope[1])
    v = v.astype(F32).reshape(b, t, RET_HEADS, 1, RET_VAL_DIM)
    log_gamma = -jax.nn.softplus(-lp['ret_decay'].astype(F32))
    la_f = jnp.broadcast_to(log_gamma[0][:, None], (b, t, RET_HEADS, 1))
    la_b = jnp.broadcast_to(log_gamma[1][:, None], (b, t, RET_HEADS, 1))
    y, s_f, s_b = bidir_scan(q, k, v, v, la_f, la_b, s0, RET_CHUNK)
    y = head_layernorm(y.reshape(b, t, RET_HEADS, RET_VAL_DIM), EPS)
    y = y.reshape(b, t, RET_INNER) * jax.nn.silu(g.astype(F32))
    return y.astype(g.dtype), (s_f, s_b)


def rwkv7_scan(r, w, k, v, a, bb, s0):
    def step(s, inp):
        r_t, w_t, k_t, v_t, a_t, b_t = inp
        sa = jnp.einsum('bhvk,bhk->bhv', s, a_t)
        s = s * w_t[:, :, None, :] + sa[..., None] * b_t[:, :, None, :] + v_t[..., None] * k_t[:, :, None, :]
        return s, jnp.einsum('bhvk,bhk->bhv', s, r_t)

    xs = tuple(jnp.moveaxis(z, 1, 0) for z in (r, w, k, v, a, bb))
    s_fin, y = lax.scan(step, s0, xs)
    return jnp.moveaxis(y, 0, 1), s_fin


def rwkv_branch(u, lp, s0):
    b, t, _ = u.shape
    out_dtype = u.dtype
    u = u.astype(F32)
    prev = jnp.pad(u, ((0, 0), (1, 0), (0, 0)))[:, :-1]
    nxt = jnp.pad(u, ((0, 0), (0, 1), (0, 0)))[:, 1:]
    u = u + lp['rwkv_mix'].astype(F32) * (0.5 * (prev + nxt) - u)
    r, k, v, w_lo, a_lo, g_lo = split_last(u, (RWKV_INNER, RWKV_INNER, RWKV_INNER, RWKV_DECAY_LORA, RWKV_AAA_LORA, RWKV_GATE_LORA))

    def heads(z):
        return z.reshape(b, t, RWKV_HEADS, RWKV_HEAD_DIM)

    w0, w2 = lp['rwkv_w0'].astype(F32), lp['rwkv_w2'].astype(F32)
    a0, a2 = lp['rwkv_a0'].astype(F32), lp['rwkv_a2'].astype(F32)
    k_a = lp['rwkv_k_a'].astype(F32)
    tw = jnp.tanh(w_lo)
    a_shared = a_lo @ a2
    kk = heads(k * lp['rwkv_k_k'].astype(F32))
    kk = kk / jnp.maximum(jnp.sqrt(jnp.sum(kk * kk, axis=-1, keepdims=True)), 1e-12)

    def direction_inputs(d):
        w_log = -jax.nn.softplus(-(w0[d] + tw @ w2[d])) - 0.5
        decay = jnp.exp(-jnp.exp(w_log))
        a = jax.nn.sigmoid(a0[d] + a_shared)
        kd = k * (1.0 + (a - 1.0) * k_a)
        return heads(decay), heads(kd), kk * heads(a)

    dec_f, k_f, b_f = direction_inputs(0)
    dec_b, k_b, b_b = direction_inputs(1)
    rh, vh = heads(r), heads(v)
    y_f, s_f = rwkv7_scan(rh, dec_f, k_f, vh, -kk, b_f, s0[0])
    y_b, s_b = rwkv7_scan(flip_t(rh), flip_t(dec_b), flip_t(k_b), flip_t(vh), flip_t(-kk), flip_t(b_b), s0[1])
    y = head_layernorm(y_f + flip_t(y_b), RWKV_LN_EPS)
    y = y * lp['rwkv_lnx_w'].astype(F32).reshape(RWKV_HEADS, RWKV_HEAD_DIM) + lp['rwkv_lnx_b'].astype(F32).reshape(RWKV_HEADS, RWKV_HEAD_DIM)
    bonus = jnp.sum(rh * (k_f + k_b) * lp['rwkv_r_k'].astype(F32), axis=-1, keepdims=True) * vh
    g = jax.nn.sigmoid(g_lo) @ lp['rwkv_g2'].astype(F32)
    out = (y + bonus).reshape(b, t, RWKV_INNER) * g
    return out.astype(out_dtype), (s_f, s_b)


def zero_states(b):
    ssd = jnp.zeros((b, SSD_GROUPS, SSD_HEADS // SSD_GROUPS, SSD_STATE, SSD_HEAD_DIM), F32)
    ret = jnp.zeros((b, RET_HEADS, 1, RET_KEY_DIM, RET_VAL_DIM), F32)
    rw = jnp.zeros((b, RWKV_HEADS, RWKV_HEAD_DIM, RWKV_HEAD_DIM), F32)
    return ((ssd, ssd), (ret, ret), (rw, rw))


def token_mixer(h, lp, init_states, rope, with_output):
    b, t, _ = h.shape
    u = h @ lp['w_in']
    gate, ssd_z, ssd_xbc, ssd_dt, ret_q, ret_k, ret_v, ret_g, rwkv_u = split_last(u, IN_SIZES)
    y_ssd, st_ssd = ssd_branch(ssd_z, ssd_xbc, ssd_dt, lp, init_states[0])
    y_ret, st_ret = retention_branch(ret_q, ret_k, ret_v, ret_g, lp, init_states[1], rope)
    y_rwkv, st_rwkv = rwkv_branch(rwkv_u, lp, init_states[2])
    states = (st_ssd, st_ret, st_rwkv)
    if not with_output:
        return None, states
    gates = jax.nn.sigmoid(gate.reshape(b, t, N_BRANCH, D_MODEL))
    merged = (gates[:, :, 0] * (y_ssd @ lp['w_ssd_out'])
              + gates[:, :, 1] * (y_ret @ lp['w_ret_out'])
              + gates[:, :, 2] * (y_rwkv @ lp['w_rwkv_out']))
    return merged @ lp['w_out'], states


def squared_relu_mlp(h, lp):
    return jnp.square(jax.nn.relu(h @ lp['mlp_w1'])) @ lp['mlp_w2']


def setup_inputs(seed: int = 0) -> dict:
    key = jax.random.key(seed)
    ks = jax.random.split(key, 32)
    L = DEPTH

    def nrm(i, shape, scale):
        return scale * jax.random.normal(ks[i], shape, F32)

    x = nrm(0, (BATCH, SEQ, D_MODEL), 1.0)
    c = nrm(1, (BATCH, D_MODEL), 1.0)
    ctx = nrm(2, (BATCH, CTX_LEN, D_MODEL), 1.0)
    c_ctx = nrm(3, (D_MODEL,), 1.0)
    norm_w = 1.0 + nrm(4, (L, 4, D_MODEL), 0.05)
    ada_w = nrm(5, (L, D_MODEL, 6 * D_MODEL), 0.5 * D_MODEL ** -0.5)
    ada_b = nrm(6, (L, 6 * D_MODEL), 0.02)
    w_in = nrm(7, (L, D_MODEL, D_IN), D_MODEL ** -0.5)
    ssd_conv_w = nrm(8, (L, SSD_CONV, SSD_CONV_DIM), SSD_CONV ** -0.5)
    ssd_conv_b = nrm(9, (L, SSD_CONV_DIM), 0.02)
    dt0 = jnp.exp(jax.random.uniform(ks[10], (L, 2, SSD_HEADS), F32, math.log(1e-3), math.log(1e-1)))
    ssd_dt_bias = dt0 + jnp.log(-jnp.expm1(-dt0))
    ssd_a_log = jnp.log(jax.random.uniform(ks[11], (L, 2, SSD_HEADS), F32, 1.0, 16.0))
    ssd_d = 1.0 + nrm(12, (L, SSD_HEADS), 0.1)
    ssd_norm_w = 1.0 + nrm(13, (L, SSD_INNER), 0.05)
    gamma = 1.0 - jnp.power(2.0, -5.0 - jnp.arange(RET_HEADS, dtype=F32))
    ret_decay = jnp.log(gamma / (1.0 - gamma)) + nrm(14, (L, 2, RET_HEADS), 0.1)
    rwkv_mix = jax.random.uniform(ks[15], (L, RWKV_IN), F32)
    rwkv_w0 = jnp.linspace(-6.0, -1.0, RWKV_INNER, dtype=F32) + nrm(16, (L, 2, RWKV_INNER), 0.1)
    rwkv_w2 = nrm(17, (L, 2, RWKV_DECAY_LORA, RWKV_INNER), 0.5 * RWKV_DECAY_LORA ** -0.5)
    rwkv_a0 = nrm(18, (L, 2, RWKV_INNER), 0.1)
    rwkv_a2 = nrm(19, (L, RWKV_AAA_LORA, RWKV_INNER), 0.5 * RWKV_AAA_LORA ** -0.5)
    rwkv_g2 = nrm(20, (L, RWKV_GATE_LORA, RWKV_INNER), RWKV_GATE_LORA ** -0.5)
    rwkv_k_k = 0.85 + nrm(21, (L, RWKV_INNER), 0.05)
    rwkv_k_a = 1.0 + nrm(22, (L, RWKV_INNER), 0.05)
    rwkv_r_k = nrm(23, (L, RWKV_HEADS, RWKV_HEAD_DIM), 0.1)
    rwkv_lnx_w = 1.0 + nrm(24, (L, RWKV_INNER), 0.05)
    rwkv_lnx_b = nrm(25, (L, RWKV_INNER), 0.02)
    w_ssd_out = nrm(26, (L, SSD_INNER, D_MODEL), SSD_INNER ** -0.5)
    w_ret_out = nrm(27, (L, RET_INNER, D_MODEL), RET_INNER ** -0.5)
    w_rwkv_out = nrm(28, (L, RWKV_INNER, D_MODEL), RWKV_INNER ** -0.5)
    w_out = nrm(29, (L, D_MODEL, D_MODEL), D_MODEL ** -0.5)
    mlp_w1 = nrm(30, (L, D_MODEL, D_FF), D_MODEL ** -0.5)
    mlp_w2 = nrm(31, (L, D_FF, D_MODEL), D_FF ** -0.5)
    return {'x': x, 'c': c, 'ctx': ctx, 'c_ctx': c_ctx, 'norm_w': norm_w, 'ada_w': ada_w, 'ada_b': ada_b,
            'w_in': w_in, 'ssd_conv_w': ssd_conv_w, 'ssd_conv_b': ssd_conv_b, 'ssd_dt_bias': ssd_dt_bias,
            'ssd_a_log': ssd_a_log, 'ssd_d': ssd_d, 'ssd_norm_w': ssd_norm_w, 'ret_decay': ret_decay,
            'rwkv_mix': rwkv_mix, 'rwkv_w0': rwkv_w0, 'rwkv_w2': rwkv_w2, 'rwkv_a0': rwkv_a0, 'rwkv_a2': rwkv_a2,
            'rwkv_g2': rwkv_g2, 'rwkv_k_k': rwkv_k_k, 'rwkv_k_a': rwkv_k_a, 'rwkv_r_k': rwkv_r_k,
            'rwkv_lnx_w': rwkv_lnx_w, 'rwkv_lnx_b': rwkv_lnx_b, 'w_ssd_out': w_ssd_out, 'w_ret_out': w_ret_out,
            'w_rwkv_out': w_rwkv_out, 'w_out': w_out, 'mlp_w1': mlp_w1, 'mlp_w2': mlp_w2}


def reference(x, c, ctx, c_ctx, norm_w, ada_w, ada_b, w_in, ssd_conv_w, ssd_conv_b, ssd_dt_bias, ssd_a_log,
              ssd_d, ssd_norm_w, ret_decay, rwkv_mix, rwkv_w0, rwkv_w2, rwkv_a0, rwkv_a2, rwkv_g2, rwkv_k_k,
              rwkv_k_a, rwkv_r_k, rwkv_lnx_w, rwkv_lnx_b, w_ssd_out, w_ret_out, w_rwkv_out, w_out, mlp_w1, mlp_w2):
    layer_params = {'norm_w': norm_w, 'ada_w': ada_w, 'ada_b': ada_b, 'w_in': w_in,
                    'ssd_conv_w': ssd_conv_w, 'ssd_conv_b': ssd_conv_b, 'ssd_dt_bias': ssd_dt_bias,
                    'ssd_a_log': ssd_a_log, 'ssd_d': ssd_d, 'ssd_norm_w': ssd_norm_w, 'ret_decay': ret_decay,
                    'rwkv_mix': rwkv_mix, 'rwkv_w0': rwkv_w0, 'rwkv_w2': rwkv_w2, 'rwkv_a0': rwkv_a0,
                    'rwkv_a2': rwkv_a2, 'rwkv_g2': rwkv_g2, 'rwkv_k_k': rwkv_k_k, 'rwkv_k_a': rwkv_k_a,
                    'rwkv_r_k': rwkv_r_k, 'rwkv_lnx_w': rwkv_lnx_w, 'rwkv_lnx_b': rwkv_lnx_b,
                    'w_ssd_out': w_ssd_out, 'w_ret_out': w_ret_out, 'w_rwkv_out': w_rwkv_out, 'w_out': w_out,
                    'mlp_w1': mlp_w1, 'mlp_w2': mlp_w2}
    b = x.shape[0]
    rope = grid_rope(x.shape[1])
    c_lat = c[:, None, :]
    c_con = c_ctx[None, None, :]
    for l in range(DEPTH):
        lp = {name: arr[l] for name, arr in layer_params.items()}
        last = l == DEPTH - 1
        nw = lp['norm_w']
        sh1_x, sc1_x, g1_x, sh2_x, sc2_x, g2_x = modulation(c_lat, lp)
        sh1_c, sc1_c, g1_c, sh2_c, sc2_c, g2_c = modulation(c_con, lp)
        hc = modulate(rmsnorm(ctx, nw[0]), sh1_c, sc1_c)
        yc, ctx_states = token_mixer(hc, lp, zero_states(b), None, not last)
        hx = modulate(rmsnorm(x, nw[0]), sh1_x, sc1_x)
        yx, _ = token_mixer(hx, lp, ctx_states, rope, True)
        x = x + g1_x * rmsnorm(yx, nw[1])
        x = x + g2_x * rmsnorm(squared_relu_mlp(modulate(rmsnorm(x, nw[2]), sh2_x, sc2_x), lp), nw[3])
        if not last:
            ctx = ctx + g1_c * rmsnorm(yc, nw[1])
            ctx = ctx + g2_c * rmsnorm(squared_relu_mlp(modulate(rmsnorm(ctx, nw[2]), sh2_c, sc2_c), lp), nw[3])
    return x
```

```cpp
#include <hip/hip_runtime.h>
#include <hip/hip_cooperative_groups.h>
#include <cstdint>
#include <cstdio>
namespace cg = cooperative_groups;

typedef unsigned short bf16_t;
typedef short bf16x8 __attribute__((ext_vector_type(8)));
typedef float f32x4 __attribute__((ext_vector_type(4)));
typedef unsigned u32x2 __attribute__((ext_vector_type(2)));
typedef unsigned u32x4 __attribute__((ext_vector_type(4)));

constexpr int RL = 32768;
constexpr int RC = 1024;
constexpr int R = RL + RC;
constexpr int LDS_BYTES = 153600;
constexpr int NPH = 2 + 11 * 4;
#ifndef PROBE_SCAN
#define PROBE_SCAN 0
#endif
#ifndef PROBE_GEMM
#define PROBE_GEMM 0
#endif

constexpr size_t OFF_MOD = 0;
constexpr size_t OFF_BAR = 491776;
constexpr size_t OFF_CTXS = 524288;
constexpr size_t OFF_DT = OFF_CTXS + 4194304;
constexpr size_t OFF_W = OFF_DT + (size_t)R * 32 * 4;
constexpr size_t OFF_H = OFF_W + 16777216;
constexpr size_t SZ1024 = (size_t)R * 1024 * 2;
constexpr size_t OFF_Z = OFF_H + SZ1024;
constexpr size_t OFF_XBC = OFF_Z + SZ1024;
constexpr size_t OFF_QKV = OFF_XBC + (size_t)R * 1536 * 2;
constexpr size_t OFF_G = OFF_QKV + SZ1024;
constexpr size_t OFF_RW = OFF_G + (size_t)R * 512 * 2;
constexpr size_t OFF_PRET = OFF_RW + (size_t)R * 1792 * 2;
constexpr size_t OFF_PRW = OFF_PRET + (size_t)R * 512 * 2;
constexpr size_t WS_END = OFF_PRW + (size_t)R * 512 * 2;
constexpr size_t W_G = 0, W_SO = 6291456, W_RO = 8388608, W_WO = 9437184, W_O = 10485760;
constexpr size_t W_1 = 0, W_2 = 8388608;
constexpr size_t MSCR_S = 0, MSCR_M = (size_t)256 * 131072;

struct Params {
    const float* in[32];
    float* out;
    unsigned char* ws;
    int ph_lo, ph_hi, coop, pad;
};

typedef const __attribute__((address_space(4))) Params CParams;

__device__ __forceinline__ float bf2f(bf16_t h) { return __uint_as_float(((unsigned)h) << 16); }
__device__ __forceinline__ float bflo(unsigned u) { return __uint_as_float(u << 16); }
__device__ __forceinline__ float bfhi(unsigned u) { return __uint_as_float(u & 0xffff0000u); }
typedef float f32x2_t __attribute__((ext_vector_type(2)));
typedef __bf16 bf16x2_t __attribute__((ext_vector_type(2)));
__device__ __forceinline__ unsigned pk2(float a, float b) { const f32x2_t v = {a, b}; const bf16x2_t r = __builtin_convertvector(v, bf16x2_t); return __builtin_bit_cast(unsigned, r); }
__device__ __forceinline__ bf16_t f2bf(float f) { const __bf16 r = (__bf16)f; return __builtin_bit_cast(unsigned short, r); }
template <int CTRL> __device__ __forceinline__ float dppf(float v) {
    return __builtin_bit_cast(float, __builtin_amdgcn_update_dpp(0, __builtin_bit_cast(int, v), CTRL, 0xf, 0xf, true));
}
__device__ __forceinline__ float red4(float v) { v += dppf<0xB1>(v); v += dppf<0x4E>(v); return v; }
__device__ __forceinline__ float red8(float v) { v = red4(v); v += dppf<0x141>(v); return v; }
__device__ __forceinline__ float red16(float v) { v = red8(v); v += dppf<0x140>(v); return v; }
__device__ __forceinline__ float wave_sum(float v) { v = red16(v); v += __shfl_xor(v, 16); v += __shfl_xor(v, 32); return v; }
__device__ __forceinline__ int opaque_tid() { int t = threadIdx.x; asm volatile("" : "+v"(t)); return t; }
__device__ __forceinline__ float sigmoidf_(float x) { return __builtin_amdgcn_rcpf(1.f + __expf(-x)); }
__device__ __forceinline__ float siluf_(float x) { return x * __builtin_amdgcn_rcpf(1.f + __expf(-x)); }
__device__ __forceinline__ float fast_tanh(float x) { return 1.f - 2.f * __builtin_amdgcn_rcpf(1.f + __expf(2.f * x)); }
__device__ __forceinline__ float fast_softplus(float x) { return x > 20.f ? x : __logf(1.f + __expf(x)); }
__device__ __forceinline__ float softplusf_(float x) { return x > 20.f ? x : log1pf(__expf(x)); }

constexpr int BK = 64, HALF = 128, HT = HALF * BK;
__device__ __forceinline__ int lds_byte(int r, int c) {
    int st = (r >> 4) * 2 + (c >> 5), rr = r & 15, cc = c & 31, ob = rr * 64 + cc * 2;
    return st * 1024 + (ob ^ (((ob >> 9) & 1) << 5));
}
__device__ __forceinline__ void stage_rc(int b, int& Rr, int& Cc) {
    int st = b / 1024, sb = b % 1024, swz = sb ^ (((sb >> 9) & 1) << 5);
    Rr = (st >> 1) * 16 + swz / 64; Cc = (st & 1) * 32 + (swz % 64) / 2;
}

#define LAS __attribute__((address_space(3)))
constexpr int HTB = HALF * BK * 2;

__device__ __forceinline__ bool tile_next(int i, int G, int c, int nM, int nN, int& pm, int& pn) {
    const int nwg = nM * nN;
    const long L = (long)i * G + c; if (L >= nwg) return false;
    int wgid = (int)L; { const int q = nwg / 8, r = nwg % 8, xcd = wgid % 8, off = wgid / 8; wgid = (xcd < r ? xcd * (q + 1) : r * (q + 1) + (xcd - r) * q) + off; }
    const int nig = 8 * nN, gid = wgid / nig, fm = gid * 8, gsz = (nM - fm) < 8 ? (nM - fm) : 8;
    pm = fm + ((wgid % nig) % gsz); pn = (wgid % nig) / gsz; return true;
}

enum { GM_IN = 0, GM_MERGE = 1, GM_OUT = 2, GM_MLP1 = 3, GM_MLP2 = 4 };
struct UnitInfo { const char* A; const char* B; int K, wt, mt, step; };

__device__ __forceinline__ bool get_unit(unsigned char* ws, int mode, int n_mt, int n_wt, int nsteps, int ui, UnitInfo& u) {
    const int it = ui / nsteps, step = ui - it * nsteps;
    int mt, wt;
    if (!tile_next(it, gridDim.x, blockIdx.x, n_mt, n_wt, mt, wt)) return false;
    const size_t tok0 = (size_t)mt * 256;
    const bf16_t* Aw; const bf16_t* Bact; int K = 1024;
    if (mode == GM_IN) { Aw = (const bf16_t*)(ws + OFF_W) + (size_t)wt * 256 * 1024; Bact = (const bf16_t*)(ws + OFF_H) + tok0 * 1024; }
    else if (mode == GM_OUT) { Aw = (const bf16_t*)(ws + OFF_W + W_O) + (size_t)wt * 256 * 1024; Bact = (const bf16_t*)(ws + OFF_QKV) + tok0 * 1024; }
    else if (mode == GM_MLP1) { Aw = (const bf16_t*)(ws + OFF_W + W_1) + (size_t)wt * 256 * 1024; Bact = (const bf16_t*)(ws + OFF_H) + tok0 * 1024; }
    else if (mode == GM_MLP2) { K = 4096; Aw = (const bf16_t*)(ws + OFF_W + W_2) + (size_t)wt * 256 * 4096; Bact = (const bf16_t*)(ws + OFF_Z) + tok0 * 4096; }
    else {
        const int k = step >> 1;
        if ((step & 1) == 0) { Aw = (const bf16_t*)(ws + OFF_W + W_G) + ((size_t)k * 1024 + (size_t)wt * 256) * 1024; Bact = (const bf16_t*)(ws + OFF_XBC) + tok0 * 1024; }
        else if (k == 0) { Aw = (const bf16_t*)(ws + OFF_W + W_SO) + (size_t)wt * 256 * 1024; Bact = (const bf16_t*)(ws + OFF_Z) + tok0 * 1024; }
        else if (k == 1) { K = 512; Aw = (const bf16_t*)(ws + OFF_W + W_RO) + (size_t)wt * 256 * 512; Bact = (const bf16_t*)(ws + OFF_G) + tok0 * 512; }
        else { K = 512; Aw = (const bf16_t*)(ws + OFF_W + W_WO) + (size_t)wt * 256 * 512; Bact = (const bf16_t*)(ws + OFF_PRW) + tok0 * 512; }
    }
    u.A = (const char*)Bact; u.B = (const char*)Aw; u.K = K; u.wt = wt; u.mt = mt; u.step = step;
    return true;
}

__device__ __forceinline__ void gemm_epilogue(unsigned char* ws, int mode, const UnitInfo& u, const f32x4 (&acc)[2][2][4][2], int wr, int wc, int fr, int fq, int tidx) {
    const size_t tok0 = (size_t)u.mt * 256; const int wt = u.wt, step = u.step;
    if (mode == GM_MERGE) {
        u32x2* sp = (u32x2*)(ws + OFF_RW + MSCR_S) + (size_t)blockIdx.x * 32 * 512 + tidx;
        f32x4* mp = (f32x4*)(ws + OFF_RW + MSCR_M) + (size_t)blockIdx.x * 32 * 512 + tidx;
        bf16_t* MG = (bf16_t*)(ws + OFF_QKV);
#pragma unroll
        for (int ai = 0; ai < 2; ++ai)
#pragma unroll
            for (int bj = 0; bj < 2; ++bj)
#pragma unroll
                for (int m = 0; m < 4; ++m)
#pragma unroll
                    for (int n = 0; n < 2; ++n) {
                        const f32x4 v = acc[ai][bj][m][n];
                        if ((step & 1) == 0) {
                            u32x2 o; o.x = pk2(sigmoidf_(v.x), sigmoidf_(v.y)); o.y = pk2(sigmoidf_(v.z), sigmoidf_(v.w));
                            *sp = o;
                        } else {
                            const u32x2 s = *sp;
                            f32x4 mm = (f32x4){bflo(s.x) * v.x, bfhi(s.x) * v.y, bflo(s.y) * v.z, bfhi(s.y) * v.w};
                            if (step > 1) mm += *mp;
                            if (step < 5) *mp = mm;
                            else {
                                const size_t tok = tok0 + ai * 128 + wr * 64 + m * 16 + fr;
                                const int feat = wt * 256 + bj * 128 + wc * 32 + fq * 8 + n * 4;
                                u32x2 o; o.x = pk2(mm.x, mm.y); o.y = pk2(mm.z, mm.w);
                                *(u32x2*)(MG + tok * 1024 + feat) = o;
                            }
                        }
                        sp += 512; mp += 512;
                        asm volatile("" : "+v"(sp), "+v"(mp) :: "memory");
                    }
    } else if (mode == GM_IN && wt == 23) {
        float* DT = (float*)(ws + OFF_DT);
        if (wc == 0) {
#pragma unroll
            for (int ai = 0; ai < 2; ++ai)
#pragma unroll
                for (int m = 0; m < 4; ++m)
#pragma unroll
                    for (int n = 0; n < 2; ++n) {
                        const size_t tok = tok0 + ai * 128 + wr * 64 + m * 16 + fr;
                        *(f32x4*)(DT + tok * 32 + fq * 8 + n * 4) = acc[ai][0][m][n];
                    }
        }
    } else {
        bf16_t* base; int ld, col0;
        if (mode == GM_IN) {
            if (wt < 4) { base = (bf16_t*)(ws + OFF_Z); ld = 1024; col0 = wt * 256; }
            else if (wt < 10) { base = (bf16_t*)(ws + OFF_XBC); ld = 1536; col0 = (wt - 4) * 256; }
            else if (wt < 14) { base = (bf16_t*)(ws + OFF_QKV); ld = 1024; col0 = (wt - 10) * 256; }
            else if (wt < 16) { base = (bf16_t*)(ws + OFF_G); ld = 512; col0 = (wt - 14) * 256; }
            else { base = (bf16_t*)(ws + OFF_RW); ld = 1792; col0 = (wt - 16) * 256; }
        } else if (mode == GM_MLP1) { base = (bf16_t*)(ws + OFF_Z); ld = 4096; col0 = wt * 256; }
        else { base = (bf16_t*)(ws + OFF_H); ld = 1024; col0 = wt * 256; }
        const bool relu2 = (mode == GM_MLP1);
#pragma unroll
        for (int ai = 0; ai < 2; ++ai)
#pragma unroll
            for (int m = 0; m < 4; ++m) {
                const size_t tok = tok0 + ai * 128 + wr * 64 + m * 16 + fr;
                bf16_t* rowp = base + tok * ld + col0 + wc * 32 + fq * 8;
#pragma unroll
                for (int bj = 0; bj < 2; ++bj) {
                    f32x4 v = acc[ai][bj][m][0], w = acc[ai][bj][m][1];
                    if (relu2) { v.x = v.x > 0.f ? v.x * v.x : 0.f; v.y = v.y > 0.f ? v.y * v.y : 0.f; v.z = v.z > 0.f ? v.z * v.z : 0.f; v.w = v.w > 0.f ? v.w * v.w : 0.f;
                                 w.x = w.x > 0.f ? w.x * w.x : 0.f; w.y = w.y > 0.f ? w.y * w.y : 0.f; w.z = w.z > 0.f ? w.z * w.z : 0.f; w.w = w.w > 0.f ? w.w * w.w : 0.f; }
                    u32x4 o; o.x = pk2(v.x, v.y); o.y = pk2(v.z, v.w); o.z = pk2(w.x, w.y); o.w = pk2(w.z, w.w);
                    *(u32x4*)(rowp + bj * 128) = o;
                }
            }
    }
}

__device__ __forceinline__ void gemm_phase(CParams& p_in, const int mode, const int n_mt, LAS unsigned char* lds) {
    CParams* pq_ = &p_in; asm volatile("" : "+s"(pq_)); CParams& p = *pq_;
    const int tid = opaque_tid(), wid = __builtin_amdgcn_readfirstlane(tid >> 6), lane = tid & 63, wr = wid >> 2, wc = wid & 3, fr = lane & 15, fq = lane >> 4;
    unsigned char* ws = p.ws;
    int n_wt, nsteps = 1;
    if (mode == GM_IN) n_wt = 24; else if (mode == GM_MLP1) n_wt = 16; else n_wt = 4;
    if (mode == GM_MERGE) nsteps = 6;
    unsigned vR[2], vC[2];
#pragma unroll
    for (int i = 0; i < 2; ++i) { int Rr, Cc; stage_rc(tid * 16 + i * 8192, Rr, Cc); vR[i] = (unsigned)Rr * 2u; vC[i] = (unsigned)Cc * 2u; }
    const size_t kstep = (size_t)(BK * 2);
    const unsigned ldsw = (unsigned)wid * 1024u;
    const int aoff = lds_byte(wr * 64 + fr, fq * 8), boff = lds_byte(wc * 32 + fr, fq * 8);
#define PG8_SA(b, h) (((b) * 2 + (h)) * HTB)
#define PG8_SB(b, h) ((4 + (b) * 2 + (h)) * HTB)
#define PG8_STAGE(bufoff, gbase, v0, v1) do { \
        __builtin_amdgcn_global_load_lds((const unsigned*)((const char*)(gbase) + (v0)), (LAS unsigned*)(lds + (bufoff) + ldsw), 16, 0, 0); \
        __builtin_amdgcn_global_load_lds((const unsigned*)((const char*)(gbase) + (v1)), (LAS unsigned*)(lds + (bufoff) + ldsw + 8192), 16, 0, 0); } while (0)
#define PG8_LDA(dst, b, h) do { _Pragma("unroll") for (int m = 0; m < 4; ++m) _Pragma("unroll") for (int k = 0; k < 2; ++k) dst[m][k] = *(const LAS bf16x8*)(lds + PG8_SA(b, h) + aoff + m * 2048 + k * 1024); } while (0)
#define PG8_LDB(dst, b, h) do { _Pragma("unroll") for (int n = 0; n < 2; ++n) _Pragma("unroll") for (int k = 0; k < 2; ++k) dst[n][k] = *(const LAS bf16x8*)(lds + PG8_SB(b, h) + boff + n * 2048 + k * 1024); } while (0)
#define PG8_MMA(ai, bj, At, Bt) do { __builtin_amdgcn_s_setprio(1); _Pragma("unroll") for (int m = 0; m < 4; ++m) _Pragma("unroll") for (int n = 0; n < 2; ++n) _Pragma("unroll") for (int k = 0; k < 2; ++k) \
        acc[ai][bj][m][n] = __builtin_amdgcn_mfma_f32_16x16x32_bf16(Bt[n][k], At[m][k], acc[ai][bj][m][n], 0, 0, 0); __builtin_amdgcn_s_setprio(0); } while (0)
#define PG8_WAIT_V(n) asm volatile("s_waitcnt vmcnt(" #n ")" ::: "memory")
#define PG8_WAIT_L(n) asm volatile("s_waitcnt lgkmcnt(" #n ")" ::: "memory")
#define PG8_BAR __builtin_amdgcn_s_barrier()
#define PG8_SCHED __builtin_amdgcn_sched_barrier(0)
    UnitInfo cur, nxt; int ui = 0;
    if (!get_unit(ws, mode, n_mt, n_wt, nsteps, 0, cur)) return;
    f32x4 acc[2][2][4][2];
#pragma unroll
    for (int a = 0; a < 2; ++a)
#pragma unroll
        for (int b = 0; b < 2; ++b)
#pragma unroll
            for (int m = 0; m < 4; ++m)
#pragma unroll
                for (int n = 0; n < 2; ++n) acc[a][b][m][n] = (f32x4){0.f, 0.f, 0.f, 0.f};
    bf16x8 At[4][2], B0[2][2], B1[2][2];
    const char* cA = cur.A; const char* cB = cur.B;
    unsigned vc0 = vR[0] * (unsigned)cur.K + vC[0], vc1 = vR[1] * (unsigned)cur.K + vC[1];
    size_t hstep = (size_t)HALF * cur.K * 2;
    PG8_STAGE(PG8_SB(0, 0), cB, vc0, vc1); PG8_STAGE(PG8_SA(0, 0), cA, vc0, vc1); PG8_STAGE(PG8_SB(0, 1), cB + hstep, vc0, vc1); PG8_STAGE(PG8_SA(0, 1), cA + hstep, vc0, vc1);
    if (wr == 1) PG8_BAR;
    PG8_WAIT_V(4); PG8_BAR;
    PG8_STAGE(PG8_SB(1, 0), cB + kstep, vc0, vc1); PG8_STAGE(PG8_SA(1, 0), cA + kstep, vc0, vc1); PG8_STAGE(PG8_SB(1, 1), cB + hstep + kstep, vc0, vc1);
    PG8_WAIT_V(6); PG8_BAR;
    for (;;) {
        const bool has_next = get_unit(ws, mode, n_mt, n_wt, nsteps, ui + 1, nxt);
        const char* nA = has_next ? nxt.A : cA; const char* nB = has_next ? nxt.B : cB;
        const int Kn = has_next ? nxt.K : cur.K;
        const unsigned vn0 = vR[0] * (unsigned)Kn + vC[0], vn1 = vR[1] * (unsigned)Kn + vC[1];
        const size_t hstepn = (size_t)HALF * Kn * 2;
        const int nt = cur.K / BK;
        for (int t = 0; t < nt; t += 2) {
            const bool last = (t == nt - 2);
            const char* a1 = cA + (size_t)(t + 1) * kstep;
            const char* a2 = last ? nA : cA + (size_t)(t + 2) * kstep; const char* b2 = last ? nB : cB + (size_t)(t + 2) * kstep;
            const char* a3 = a2 + kstep; const char* b3 = b2 + kstep;
            const unsigned w0 = last ? vn0 : vc0, w1 = last ? vn1 : vc1;
            const size_t hs2 = last ? hstepn : hstep;
            PG8_LDB(B0, 0, 0); PG8_SCHED; PG8_LDA(At, 0, 0); PG8_STAGE(PG8_SA(1, 1), a1 + hstep, vc0, vc1);
            PG8_WAIT_L(8); PG8_BAR; PG8_WAIT_L(0); PG8_MMA(0, 0, At, B0); PG8_BAR; PG8_SCHED;
            PG8_LDB(B1, 0, 1); PG8_STAGE(PG8_SB(0, 0), b2, w0, w1);
            PG8_BAR; PG8_WAIT_L(0); PG8_MMA(0, 1, At, B1); PG8_BAR;
            PG8_LDA(At, 0, 1); PG8_STAGE(PG8_SA(0, 0), a2, w0, w1);
            PG8_BAR; PG8_WAIT_L(0); PG8_MMA(1, 0, At, B0); PG8_BAR; PG8_SCHED;
            PG8_STAGE(PG8_SB(0, 1), b2 + hs2, w0, w1);
            PG8_WAIT_V(6); PG8_BAR; PG8_MMA(1, 1, At, B1); PG8_BAR;
            PG8_LDB(B0, 1, 0); PG8_SCHED; PG8_LDA(At, 1, 0); PG8_STAGE(PG8_SA(0, 1), a2 + hs2, w0, w1);
            PG8_WAIT_L(8); PG8_BAR; PG8_WAIT_L(0); PG8_MMA(0, 0, At, B0); PG8_BAR; PG8_SCHED;
            PG8_LDB(B1, 1, 1); PG8_STAGE(PG8_SB(1, 0), b3, w0, w1);
            PG8_BAR; PG8_WAIT_L(0); PG8_MMA(0, 1, At, B1); PG8_BAR;
            PG8_LDA(At, 1, 1); PG8_STAGE(PG8_SA(1, 0), a3, w0, w1);
            PG8_BAR; PG8_WAIT_L(0); PG8_MMA(1, 0, At, B0); PG8_BAR; PG8_SCHED;
            PG8_STAGE(PG8_SB(1, 1), b3 + hs2, w0, w1);
            PG8_WAIT_V(6); PG8_BAR; PG8_MMA(1, 1, At, B1); PG8_BAR;
        }
        gemm_epilogue(ws, mode, cur, acc, wr, wc, fr, fq, tid);
        if (!has_next) break;
#pragma unroll
        for (int a = 0; a < 2; ++a)
#pragma unroll
            for (int b = 0; b < 2; ++b)
#pragma unroll
                for (int m = 0; m < 4; ++m)
#pragma unroll
                    for (int n = 0; n < 2; ++n) acc[a][b][m][n] = (f32x4){0.f, 0.f, 0.f, 0.f};
        cur = nxt; cA = nA; cB = nB; vc0 = vn0; vc1 = vn1; hstep = hstepn; ++ui;
    }
    PG8_WAIT_V(0);
    if (wr == 0) PG8_BAR;
    PG8_BAR;
}

__device__ __forceinline__ void phase_mod(CParams& p_in, unsigned char* smem) {
    CParams* pq_ = &p_in; asm volatile("" : "+s"(pq_)); CParams& p = *pq_;
    const int tidx = opaque_tid();
    float* sc = (float*)smem;
    float* red = sc + 5 * 1024;
    for (int i = tidx; i < 5 * 1024; i += 512) { int r = i >> 10, k = i & 1023; float v = r < 4 ? p.in[1][r * 1024 + k] : p.in[3][k]; sc[i] = siluf_(v); }
    __syncthreads();
    float* MOD = (float*)(p.ws + OFF_MOD);
    const int col = tidx & 63, kp = tidx >> 6;
    for (int item = blockIdx.x; item < 4 * 96; item += gridDim.x) {
        const int l = item / 96, n0 = (item % 96) * 64;
        const float* W = p.in[5] + (size_t)l * 1024 * 6144 + n0 + col;
        float a0 = 0.f, a1 = 0.f, a2 = 0.f, a3 = 0.f, a4 = 0.f;
        for (int k0 = kp * 128; k0 < kp * 128 + 128; k0 += 16) {
            float w[16];
#pragma unroll
            for (int j = 0; j < 16; ++j) w[j] = W[(size_t)(k0 + j) * 6144];
#pragma unroll
            for (int j = 0; j < 16; ++j) { const int k = k0 + j; a0 += sc[k] * w[j]; a1 += sc[1024 + k] * w[j]; a2 += sc[2048 + k] * w[j]; a3 += sc[3072 + k] * w[j]; a4 += sc[4096 + k] * w[j]; }
        }
        red[(kp * 5 + 0) * 64 + col] = a0; red[(kp * 5 + 1) * 64 + col] = a1; red[(kp * 5 + 2) * 64 + col] = a2;
        red[(kp * 5 + 3) * 64 + col] = a3; red[(kp * 5 + 4) * 64 + col] = a4;
        __syncthreads();
        if (tidx < 320) {
            const int r = tidx >> 6; float s = 0.f;
            for (int q = 0; q < 8; ++q) s += red[(q * 5 + r) * 64 + col];
            MOD[(size_t)(l * 5 + r) * 6144 + n0 + col] = s + p.in[6][l * 6144 + n0 + col];
        }
        __syncthreads();
    }
}

__device__ __forceinline__ void cvt_job(const float* W, int ldw, int col0, int ncols, int K, bf16_t* WT, int row0, unsigned char* smem, int cb, int cn) {
    const int tidx = opaque_tid();
    const int wave = tidx >> 6, lane = tidx & 63;
    float* scr = (float*)smem + wave * (64 * 33);
    const int nblk = ncols / 32, nitems = (K / 64) * nblk;
    for (int base = cb * 8; base < nitems; base += cn * 8) {
        const int it = base + wave; const bool valid = it < nitems;
        const int kb = valid ? it / nblk : 0, nb = valid ? it % nblk : 0, k0 = kb * 64, n0 = nb * 32;
        if (valid) {
#pragma unroll 8
            for (int i = 0; i < 32; ++i) { const int kk = 2 * i + (lane >> 5); scr[kk * 33 + (lane & 31)] = W[(size_t)(k0 + kk) * ldw + col0 + n0 + (lane & 31)]; }
        }
        __syncthreads();
        if (valid) {
            const int c = lane & 7;
#pragma unroll
            for (int j = 0; j < 4; ++j) {
                const int n = (lane >> 3) + 8 * j; const float* s = scr + (8 * c) * 33 + n;
                u32x4 o; o.x = pk2(s[0], s[33]); o.y = pk2(s[66], s[99]); o.z = pk2(s[132], s[165]); o.w = pk2(s[198], s[231]);
                const int rho = ((n >> 2) & 1) * 16 + (n >> 3) * 4 + (n & 3);
                *(u32x4*)(WT + (size_t)(row0 + n0 + rho) * K + k0 + 8 * c) = o;
            }
        }
        __syncthreads();
    }
}
__device__ __forceinline__ void cvt_win(CParams& p_in, int l_in, unsigned char* smem, int cb, int cn) {
    CParams* pq_ = &p_in; asm volatile("" : "+s"(pq_)); CParams& p = *pq_;
    int l = l_in; asm volatile("" : "+s"(l));
    const float* W = p.in[7] + (size_t)l * 1024 * 8992; bf16_t* WB = (bf16_t*)(p.ws + OFF_W);
    cvt_job(W, 8992, 3072, 2560, 1024, WB, 0, smem, cb, cn);
    cvt_job(W, 8992, 5664, 3328, 1024, WB, 2560, smem, cb, cn);
    cvt_job(W, 8992, 5632, 256, 1024, WB, 5888, smem, cb, cn);
}
__device__ __forceinline__ void cvt_mix(CParams& p_in, int l_in, unsigned char* smem, int cb, int cn) {
    CParams* pq_ = &p_in; asm volatile("" : "+s"(pq_)); CParams& p = *pq_;
    int l = l_in; asm volatile("" : "+s"(l));
    cvt_job(p.in[7] + (size_t)l * 1024 * 8992, 8992, 0, 3072, 1024, (bf16_t*)(p.ws + OFF_W + W_G), 0, smem, cb, cn);
    cvt_job(p.in[26] + (size_t)l * 1024 * 1024, 1024, 0, 1024, 1024, (bf16_t*)(p.ws + OFF_W + W_SO), 0, smem, cb, cn);
    cvt_job(p.in[27] + (size_t)l * 512 * 1024, 1024, 0, 1024, 512, (bf16_t*)(p.ws + OFF_W + W_RO), 0, smem, cb, cn);
    cvt_job(p.in[28] + (size_t)l * 512 * 1024, 1024, 0, 1024, 512, (bf16_t*)(p.ws + OFF_W + W_WO), 0, smem, cb, cn);
    cvt_job(p.in[29] + (size_t)l * 1024 * 1024, 1024, 0, 1024, 1024, (bf16_t*)(p.ws + OFF_W + W_O), 0, smem, cb, cn);
}
__device__ __forceinline__ void cvt_mlp(CParams& p_in, int l_in, unsigned char* smem, int cb, int cn) {
    CParams* pq_ = &p_in; asm volatile("" : "+s"(pq_)); CParams& p = *pq_;
    int l = l_in; asm volatile("" : "+s"(l));
    cvt_job(p.in[30] + (size_t)l * 1024 * 4096, 4096, 0, 4096, 1024, (bf16_t*)(p.ws + OFF_W + W_1), 0, smem, cb, cn);
    cvt_job(p.in[31] + (size_t)l * 4096 * 1024, 1024, 0, 1024, 4096, (bf16_t*)(p.ws + OFF_W + W_2), 0, smem, cb, cn);
}

__device__ __forceinline__ void row_pass(const float* xrow, const bf16_t* yrow, const float* gate, const float* nwA, float* xout,
                                         bool do_h, const float* nwB, const float* sh, const float* sc, bf16_t* hrow, int lane) {
    f32x4 x[4];
#pragma unroll
    for (int j = 0; j < 4; ++j) x[j] = *(const f32x4*)(xrow + j * 256 + lane * 4);
    if (yrow) {
        f32x4 y[4]; float ss = 0.f;
#pragma unroll
        for (int j = 0; j < 4; ++j) {
            const u32x2 raw = *(const u32x2*)(yrow + j * 256 + lane * 4);
            y[j] = (f32x4){bflo(raw.x), bfhi(raw.x), bflo(raw.y), bfhi(raw.y)};
            ss += y[j].x * y[j].x + y[j].y * y[j].y + y[j].z * y[j].z + y[j].w * y[j].w;
        }
        ss = wave_sum(ss);
        const float rs = rsqrtf(ss * (1.f / 1024.f) + 1e-6f);
#pragma unroll
        for (int j = 0; j < 4; ++j) {
            const f32x4 g = *(const f32x4*)(gate + j * 256 + lane * 4), w = *(const f32x4*)(nwA + j * 256 + lane * 4);
            x[j] += g * (y[j] * rs * w);
        }
    }
    if (xout) {
#pragma unroll
        for (int j = 0; j < 4; ++j) *(f32x4*)(xout + j * 256 + lane * 4) = x[j];
    }
    if (do_h) {
        float ss = 0.f;
#pragma unroll
        for (int j = 0; j < 4; ++j) ss += x[j].x * x[j].x + x[j].y * x[j].y + x[j].z * x[j].z + x[j].w * x[j].w;
        ss = wave_sum(ss);
        const float rs = rsqrtf(ss * (1.f / 1024.f) + 1e-6f);
#pragma unroll
        for (int j = 0; j < 4; ++j) {
            const f32x4 w = *(const f32x4*)(nwB + j * 256 + lane * 4), s = *(const f32x4*)(sh + j * 256 + lane * 4), c = *(const f32x4*)(sc + j * 256 + lane * 4);
            const f32x4 h = (x[j] * rs * w) * (c + 1.f) + s;
            u32x2 o; o.x = pk2(h.x, h.y); o.y = pk2(h.z, h.w);
            *(u32x2*)(hrow + j * 256 + lane * 4) = o;
        }
    }
}

__device__ __forceinline__ void token_phase(CParams& p_in, int l_in, int kind, int nrows) {
    CParams* pq_ = &p_in; asm volatile("" : "+s"(pq_)); CParams& p = *pq_;
    int l = l_in; asm volatile("" : "+s"(l));
    const int tidx = opaque_tid();
    const int lane = tidx & 63, gw = blockIdx.x * 8 + (tidx >> 6), ngw = gridDim.x * 8;
    const float* MOD = (const float*)(p.ws + OFF_MOD);
    const float* NW = p.in[4];
    bf16_t* H = (bf16_t*)(p.ws + OFF_H);
    float* CTXS = (float*)(p.ws + OFF_CTXS);
    for (int row = gw; row < nrows; row += ngw) {
        const bool lat = row < RL; const int mi = lat ? (row >> 13) : 4;
        const float* xin; float* xout = nullptr;
        const bool from_input = (l == 0 && kind <= 1);
        if (lat) xin = from_input ? p.in[0] + (size_t)row * 1024 : p.out + (size_t)row * 1024;
        else xin = from_input ? p.in[2] + (size_t)(row - RL) * 1024 : CTXS + (size_t)(row - RL) * 1024;
        if (kind > 0) xout = lat ? p.out + (size_t)row * 1024 : CTXS + (size_t)(row - RL) * 1024;
        const float* modl = MOD + (size_t)(l * 5 + mi) * 6144;
        bf16_t* hrow = H + (size_t)row * 1024;
        if (kind == 0) row_pass(xin, nullptr, nullptr, nullptr, nullptr, true, NW + (l * 4 + 0) * 1024, modl, modl + 1024, hrow, lane);
        else if (kind == 1) row_pass(xin, hrow, modl + 2048, NW + (l * 4 + 1) * 1024, xout, true, NW + (l * 4 + 2) * 1024, modl + 3072, modl + 4096, hrow, lane);
        else {
            const bool nxt = l < 3; const float* modn = MOD + (size_t)((l + 1) * 5 + mi) * 6144;
            row_pass(xin, hrow, modl + 5120, NW + (l * 4 + 3) * 1024, xout, nxt, NW + ((l + 1) * 4 + 0) * 1024, modn, modn + 1024, hrow, lane);
        }
    }
}

template <int NQ, int PB>
__device__ __forceinline__ void lin_steps(float (&S)[16], const float* qL, const float* kL, const float* vL, const float* dtL, const float* decL, float* yL, int dir, int nq, int pl) {
    constexpr int N = NQ * 16;
    for (int j = 0; j < 32; ++j) {
        const int tt = dir ? 31 - j : j;
        const float xdt = vL[tt * PB + pl] * dtL[tt];
        const float dec = decL[tt];
        const f32x4* kp = (const f32x4*)(kL + tt * N + nq * 16);
        const f32x4* qp = (const f32x4*)(qL + tt * N + nq * 16);
        float part = 0.f;
#pragma unroll
        for (int q4 = 0; q4 < 4; ++q4) {
            const f32x4 kv = kp[q4], qv = qp[q4];
            S[q4 * 4 + 0] = dec * S[q4 * 4 + 0] + kv.x * xdt; part += qv.x * S[q4 * 4 + 0];
            S[q4 * 4 + 1] = dec * S[q4 * 4 + 1] + kv.y * xdt; part += qv.y * S[q4 * 4 + 1];
            S[q4 * 4 + 2] = dec * S[q4 * 4 + 2] + kv.z * xdt; part += qv.z * S[q4 * 4 + 2];
            S[q4 * 4 + 3] = dec * S[q4 * 4 + 3] + kv.w * xdt; part += qv.w * S[q4 * 4 + 3];
        }
        part = (NQ == 8) ? red8(part) : red4(part);
        if (nq == 0) yL[tt * PB + pl] = part;
    }
}

__device__ __forceinline__ void scan_tile(int b, int dir, int tau, int& low, int& s0, int& s1, bool& isctx, bool& first) {
    int ti, nt;
    isctx = tau < 8;
    if (isctx) { ti = dir ? 7 - tau : tau; s0 = RL + b * 256; s1 = s0 + 256; nt = 8; }
    else { ti = dir ? 255 - (tau - 8) : tau - 8; s0 = b * 8192; s1 = s0 + 8192; nt = 256; }
    low = s0 + ti * 32;
    first = (dir == 0) == (ti < nt / 2);
}

template <int NK> struct CsL {
    static constexpr int SN = NK + 8, SS = 40;
    static constexpr int O_CN = 0, O_BN = O_CN + 32 * SN * 2, O_BWT = O_BN + 32 * SN * 2, O_XT = O_BWT + NK * SS * 2, O_PM = O_XT + 64 * SS * 2,
                         O_ST = O_PM + 32 * SS * 2, O_F = O_ST + 64 * SN * 2, O_Y = O_F + 544, O_RAW = (NK == 128) ? O_Y : O_Y + 8192;
};
template <int NK>
__device__ __forceinline__ void cs_core(unsigned char* base, f32x4 (&accS)[NK / 16], int dir, int w, int fr, int fq) {
    typedef CsL<NK> L;
    constexpr int SN = L::SN, SS = L::SS, KC = NK / 32, NT = NK / 16;
    bf16_t* Cn = (bf16_t*)(base + L::O_CN); bf16_t* Bn = (bf16_t*)(base + L::O_BN); bf16_t* BwT = (bf16_t*)(base + L::O_BWT);
    bf16_t* XT = (bf16_t*)(base + L::O_XT); bf16_t* Pm = (bf16_t*)(base + L::O_PM); bf16_t* ST = (bf16_t*)(base + L::O_ST);
    float* cumL = (float*)(base + L::O_F); float* dtL = cumL + 32; float* eL = dtL + 32; float* totL = eL + 64;
    float* yL = (float*)(base + ((NK == 128) ? L::O_BN : L::O_Y));
    f32x4 acc4[2];
    {
        const int mt = w >> 1, nt = w & 1;
        f32x4 g = (f32x4){0.f, 0.f, 0.f, 0.f};
#pragma unroll
        for (int kc = 0; kc < KC; ++kc) {
            const bf16x8 A = *(const bf16x8*)(Cn + (mt * 16 + fr) * SN + kc * 32 + fq * 8);
            const bf16x8 Bf = *(const bf16x8*)(Bn + (nt * 16 + fr) * SN + kc * 32 + fq * 8);
            g = __builtin_amdgcn_mfma_f32_16x16x32_bf16(A, Bf, g, 0, 0, 0);
        }
        const int s = nt * 16 + fr; const float cs = cumL[s], ds = dtL[s];
#pragma unroll
        for (int r = 0; r < 4; ++r) {
            const int t = mt * 16 + fq * 4 + r;
            const bool ok = dir ? (s >= t) : (s <= t);
            const float val = ok ? g[r] * __expf(cumL[t] - cs) * ds : 0.f;
            Pm[t * SS + s] = f2bf(val);
        }
#pragma unroll
        for (int mt2 = 0; mt2 < 2; ++mt2) {
            acc4[mt2] = (f32x4){0.f, 0.f, 0.f, 0.f};
#pragma unroll
            for (int kc = 0; kc < KC; ++kc) {
                const bf16x8 A = *(const bf16x8*)(Cn + (mt2 * 16 + fr) * SN + kc * 32 + fq * 8);
                const bf16x8 Bf = *(const bf16x8*)(ST + (w * 16 + fr) * SN + kc * 32 + fq * 8);
                acc4[mt2] = __builtin_amdgcn_mfma_f32_16x16x32_bf16(A, Bf, acc4[mt2], 0, 0, 0);
            }
        }
    }
    __syncthreads();
    {
        const bf16x8 Xf = *(const bf16x8*)(XT + (w * 16 + fr) * SS + fq * 8);
#pragma unroll
        for (int mt2 = 0; mt2 < 2; ++mt2) {
            const bf16x8 A = *(const bf16x8*)(Pm + (mt2 * 16 + fr) * SS + fq * 8);
            f32x4 a3 = (f32x4){0.f, 0.f, 0.f, 0.f};
            a3 = __builtin_amdgcn_mfma_f32_16x16x32_bf16(A, Xf, a3, 0, 0, 0);
#pragma unroll
            for (int r = 0; r < 4; ++r) { const int t = mt2 * 16 + fq * 4 + r; yL[t * 64 + w * 16 + fr] = a3[r] + eL[t] * acc4[mt2][r]; }
        }
        const float dtot = __expf(totL[0]);
#pragma unroll
        for (int n8 = 0; n8 < NT; ++n8) {
            const bf16x8 Bf = *(const bf16x8*)(BwT + (n8 * 16 + fr) * SS + fq * 8);
            accS[n8] = accS[n8] * dtot;
            accS[n8] = __builtin_amdgcn_mfma_f32_16x16x32_bf16(Xf, Bf, accS[n8], 0, 0, 0);
#pragma unroll
            for (int r = 0; r < 4; ++r) ST[(w * 16 + fq * 4 + r) * SN + n8 * 16 + fr] = f2bf(accS[n8][r]);
        }
    }
    __syncthreads();
}

template <int NK, bool DX>
__device__ __forceinline__ void cs_writeout(unsigned char* base, bf16_t* pp, u32x4 pv, int tl, float Dh) {
    typedef CsL<NK> L;
    const float* yL = (const float*)(base + ((NK == 128) ? L::O_BN : L::O_Y));
    const bf16_t* XT = (const bf16_t*)(base + L::O_XT);
    const int t = tl >> 3, pg = tl & 7;
    const f32x4 ya = *(const f32x4*)(yL + t * 64 + pg * 8), yb = *(const f32x4*)(yL + t * 64 + pg * 8 + 4);
    float y[8] = {ya.x, ya.y, ya.z, ya.w, yb.x, yb.y, yb.z, yb.w};
    const unsigned pa[4] = {pv.x, pv.y, pv.z, pv.w};
#pragma unroll
    for (int j = 0; j < 4; ++j) { y[2 * j] += bflo(pa[j]); y[2 * j + 1] += bfhi(pa[j]); }
    if (DX) {
#pragma unroll
        for (int j = 0; j < 8; ++j) y[j] += Dh * bf2f(XT[(pg * 8 + j) * L::SS + t]);
    }
    u32x4 o; o.x = pk2(y[0], y[1]); o.y = pk2(y[2], y[3]); o.z = pk2(y[4], y[5]); o.w = pk2(y[6], y[7]);
    *(u32x4*)pp = o;
}

__device__ __forceinline__ void ssd_scan_item(CParams& p_in, int l_in, int item, unsigned char* smem) {
    CParams* pq_ = &p_in; asm volatile("" : "+s"(pq_)); CParams& p = *pq_;
    int l = l_in; asm volatile("" : "+s"(l));
    const int tidx = opaque_tid();
    typedef CsL<128> L;
    constexpr int SN = L::SN, SS = L::SS;
    const int b = item >> 4, h = item & 15, g = h >> 3;
    const int tid = tidx, dir = tid >> 8, tl = tid & 255, lane = tid & 63, w = tl >> 6, fr = lane & 15, fq = lane >> 4;
    unsigned char* base = smem + dir * 76800;
    bf16_t* Cn = (bf16_t*)(base + L::O_CN); bf16_t* Bn = (bf16_t*)(base + L::O_BN); bf16_t* BwT = (bf16_t*)(base + L::O_BWT);
    bf16_t* XT = (bf16_t*)(base + L::O_XT); bf16_t* ST = (bf16_t*)(base + L::O_ST);
    float* cumL = (float*)(base + L::O_F); float* dtL = cumL + 32; float* eL = dtL + 32; float* wL = eL + 32; float* totL = eL + 64;
    bf16_t* rawL = (bf16_t*)(base + L::O_RAW);
    const bf16_t* XBC = (const bf16_t*)(p.ws + OFF_XBC);
    const float* DT = (const float*)(p.ws + OFF_DT);
    bf16_t* P = (bf16_t*)(p.ws + OFF_H);
    const float* cw = p.in[8] + (size_t)l * 5 * 1536; const float* cbias = p.in[9] + (size_t)l * 1536;
    const float dtb = p.in[10][l * 32 + dir * 16 + h];
    const float aneg = -__expf(p.in[11][l * 32 + dir * 16 + h]);
    const float Dh = p.in[12][l * 16 + h];
    const int xc1 = 1024 + g * 128 + (tl & 127) * 2;
    const int xc1c = ((tl & 127) < 64) ? xc1 : 1280 + g * 128 + ((tl & 127) - 64) * 2;
    const f32x2_t cw0 = {cw[xc1c], cw[xc1c + 1]}, cw1 = {cw[1536 + xc1c], cw[1536 + xc1c + 1]}, cw2 = {cw[2 * 1536 + xc1c], cw[2 * 1536 + xc1c + 1]},
                  cw3 = {cw[3 * 1536 + xc1c], cw[3 * 1536 + xc1c + 1]}, cw4 = {cw[4 * 1536 + xc1c], cw[4 * 1536 + xc1c + 1]}, cwb = {cbias[xc1c], cbias[xc1c + 1]};
    const int xc2 = h * 64 + (tl & 63);
    const float c20 = cw[xc2], c21 = cw[1536 + xc2], c22 = cw[2 * 1536 + xc2], c23 = cw[3 * 1536 + xc2], c24 = cw[4 * 1536 + xc2], c2b = cbias[xc2];
    for (int i = tl; i < 64 * SN; i += 256) ST[i] = 0;
    f32x4 accS[8];
#pragma unroll
    for (int i = 0; i < 8; ++i) accS[i] = (f32x4){0.f, 0.f, 0.f, 0.f};
    u32x4 rv[6]; float dtr = 0.f;
    int pf_rr[6], pf_off[6], pf_lds[6];
#pragma unroll
    for (int i = 0; i < 6; ++i) {
        const int e = tl + 256 * i; const int rr = e / 40, ch = e - rr * 40;
        const int xc = ch < 16 ? 1024 + g * 128 + ch * 8 : (ch < 32 ? 1280 + g * 128 + (ch - 16) * 8 : h * 64 + (ch - 32) * 8);
        pf_rr[i] = rr; pf_off[i] = rr * 1536 + xc; pf_lds[i] = (e < 36 * 40) ? rr * 320 + ch * 8 : -1;
    }
#define SSD_PREFETCH(tau_) do { int low_, s0_, s1_; bool ic_, fi_; scan_tile(b, dir, (tau_), low_, s0_, s1_, ic_, fi_); \
        const bf16_t* rb_ = XBC + (size_t)(low_ - 2) * 1536; \
        _Pragma("unroll") for (int i = 0; i < 6; ++i) { \
            const int row = low_ - 2 + pf_rr[i]; \
            rv[i] = (u32x4){0u, 0u, 0u, 0u}; \
            if (pf_lds[i] >= 0 && row >= s0_ && row < s1_) rv[i] = *(const u32x4*)(rb_ + pf_off[i]); } \
        if (tl < 32) dtr = DT[(size_t)(low_ + tl) * 32 + dir * 16 + h]; } while (0)
    SSD_PREFETCH(0);
    for (int tau = 0; tau < 264; ++tau) {
        int low, s0, s1; bool isctx, first;
        scan_tile(b, dir, tau, low, s0, s1, isctx, first);
#pragma unroll
        for (int i = 0; i < 6; ++i) { if (pf_lds[i] >= 0) *(u32x4*)(rawL + pf_lds[i]) = rv[i]; }
        if (tl < 64) {
            const float dt = fast_softplus(dtr + dtb);
            const float la = dt * aneg;
            float c = la;
#pragma unroll
            for (int o = 1; o < 32; o <<= 1) { const float v = __shfl_up(c, o); if (lane >= o) c += v; }
            const float total = __shfl(c, 31);
            const float cd = dir ? (total - c + la) : c;
            if (tl < 32) { cumL[tl] = cd; dtL[tl] = dt; eL[tl] = __expf(cd); wL[tl] = __expf(total - cd) * dt; if (tl == 0) totL[0] = total; }
        }
        bf16_t* pp = P + (size_t)(low + (tl >> 3)) * 1024 + h * 64 + (tl & 7) * 8;
        const bool late = (tau == 4) || (tau == 136);
        u32x4 pv = (u32x4){0u, 0u, 0u, 0u};
        if (!first && !late) pv = *(const u32x4*)pp;
        __syncthreads();
        {
            const bf16_t* __restrict__ rawR = rawL;
            {
                const int cp = tl & 127, th = tl >> 7, c0 = cp * 2, tb = th * 16;
                f32x2_t q0, q1, q2, q3;
                { const unsigned a = *(const unsigned*)(rawR + (tb) * 320 + c0), bq = *(const unsigned*)(rawR + (tb + 1) * 320 + c0), cq = *(const unsigned*)(rawR + (tb + 2) * 320 + c0), dq = *(const unsigned*)(rawR + (tb + 3) * 320 + c0);
                  q0 = (f32x2_t){bflo(a), bfhi(a)}; q1 = (f32x2_t){bflo(bq), bfhi(bq)}; q2 = (f32x2_t){bflo(cq), bfhi(cq)}; q3 = (f32x2_t){bflo(dq), bfhi(dq)}; }
#pragma unroll 8
                for (int j = 0; j < 16; ++j) {
                    const int t = tb + j;
                    const unsigned e = *(const unsigned*)(rawR + (t + 4) * 320 + c0);
                    const f32x2_t q4 = {bflo(e), bfhi(e)};
                    f32x2_t o = __builtin_elementwise_fma(cw4, q4, cwb);
                    o = __builtin_elementwise_fma(cw3, q3, o); o = __builtin_elementwise_fma(cw2, q2, o);
                    o = __builtin_elementwise_fma(cw1, q1, o); o = __builtin_elementwise_fma(cw0, q0, o);
                    o.x = siluf_(o.x); o.y = siluf_(o.y);
                    if (cp < 64) {
                        *(unsigned*)(Bn + t * SN + c0) = pk2(o.x, o.y);
                        const float wt = wL[t];
                        const unsigned bw = pk2(o.x * wt, o.y * wt);
                        BwT[c0 * SS + t] = (bf16_t)(bw & 0xffffu); BwT[(c0 + 1) * SS + t] = (bf16_t)(bw >> 16);
                    } else *(unsigned*)(Cn + t * SN + c0 - 128) = pk2(o.x, o.y);
                    q0 = q1; q1 = q2; q2 = q3; q3 = q4;
                }
            }
            const int xcol = 256 + (tl & 63), tq = tl >> 6;
            float q0 = bf2f(rawL[(tq * 8) * 320 + xcol]), q1 = bf2f(rawL[(tq * 8 + 1) * 320 + xcol]), q2 = bf2f(rawL[(tq * 8 + 2) * 320 + xcol]), q3 = bf2f(rawL[(tq * 8 + 3) * 320 + xcol]);
            unsigned xo[4];
#pragma unroll
            for (int j = 0; j < 8; ++j) {
                const float q4 = bf2f(rawL[(tq * 8 + j + 4) * 320 + xcol]);
                const float o = siluf_(c20 * q0 + c21 * q1 + c22 * q2 + c23 * q3 + c24 * q4 + c2b);
                if (j & 1) xo[j >> 1] |= ((unsigned)f2bf(o)) << 16; else xo[j >> 1] = f2bf(o);
                q0 = q1; q1 = q2; q2 = q3; q3 = q4;
            }
            *(u32x4*)(XT + (tl & 63) * SS + tq * 8) = (u32x4){xo[0], xo[1], xo[2], xo[3]};
        }
        __syncthreads();
        if (!first && late) pv = *(const u32x4*)pp;
        if (tau + 1 < 264) SSD_PREFETCH(tau + 1);
        cs_core<128>(base, accS, dir, w, fr, fq);
        cs_writeout<128, true>(base, pp, pv, tl, first ? 0.f : Dh);
    }
#undef SSD_PREFETCH
}

__device__ __forceinline__ void ret_scan_item(CParams& p_in, int l_in, int item, unsigned char* smem) {
    CParams* pq_ = &p_in; asm volatile("" : "+s"(pq_)); CParams& p = *pq_;
    int l = l_in; asm volatile("" : "+s"(l));
    const int tidx = opaque_tid();
    typedef CsL<64> L;
    constexpr int SN = L::SN, SS = L::SS;
    const int b = item >> 3, hd = (item >> 1) & 3, phalf = item & 1;
    const int tid = tidx, dir = tid >> 8, tl = tid & 255, lane = tid & 63, w = tl >> 6, fr = lane & 15, fq = lane >> 4;
    unsigned char* base = smem + dir * 76800;
    bf16_t* Cn = (bf16_t*)(base + L::O_CN); bf16_t* Bn = (bf16_t*)(base + L::O_BN); bf16_t* BwT = (bf16_t*)(base + L::O_BWT);
    bf16_t* XT = (bf16_t*)(base + L::O_XT); bf16_t* ST = (bf16_t*)(base + L::O_ST);
    float* cumL = (float*)(base + L::O_F); float* dtL = cumL + 32; float* eL = dtL + 32; float* wL = eL + 32; float* totL = eL + 64;
    bf16_t* rawL = (bf16_t*)(base + L::O_RAW);
    const bf16_t* QKV = (const bf16_t*)(p.ws + OFF_QKV);
    bf16_t* P = (bf16_t*)(p.ws + OFF_PRET);
    const float lg = -fast_softplus(-p.in[14][l * 8 + dir * 4 + hd]);
    if (tl < 32) {
        const float cd = dir ? (float)(32 - tl) * lg : (float)(tl + 1) * lg;
        const float total = 32.f * lg;
        cumL[tl] = cd; dtL[tl] = 1.f; eL[tl] = __expf(cd); wL[tl] = __expf(total - cd); if (tl == 0) totL[0] = total;
    }
    for (int i = tl; i < 64 * SN; i += 256) ST[i] = 0;
    f32x4 accS[4];
#pragma unroll
    for (int i = 0; i < 4; ++i) accS[i] = (f32x4){0.f, 0.f, 0.f, 0.f};
    const int pairidx = tl & 63, tq = tl >> 6, which = pairidx >> 5, pi = pairidx & 31;
    const float inv = exp2f(-(float)(pi & 15) * (13.287712379549449f / 16.f));
    u32x4 rv[3];
#define RET_PREFETCH(tau_) do { int low_, s0_, s1_; bool ic_, fi_; scan_tile(b, dir, (tau_), low_, s0_, s1_, ic_, fi_); \
        _Pragma("unroll") for (int i = 0; i < 3; ++i) { \
            const int e = tl + 256 * i; const int rr = e / 24, ch = e - rr * 24; \
            const int col = ch < 8 ? hd * 64 + ch * 8 : (ch < 16 ? 256 + hd * 64 + (ch - 8) * 8 : 512 + hd * 128 + phalf * 64 + (ch - 16) * 8); \
            rv[i] = *(const u32x4*)(QKV + (size_t)(low_ + rr) * 1024 + col); } } while (0)
    RET_PREFETCH(0);
    for (int tau = 0; tau < 264; ++tau) {
        int low, s0, s1; bool isctx, first;
        scan_tile(b, dir, tau, low, s0, s1, isctx, first);
#pragma unroll
        for (int i = 0; i < 3; ++i) { const int e = tl + 256 * i; const int rr = e / 24, ch = e - rr * 24; *(u32x4*)(rawL + rr * 192 + ch * 8) = rv[i]; }
        bf16_t* pp = P + (size_t)(low + (tl >> 3)) * 512 + hd * 128 + phalf * 64 + (tl & 7) * 8;
        const bool late = (tau == 4) || (tau == 136);
        u32x4 pv = (u32x4){0u, 0u, 0u, 0u};
        if (!first && !late) pv = *(const u32x4*)pp;
        __syncthreads();
        {
#pragma unroll
            for (int j = 0; j < 8; ++j) {
                const int t = tq * 8 + j;
                const unsigned raw = *(const unsigned*)(rawL + t * 192 + which * 64 + 2 * pi);
                const float x1 = bflo(raw), x2 = bfhi(raw);
                float c = 1.f, s = 0.f;
                if (!isctx) { const int pos = low + t - s0; const float ppos = (pi < 16) ? (float)(pos >> 6) : (float)(pos & 63); const float ang = ppos * inv; c = __cosf(ang); s = __sinf(ang); }
                const float o1 = x1 * c - x2 * s, o2 = x1 * s + x2 * c;
                if (which == 0) *(unsigned*)(Cn + t * SN + 2 * pi) = pk2(o1, o2);
                else {
                    const float k1 = o1 * 0.125f, k2 = o2 * 0.125f, wt = wL[t];
                    *(unsigned*)(Bn + t * SN + 2 * pi) = pk2(k1, k2);
                    BwT[(2 * pi) * SS + t] = f2bf(k1 * wt); BwT[(2 * pi + 1) * SS + t] = f2bf(k2 * wt);
                }
            }
            unsigned xo[4];
#pragma unroll
            for (int j = 0; j < 8; ++j) { const unsigned v = rawL[(tq * 8 + j) * 192 + 128 + pairidx]; if (j & 1) xo[j >> 1] |= v << 16; else xo[j >> 1] = v; }
            *(u32x4*)(XT + pairidx * SS + tq * 8) = (u32x4){xo[0], xo[1], xo[2], xo[3]};
        }
        __syncthreads();
        if (!first && late) pv = *(const u32x4*)pp;
        if (tau + 1 < 264) RET_PREFETCH(tau + 1);
        cs_core<64>(base, accS, dir, w, fr, fq);
        cs_writeout<64, false>(base, pp, pv, tl, 0.f);
    }
#undef RET_PREFETCH
}

__device__ __forceinline__ void shift_phase(CParams& p_in, int l_in, int part, unsigned char* smem) {
    CParams* pq_ = &p_in; asm volatile("" : "+s"(pq_)); CParams& p = *pq_;
    int l = l_in; asm volatile("" : "+s"(l));
    const int tidx = opaque_tid();
    bf16_t* RW = (bf16_t*)(p.ws + OFF_RW);
    u32x2* halo = (u32x2*)smem;
    const int c0 = tidx * 4;
    if (tidx >= 448) return;
    if (part == 0) {
        for (int k = 0; k < 5; ++k) {
            const int chunk = blockIdx.x + k * gridDim.x; if (chunk >= R / 32) break;
            const int lo = chunk * 32; int s0, s1;
            if (lo < RL) { s0 = lo & ~8191; s1 = s0 + 8192; } else { s0 = RL + ((lo - RL) & ~255); s1 = s0 + 256; }
            u32x2 a = (u32x2){0u, 0u}, b = (u32x2){0u, 0u};
            if (lo - 1 >= s0) a = *(const u32x2*)(RW + (size_t)(lo - 1) * 1792 + c0);
            if (lo + 32 < s1) b = *(const u32x2*)(RW + (size_t)(lo + 32) * 1792 + c0);
            halo[(k * 2 + 0) * 448 + tidx] = a; halo[(k * 2 + 1) * 448 + tidx] = b;
        }
        return;
    }
    const f32x4 mx = *(const f32x4*)(p.in[15] + (size_t)l * 1792 + c0);
    const int kind = (c0 >= 1536 && c0 < 1600) ? 1 : (c0 >= 1664 ? 2 : 0);
    for (int k = 0; k < 5; ++k) {
        const int chunk = blockIdx.x + k * gridDim.x; if (chunk >= R / 32) break;
        bf16_t* base = RW + (size_t)chunk * 32 * 1792 + c0;
        u32x2 rows[34];
        rows[0] = halo[(k * 2 + 0) * 448 + tidx]; rows[33] = halo[(k * 2 + 1) * 448 + tidx];
#pragma unroll
        for (int t = 0; t < 32; ++t) rows[t + 1] = *(const u32x2*)(base + (size_t)t * 1792);
#pragma unroll
        for (int t = 0; t < 32; ++t) {
            const u32x2 a = rows[t], b = rows[t + 1], c = rows[t + 2];
            f32x4 u0 = (f32x4){bflo(a.x), bfhi(a.x), bflo(a.y), bfhi(a.y)}, u1 = (f32x4){bflo(b.x), bfhi(b.x), bflo(b.y), bfhi(b.y)}, u2 = (f32x4){bflo(c.x), bfhi(c.x), bflo(c.y), bfhi(c.y)};
            f32x4 v = u1 + mx * ((u0 + u2) * 0.5f - u1);
            if (kind == 1) { v.x = fast_tanh(v.x); v.y = fast_tanh(v.y); v.z = fast_tanh(v.z); v.w = fast_tanh(v.w); }
            else if (kind == 2) { v.x = sigmoidf_(v.x); v.y = sigmoidf_(v.y); v.z = sigmoidf_(v.z); v.w = sigmoidf_(v.w); }
            u32x2 o; o.x = pk2(v.x, v.y); o.y = pk2(v.z, v.w);
            *(u32x2*)(base + (size_t)t * 1792) = o;
        }
    }
}

__device__ __forceinline__ void rwkv_scan_item(CParams& p_in, int l_in, int item, unsigned char* smem) {
    CParams* pq_ = &p_in; asm volatile("" : "+s"(pq_)); CParams& p = *pq_;
    int l = l_in; asm volatile("" : "+s"(l));
    const int tidx = opaque_tid();
    const int b = item >> 5, h = (item >> 2) & 7, rq = item & 3;
    const int tid = tidx, dir = tid >> 8, tl = tid & 255, lane = tid & 63, wv = tl >> 6;
    const int kq = lane & 15, rloc = wv * 4 + (lane >> 4);
    const int fr = lane & 15, fq = lane >> 4;
    unsigned char* base = smem + dir * 67072;
    float* rL = (float*)base;
    float *kL = rL + 2048, *wL = kL + 2048, *bL = wL + 2048, *nkL = bL + 2048, *vL = nkL + 2048, *yL = vL + 1024;
    float* kdL = (float*)(base + 58880);
    bf16_t* twB = (bf16_t*)(yL + 1024);
    bf16_t* aloB = twB + 2048;
    float* invn = (float*)(aloB + 2048);
    const bf16_t* RW = (const bf16_t*)(p.ws + OFF_RW);
    bf16_t* P = (bf16_t*)(p.ws + OFF_PRW);
    const int cch = h * 64 + wv * 16 + fr;
    bf16x8 Bw[2], Ba[2];
    {
        const float* w2g = p.in[17] + ((size_t)(l * 2 + dir) * 64) * 512 + cch;
        const float* a2g = p.in[19] + ((size_t)l * 64) * 512 + cch;
#pragma unroll
        for (int kc = 0; kc < 2; ++kc)
#pragma unroll
            for (int e = 0; e < 8; ++e) {
                const int j = kc * 32 + fq * 8 + e;
                Bw[kc][e] = (short)f2bf(w2g[(size_t)j * 512]); Ba[kc][e] = (short)f2bf(a2g[(size_t)j * 512]);
            }
    }
    const float w0c = p.in[16][(l * 2 + dir) * 512 + cch], a0c = p.in[18][(l * 2 + dir) * 512 + cch];
    const float kkc = p.in[21][l * 512 + cch], kac = p.in[22][l * 512 + cch];
    const int t2 = tl >> 3, part2 = tl & 7;
    f32x4 kk2a = *(const f32x4*)(p.in[21] + l * 512 + h * 64 + part2 * 8), kk2b = *(const f32x4*)(p.in[21] + l * 512 + h * 64 + part2 * 8 + 4);
    float S[4];
#pragma unroll
    for (int i = 0; i < 4; ++i) S[i] = 0.f;
    u32x4 rv[5];
    int pf_off[5], pf_dst[5], pf_mode[5];
#pragma unroll
    for (int i = 0; i < 5; ++i) {
        const int e = tl + 256 * i; const int rr = e / 34, ch = e - rr * 34;
        const int col = ch < 8 ? h * 64 + ch * 8 : (ch < 16 ? 512 + h * 64 + (ch - 8) * 8 : (ch < 32 ? 1536 + (ch - 16) * 8 : 1024 + h * 64 + rq * 16 + (ch - 32) * 8));
        pf_off[i] = rr * 1792 + col;
        int dst, mode;
        if (ch < 8) { dst = (int)((unsigned char*)(rL + rr * 64 + ch * 8) - base); mode = 0; }
        else if (ch < 16) { dst = (int)((unsigned char*)(kL + rr * 64 + (ch - 8) * 8) - base); mode = 0; }
        else if (ch < 24) { dst = (int)((unsigned char*)(twB + rr * 64 + (ch - 16) * 8) - base); mode = 1; }
        else if (ch < 32) { dst = (int)((unsigned char*)(aloB + rr * 64 + (ch - 24) * 8) - base); mode = 1; }
        else { dst = (int)((unsigned char*)(vL + rr * 16 + (ch - 32) * 8) - base); mode = 0; }
        pf_dst[i] = dst; pf_mode[i] = (e < 32 * 34) ? mode : -1;
    }
#define RW_PREFETCH(tau_) do { int low_, s0_, s1_; bool ic_, fi_; scan_tile(b, dir, (tau_), low_, s0_, s1_, ic_, fi_); \
        const bf16_t* rb_ = RW + (size_t)low_ * 1792; \
        _Pragma("unroll") for (int i = 0; i < 5; ++i) { \
            rv[i] = (u32x4){0u, 0u, 0u, 0u}; \
            if (pf_mode[i] >= 0) rv[i] = *(const u32x4*)(rb_ + pf_off[i]); } } while (0)
    RW_PREFETCH(0);
    for (int tau = 0; tau < 264; ++tau) {
        int low, s0, s1; bool isctx, first;
        scan_tile(b, dir, tau, low, s0, s1, isctx, first);
#pragma unroll
        for (int i = 0; i < 5; ++i) {
            if (pf_mode[i] == 1) *(u32x4*)(base + pf_dst[i]) = rv[i];
            else if (pf_mode[i] == 0) {
                *(f32x4*)(base + pf_dst[i]) = (f32x4){bflo(rv[i].x), bfhi(rv[i].x), bflo(rv[i].y), bfhi(rv[i].y)};
                *(f32x4*)(base + pf_dst[i] + 16) = (f32x4){bflo(rv[i].z), bfhi(rv[i].z), bflo(rv[i].w), bfhi(rv[i].w)};
            }
        }
        bf16_t* pp = P + (size_t)(low + t2) * 512 + h * 64 + rq * 16 + part2 * 2;
        const bool late = (tau == 4) || (tau == 136);
        unsigned pv = 0u;
        if (!first && !late) pv = *(const unsigned*)pp;
        __syncthreads();
        {
            const f32x4 ka = *(const f32x4*)(kL + t2 * 64 + part2 * 8), kb = *(const f32x4*)(kL + t2 * 64 + part2 * 8 + 4);
            const f32x4 pa = ka * kk2a, pb = kb * kk2b;
            float ss = pa.x * pa.x + pa.y * pa.y + pa.z * pa.z + pa.w * pa.w + pb.x * pb.x + pb.y * pb.y + pb.z * pb.z + pb.w * pb.w;
            ss = red8(ss);
            if (part2 == 0) { const float iv = __builtin_amdgcn_rcpf(fmaxf(sqrtf(ss), 1e-12f)); invn[t2] = iv * iv; }
        }
        f32x4 accw[2], acca[2];
#pragma unroll
        for (int mt = 0; mt < 2; ++mt) {
            accw[mt] = (f32x4){0.f, 0.f, 0.f, 0.f}; acca[mt] = (f32x4){0.f, 0.f, 0.f, 0.f};
#pragma unroll
            for (int kc = 0; kc < 2; ++kc) {
                const bf16x8 Aw = *(const bf16x8*)(twB + (mt * 16 + fr) * 64 + kc * 32 + fq * 8);
                const bf16x8 Aa = *(const bf16x8*)(aloB + (mt * 16 + fr) * 64 + kc * 32 + fq * 8);
                accw[mt] = __builtin_amdgcn_mfma_f32_16x16x32_bf16(Aw, Bw[kc], accw[mt], 0, 0, 0);
                acca[mt] = __builtin_amdgcn_mfma_f32_16x16x32_bf16(Aa, Ba[kc], acca[mt], 0, 0, 0);
            }
        }
#pragma unroll
        for (int mt = 0; mt < 2; ++mt)
#pragma unroll
            for (int r = 0; r < 4; ++r) {
                const int t = mt * 16 + fq * 4 + r, c = wv * 16 + fr;
                const float wl = w0c + accw[mt][r];
                const float decay = __expf(-0.6065306597f * sigmoidf_(wl));
                const float a = sigmoidf_(a0c + acca[mt][r]);
                const float kraw = kL[t * 64 + c];
                const float kk = kraw * kkc;
                wL[t * 64 + c] = decay;
                kdL[t * 64 + c] = kraw * (1.f + (a - 1.f) * kac);
                bL[t * 64 + c] = kk * a;
                nkL[t * 64 + c] = -kk;
            }
        __syncthreads();
        if (!first && late) pv = *(const unsigned*)pp;
        if (tau + 1 < 264) RW_PREFETCH(tau + 1);
        {
            const float* __restrict__ nkR = nkL + kq * 4; const float* __restrict__ wR = wL + kq * 4; const float* __restrict__ bR = bL + kq * 4;
            const float* __restrict__ kR = kdL + kq * 4; const float* __restrict__ rR = rL + kq * 4; const float* __restrict__ vR = vL + rloc;
            float* __restrict__ yW = yL + rloc;
            const int t0 = dir ? 31 : 0, dt = dir ? -1 : 1;
            f32x4 n0 = *(const f32x4*)(nkR + t0 * 64), wa = *(const f32x4*)(wR + t0 * 64), ba = *(const f32x4*)(bR + t0 * 64);
            f32x4 ka = *(const f32x4*)(kR + t0 * 64), ra = *(const f32x4*)(rR + t0 * 64);
            float vv = vR[t0 * 16], iv2 = invn[t0];
            f32x2_t S01 = {S[0], S[1]}, S23 = {S[2], S[3]};
            float yprev = 0.f; int tprev = t0;
#pragma unroll 2
            for (int j = 0; j < 32; ++j) {
                const int tt = t0 + dt * j;
                const int tn = (j < 31) ? tt + dt : tt;
                const f32x4 n0n = *(const f32x4*)(nkR + tn * 64), wan = *(const f32x4*)(wR + tn * 64), ban = *(const f32x4*)(bR + tn * 64);
                const f32x4 kan = *(const f32x4*)(kR + tn * 64), ran = *(const f32x4*)(rR + tn * 64);
                const float vvn = vR[tn * 16], iv2n = invn[tn];
                f32x2_t pp2 = S01 * (f32x2_t){n0.x, n0.y};
                pp2 = __builtin_elementwise_fma(S23, (f32x2_t){n0.z, n0.w}, pp2);
                float ra_ = pp2.x + pp2.y, rb_ = yprev;
                ra_ += dppf<0xB1>(ra_); rb_ += dppf<0xB1>(rb_);
                ra_ += dppf<0x4E>(ra_); rb_ += dppf<0x4E>(rb_);
                ra_ += dppf<0x141>(ra_); rb_ += dppf<0x141>(rb_);
                ra_ += dppf<0x140>(ra_); rb_ += dppf<0x140>(rb_);
                if (kq == 0 && j > 0) yW[tprev * 16] = rb_;
                const float sa = ra_ * iv2;
                const f32x2_t sav = {sa, sa}, vvv = {vv, vv};
                f32x2_t t01 = vvv * (f32x2_t){ka.x, ka.y}, t23 = vvv * (f32x2_t){ka.z, ka.w};
                t01 = __builtin_elementwise_fma(sav, (f32x2_t){ba.x, ba.y}, t01);
                t23 = __builtin_elementwise_fma(sav, (f32x2_t){ba.z, ba.w}, t23);
                S01 = __builtin_elementwise_fma(S01, (f32x2_t){wa.x, wa.y}, t01);
                S23 = __builtin_elementwise_fma(S23, (f32x2_t){wa.z, wa.w}, t23);
                f32x2_t qq = S01 * (f32x2_t){ra.x, ra.y};
                qq = __builtin_elementwise_fma(S23, (f32x2_t){ra.z, ra.w}, qq);
                yprev = qq.x + qq.y; tprev = tt;
                n0 = n0n; wa = wan; ba = ban; ka = kan; ra = ran; vv = vvn; iv2 = iv2n;
            }
            { const float y = red16(yprev); if (kq == 0) yW[tprev * 16] = y; }
            S[0] = S01.x; S[1] = S01.y; S[2] = S23.x; S[3] = S23.y;
        }
        __syncthreads();
        {
            const float y0 = yL[t2 * 16 + part2 * 2], y1 = yL[t2 * 16 + part2 * 2 + 1];
            *(unsigned*)pp = pk2(bflo(pv) + y0, bfhi(pv) + y1);
        }
    }
#undef RW_PREFETCH
}

__device__ __forceinline__ void scan_phase(CParams& p, int l, unsigned char* smem) {
    for (int it = blockIdx.x; it < 224; it += gridDim.x) {
        if (it < 128) rwkv_scan_item(p, l, it, smem);
        else if (it < 192) ssd_scan_item(p, l, it - 128, smem);
        else ret_scan_item(p, l, it - 192, smem);
        __syncthreads();
    }
    int cb = (int)blockIdx.x - 224, cn = (int)gridDim.x - 224;
    if (cn <= 0) { cb = blockIdx.x; cn = gridDim.x; }
    if (cb >= 0) cvt_mix(p, l, smem, cb, cn);
}

__device__ __forceinline__ void post_phase(CParams& p_in, int l_in, int nrows, unsigned char* smem) {
    CParams* pq_ = &p_in; asm volatile("" : "+s"(pq_)); CParams& p = *pq_;
    int l = l_in; asm volatile("" : "+s"(l));
    const int tidx = opaque_tid();
    const int lane = tidx & 63, gw = blockIdx.x * 8 + (tidx >> 6), ngw = gridDim.x * 8;
    unsigned char* ws = p.ws;
    const float* MOD = (const float*)(ws + OFF_MOD);
    for (int row = gw; row < nrows; row += ngw) {
        {
            const bf16_t* yp = (const bf16_t*)(ws + OFF_H) + (size_t)row * 1024 + lane * 16;
            bf16_t* zp = (bf16_t*)(ws + OFF_Z) + (size_t)row * 1024 + lane * 16;
            const float* nw = p.in[13] + (size_t)l * 1024 + lane * 16;
            float v[16]; float ss = 0.f;
#pragma unroll
            for (int q = 0; q < 2; ++q) {
                const u32x4 yr = *(const u32x4*)(yp + q * 8), zr = *(const u32x4*)(zp + q * 8);
                const unsigned ya[4] = {yr.x, yr.y, yr.z, yr.w}, za[4] = {zr.x, zr.y, zr.z, zr.w};
#pragma unroll
                for (int e = 0; e < 4; ++e) {
                    const float y0 = bflo(ya[e]), y1 = bfhi(ya[e]), z0 = bflo(za[e]), z1 = bfhi(za[e]);
                    const float a = y0 * siluf_(z0), c = y1 * siluf_(z1);
                    v[q * 8 + e * 2] = a; v[q * 8 + e * 2 + 1] = c; ss += a * a + c * c;
                }
            }
            ss = red16(ss); ss += __shfl_xor(ss, 16);
            const float rs = rsqrtf(ss * (1.f / 512.f) + 1e-6f);
#pragma unroll
            for (int q = 0; q < 2; ++q) {
                const f32x4 wa = *(const f32x4*)(nw + q * 8), wb = *(const f32x4*)(nw + q * 8 + 4);
                u32x4 o;
                o.x = pk2(v[q * 8 + 0] * rs * wa.x, v[q * 8 + 1] * rs * wa.y); o.y = pk2(v[q * 8 + 2] * rs * wa.z, v[q * 8 + 3] * rs * wa.w);
                o.z = pk2(v[q * 8 + 4] * rs * wb.x, v[q * 8 + 5] * rs * wb.y); o.w = pk2(v[q * 8 + 6] * rs * wb.z, v[q * 8 + 7] * rs * wb.w);
                *(u32x4*)(zp + q * 8) = o;
            }
        }
        {
            const bf16_t* yp = (const bf16_t*)(ws + OFF_PRET) + (size_t)row * 512 + lane * 8;
            bf16_t* gp = (bf16_t*)(ws + OFF_G) + (size_t)row * 512 + lane * 8;
            const u32x4 yr = *(const u32x4*)yp, gr = *(const u32x4*)gp;
            const unsigned ya[4] = {yr.x, yr.y, yr.z, yr.w}, ga[4] = {gr.x, gr.y, gr.z, gr.w};
            float v[8], gg[8]; float s = 0.f;
#pragma unroll
            for (int e = 0; e < 4; ++e) { v[2 * e] = bflo(ya[e]); v[2 * e + 1] = bfhi(ya[e]); gg[2 * e] = bflo(ga[e]); gg[2 * e + 1] = bfhi(ga[e]); s += v[2 * e] + v[2 * e + 1]; }
            s = red16(s);
            const float mean = s * (1.f / 128.f); float q2 = 0.f;
#pragma unroll
            for (int e = 0; e < 8; ++e) { v[e] -= mean; q2 += v[e] * v[e]; }
            q2 = red16(q2);
            const float rs = rsqrtf(q2 * (1.f / 128.f) + 1e-6f);
            u32x4 o;
            o.x = pk2(v[0] * rs * siluf_(gg[0]), v[1] * rs * siluf_(gg[1])); o.y = pk2(v[2] * rs * siluf_(gg[2]), v[3] * rs * siluf_(gg[3]));
            o.z = pk2(v[4] * rs * siluf_(gg[4]), v[5] * rs * siluf_(gg[5])); o.w = pk2(v[6] * rs * siluf_(gg[6]), v[7] * rs * siluf_(gg[7]));
            *(u32x4*)gp = o;
        }
        {
            const bool lat = row < RL; const int mi = lat ? (row >> 13) : 4;
            const float* xin;
            if (lat) xin = (l == 0) ? p.in[0] + (size_t)row * 1024 : p.out + (size_t)row * 1024;
            else xin = (l == 0) ? p.in[2] + (size_t)(row - RL) * 1024 : (const float*)(ws + OFF_CTXS) + (size_t)(row - RL) * 1024;
            const float* modl = MOD + (size_t)(l * 5 + mi) * 6144;
            row_pass(xin, nullptr, nullptr, nullptr, nullptr, true, p.in[4] + (l * 4 + 0) * 1024, modl, modl + 1024, (bf16_t*)(ws + OFF_XBC) + (size_t)row * 1024, lane);
        }
    }
    bf16_t* aB = (bf16_t*)smem;
    bf16_t* gB = aB + 32 * 72;
    float* asL = (float*)(smem + 13312);
    float* gsL = asL + 32 * 512;
    const bf16_t* RW = (const bf16_t*)(ws + OFF_RW);
    bf16_t* P = (bf16_t*)(ws + OFF_PRW);
    const float* mix = p.in[15] + (size_t)l * 1792;
    const int c = tidx;
    const float a0f = p.in[18][(l * 2 + 0) * 512 + c], a0b = p.in[18][(l * 2 + 1) * 512 + c];
    const float kac = p.in[22][l * 512 + c], rkc = p.in[23][l * 512 + c], lw = p.in[24][l * 512 + c], lb = p.in[25][l * 512 + c];
    const float mxr = mix[c], mxk = mix[512 + c], mxv = mix[1024 + c];
    const int wvB = tidx >> 6, frB = lane & 15, fqB = lane >> 4;
    const float* a2 = p.in[19] + (size_t)l * 64 * 512 + wvB * 64 + frB;
    const float* g2 = p.in[20] + (size_t)l * 128 * 512 + wvB * 64 + frB;
    for (int tile = blockIdx.x; tile < nrows / 32; tile += gridDim.x) {
        const int low = tile * 32;
        int s0, s1;
        if (low < RL) { s0 = low & ~8191; s1 = s0 + 8192; } else { s0 = RL + ((low - RL) & ~255); s1 = s0 + 256; }
        {
            for (int e = tidx; e < 32 * 24; e += 512) {
                const int t = e / 24, ch = e - t * 24;
                const u32x4 v = *(const u32x4*)(RW + (size_t)(low + t) * 1792 + 1600 + ch * 8);
                if (ch < 8) *(u32x4*)(aB + t * 72 + ch * 8) = v; else *(u32x4*)(gB + t * 136 + (ch - 8) * 8) = v;
            }
        }
        __syncthreads();
        {
            bf16x8 Aa[2][2], Ag[2][4];
#pragma unroll
            for (int mt = 0; mt < 2; ++mt) {
#pragma unroll
                for (int kc = 0; kc < 2; ++kc) Aa[mt][kc] = *(const bf16x8*)(aB + (mt * 16 + frB) * 72 + kc * 32 + fqB * 8);
#pragma unroll
                for (int kc = 0; kc < 4; ++kc) Ag[mt][kc] = *(const bf16x8*)(gB + (mt * 16 + frB) * 136 + kc * 32 + fqB * 8);
            }
#pragma unroll 1
            for (int nt = 0; nt < 4; ++nt) {
                bf16x8 ba[2], bg[4];
#pragma unroll
                for (int kc = 0; kc < 2; ++kc)
#pragma unroll
                    for (int e = 0; e < 8; ++e) ba[kc][e] = (short)f2bf(a2[(size_t)(kc * 32 + fqB * 8 + e) * 512 + nt * 16]);
#pragma unroll
                for (int kc = 0; kc < 4; ++kc)
#pragma unroll
                    for (int e = 0; e < 8; ++e) bg[kc][e] = (short)f2bf(g2[(size_t)(kc * 32 + fqB * 8 + e) * 512 + nt * 16]);
#pragma unroll
                for (int mt = 0; mt < 2; ++mt) {
                    f32x4 ca = (f32x4){0.f, 0.f, 0.f, 0.f}, cg = (f32x4){0.f, 0.f, 0.f, 0.f};
#pragma unroll
                    for (int kc = 0; kc < 2; ++kc) ca = __builtin_amdgcn_mfma_f32_16x16x32_bf16(Aa[mt][kc], ba[kc], ca, 0, 0, 0);
#pragma unroll
                    for (int kc = 0; kc < 4; ++kc) cg = __builtin_amdgcn_mfma_f32_16x16x32_bf16(Ag[mt][kc], bg[kc], cg, 0, 0, 0);
#pragma unroll
                    for (int r = 0; r < 4; ++r) {
                        const int idx = (mt * 16 + fqB * 4 + r) * 512 + wvB * 64 + nt * 16 + frB;
                        asL[idx] = ca[r]; gsL[idx] = cg[r];
                    }
                }
            }
        }
        __syncthreads();
        const bf16_t* u = RW + (size_t)low * 1792;
#pragma unroll 4
        for (int i = 0; i < 32; ++i) {
            const int row = low + i;
            const bf16_t* un = u + (size_t)i * 1792;
            const float r = bf2f(un[c]), k = bf2f(un[512 + c]), v = bf2f(un[1024 + c]);
            const float y = bf2f(P[(size_t)row * 512 + c]);
            const float ash = asL[i * 512 + c];
            const float af = sigmoidf_(a0f + ash), ab = sigmoidf_(a0b + ash);
            const float ks = k * (2.f + (af + ab - 2.f) * kac);
            const float bsum = wave_sum(r * ks * rkc);
            const float mean = wave_sum(y) * (1.f / 64.f);
            const float d = y - mean;
            const float var = wave_sum(d * d) * (1.f / 64.f);
            const float yn = d * rsqrtf(var + 64e-5f) * lw + lb;
            P[(size_t)row * 512 + c] = f2bf((yn + bsum * v) * gsL[i * 512 + c]);
        }
        __syncthreads();
    }
}

__device__ __forceinline__ void flat_barrier(unsigned* cnt, unsigned target) {
    asm volatile("s_waitcnt vmcnt(0)" ::: "memory");
    __syncthreads();
    if (threadIdx.x == 0) {
        __builtin_amdgcn_fence(__ATOMIC_RELEASE, "agent");
        asm volatile("s_waitcnt vmcnt(0)" ::: "memory");
        __hip_atomic_fetch_add(cnt, 1u, __ATOMIC_RELAXED, __HIP_MEMORY_SCOPE_AGENT);
        while (__hip_atomic_load(cnt, __ATOMIC_RELAXED, __HIP_MEMORY_SCOPE_AGENT) < target) __builtin_amdgcn_s_sleep(1);
        __builtin_amdgcn_fence(__ATOMIC_ACQUIRE, "agent");
        asm volatile("s_waitcnt vmcnt(0)" ::: "memory");
    }
    __syncthreads();
}

__global__ void __launch_bounds__(512) mega(Params p_arg) {
    extern __shared__ __attribute__((aligned(16))) unsigned char smem[];
    CParams* pbase = (CParams*)__builtin_amdgcn_kernarg_segment_ptr();
    const int ph_lo = p_arg.ph_lo, ph_hi = p_arg.ph_hi;
    for (int ph = ph_lo; ph < ph_hi; ++ph) {
        CParams* pq = pbase;
        asm volatile("" : "+s"(pq));
        CParams& p = *pq;
        int gm = -1, l = 0, sub = -1;
        if (ph >= 2) { l = (ph - 2) / 11; sub = (ph - 2) % 11; }
        const int nrows = (l == 3) ? RL : R;
        if (sub == 0) gm = GM_IN; else if (sub == 5) gm = GM_MERGE; else if (sub == 6) gm = GM_OUT; else if (sub == 8) gm = GM_MLP1; else if (sub == 9) gm = GM_MLP2;
        if (gm >= 0) {
            gemm_phase(p, gm, gm == GM_IN ? 132 : nrows / 256, (LAS unsigned char*)smem);
            __syncthreads();
        } else if (ph == 0) {
            phase_mod(p, smem);
            cvt_win(p, 0, smem, blockIdx.x, gridDim.x);
        } else if (ph == 1) {
            token_phase(p, 0, 0, R);
        } else if (sub == 1) {
            shift_phase(p, l, 0, smem);
        } else if (sub == 2) {
            shift_phase(p, l, 1, smem);
        } else if (sub == 3) {
            scan_phase(p, l, smem);
        } else if (sub == 4) {
            post_phase(p, l, nrows, smem);
        } else if (sub == 7) {
            token_phase(p, l, 1, nrows);
            cvt_mlp(p, l, smem, blockIdx.x, gridDim.x);
        } else if (sub == 10) {
            token_phase(p, l, 2, nrows);
            if (l < 3) cvt_win(p, l + 1, smem, blockIdx.x, gridDim.x);
        }
        if (ph + 1 < ph_hi) {
            if (ph == ph_lo) { __threadfence(); cg::this_grid().sync(); }
            else flat_barrier((unsigned*)(p_arg.ws + OFF_BAR), (unsigned)(ph - ph_lo) * gridDim.x);
        }
    }
}

extern "C" void kernel_launch(void* const* d_in, const int* in_sizes, int n_in, void* d_out, int out_size, void* d_ws, size_t ws_size, hipStream_t stream) {
    static int grid = 0;
    if (grid == 0) {
        if (n_in != 32 || ws_size < WS_END) { fprintf(stderr, "kernel_launch: bad n_in %d or ws %zu < %zu\n", n_in, ws_size, (size_t)WS_END); grid = -1; return; }
        if (hipFuncSetAttribute((const void*)mega, hipFuncAttributeMaxDynamicSharedMemorySize, LDS_BYTES) != hipSuccess) { grid = -1; return; }
        int dev = 0, cus = 0, per_cu = 0;
        hipGetDevice(&dev);
        hipDeviceGetAttribute(&cus, hipDeviceAttributeMultiprocessorCount, dev);
        hipOccupancyMaxActiveBlocksPerMultiprocessor(&per_cu, (const void*)mega, 512, LDS_BYTES);
        (void)hipGetLastError();
        if (per_cu < 1) per_cu = 1;
        grid = cus * per_cu; if (grid > 256) grid = 256;
    }
    if (grid < 0) return;
    Params p{};
    for (int i = 0; i < 32; ++i) p.in[i] = (const float*)d_in[i];
    p.out = (float*)d_out; p.ws = (unsigned char*)d_ws;
    p.ph_lo = 0; p.ph_hi = NPH; p.coop = 1; p.pad = 0;
    if (hipMemsetAsync((char*)d_ws + OFF_BAR, 0, 64, stream) != hipSuccess) return;
    void* args[] = {&p};
    hipError_t e = hipLaunchCooperativeKernel((const void*)mega, dim3(grid), dim3(512), args, LDS_BYTES, stream);
    if (e != hipSuccess) fprintf(stderr, "cooperative launch failed: %s (grid %d)\n", hipGetErrorString(e), grid);
}
```

```cpp
#include <hip/hip_runtime.h>
#include <hip/hip_cooperative_groups.h>
#include <cstdint>
#include <cstdio>
namespace cg = cooperative_groups;

typedef unsigned short bf16_t;
typedef short bf16x8 __attribute__((ext_vector_type(8)));
typedef float f32x4 __attribute__((ext_vector_type(4)));
typedef unsigned u32x2 __attribute__((ext_vector_type(2)));
typedef unsigned u32x4 __attribute__((ext_vector_type(4)));

constexpr int RL = 32768;
constexpr int RC = 1024;
constexpr int R = RL + RC;
constexpr int LDS_BYTES = 153600;
constexpr int NPH = 2 + 11 * 4;
#ifndef PROBE_SCAN
#define PROBE_SCAN 0
#endif
#ifndef PROBE_GEMM
#define PROBE_GEMM 0
#endif

constexpr size_t OFF_MOD = 0;
constexpr size_t OFF_BAR = 491776;
constexpr size_t OFF_CTXS = 524288;
constexpr size_t OFF_DT = OFF_CTXS + 4194304;
constexpr size_t OFF_W = OFF_DT + (size_t)R * 32 * 4;
constexpr size_t OFF_H = OFF_W + 16777216;
constexpr size_t SZ1024 = (size_t)R * 1024 * 2;
constexpr size_t OFF_Z = OFF_H + SZ1024;
constexpr size_t OFF_XBC = OFF_Z + SZ1024;
constexpr size_t OFF_QKV = OFF_XBC + (size_t)R * 1536 * 2;
constexpr size_t OFF_G = OFF_QKV + SZ1024;
constexpr size_t OFF_RW = OFF_G + (size_t)R * 512 * 2;
constexpr size_t OFF_PRET = OFF_RW + (size_t)R * 1792 * 2;
constexpr size_t OFF_PRW = OFF_PRET + (size_t)R * 512 * 2;
constexpr size_t WS_END = OFF_PRW + (size_t)R * 512 * 2;
constexpr size_t W_G = 0, W_SO = 6291456, W_RO = 8388608, W_WO = 9437184, W_O = 10485760;
constexpr size_t W_1 = 0, W_2 = 8388608;
constexpr size_t MSCR_S = 0, MSCR_M = (size_t)256 * 131072;

struct Params {
    const float* in[32];
    float* out;
    unsigned char* ws;
    int ph_lo, ph_hi, coop, pad;
};

typedef const __attribute__((address_space(4))) Params CParams;

__device__ __forceinline__ float bf2f(bf16_t h) { return __uint_as_float(((unsigned)h) << 16); }
__device__ __forceinline__ float bflo(unsigned u) { return __uint_as_float(u << 16); }
__device__ __forceinline__ float bfhi(unsigned u) { return __uint_as_float(u & 0xffff0000u); }
typedef float f32x2_t __attribute__((ext_vector_type(2)));
typedef __bf16 bf16x2_t __attribute__((ext_vector_type(2)));
__device__ __forceinline__ unsigned pk2(float a, float b) { const f32x2_t v = {a, b}; const bf16x2_t r = __builtin_convertvector(v, bf16x2_t); return __builtin_bit_cast(unsigned, r); }
__device__ __forceinline__ bf16_t f2bf(float f) { const __bf16 r = (__bf16)f; return __builtin_bit_cast(unsigned short, r); }
template <int CTRL> __device__ __forceinline__ float dppf(float v) {
    return __builtin_bit_cast(float, __builtin_amdgcn_update_dpp(0, __builtin_bit_cast(int, v), CTRL, 0xf, 0xf, true));
}
__device__ __forceinline__ float red4(float v) { v += dppf<0xB1>(v); v += dppf<0x4E>(v); return v; }
__device__ __forceinline__ float red8(float v) { v = red4(v); v += dppf<0x141>(v); return v; }
__device__ __forceinline__ float red16(float v) { v = red8(v); v += dppf<0x140>(v); return v; }
__device__ __forceinline__ float wave_sum(float v) { v = red16(v); v += __shfl_xor(v, 16); v += __shfl_xor(v, 32); return v; }
__device__ __forceinline__ int opaque_tid() { int t = threadIdx.x; asm volatile("" : "+v"(t)); return t; }
__device__ __forceinline__ float sigmoidf_(float x) { return __builtin_amdgcn_rcpf(1.f + __expf(-x)); }
__device__ __forceinline__ float siluf_(float x) { return x * __builtin_amdgcn_rcpf(1.f + __expf(-x)); }
__device__ __forceinline__ float fast_tanh(float x) { return 1.f - 2.f * __builtin_amdgcn_rcpf(1.f + __expf(2.f * x)); }
__device__ __forceinline__ float fast_softplus(float x) { return x > 20.f ? x : __logf(1.f + __expf(x)); }
__device__ __forceinline__ float softplusf_(float x) { return x > 20.f ? x : log1pf(__expf(x)); }

constexpr int BK = 64, HALF = 128, HT = HALF * BK;
__device__ __forceinline__ int lds_byte(int r, int c) {
    int st = (r >> 4) * 2 + (c >> 5), rr = r & 15, cc = c & 31, ob = rr * 64 + cc * 2;
    return st * 1024 + (ob ^ (((ob >> 9) & 1) << 5));
}
__device__ __forceinline__ void stage_rc(int b, int& Rr, int& Cc) {
    int st = b / 1024, sb = b % 1024, swz = sb ^ (((sb >> 9) & 1) << 5);
    Rr = (st >> 1) * 16 + swz / 64; Cc = (st & 1) * 32 + (swz % 64) / 2;
}

#define LAS __attribute__((address_space(3)))
constexpr int HTB = HALF * BK * 2;

__device__ __forceinline__ bool tile_next(int i, int G, int c, int nM, int nN, int& pm, int& pn) {
    const int nwg = nM * nN;
    const long L = (long)i * G + c; if (L >= nwg) return false;
    int wgid = (int)L; { const int q = nwg / 8, r = nwg % 8, xcd = wgid % 8, off = wgid / 8; wgid = (xcd < r ? xcd * (q + 1) : r * (q + 1) + (xcd - r) * q) + off; }
    const int nig = 8 * nN, gid = wgid / nig, fm = gid * 8, gsz = (nM - fm) < 8 ? (nM - fm) : 8;
    pm = fm + ((wgid % nig) % gsz); pn = (wgid % nig) / gsz; return true;
}

enum { GM_IN = 0, GM_MERGE = 1, GM_OUT = 2, GM_MLP1 = 3, GM_MLP2 = 4 };
struct UnitInfo { const char* A; const char* B; int K, wt, mt, step; };

__device__ __forceinline__ bool get_unit(unsigned char* ws, int mode, int n_mt, int n_wt, int nsteps, int ui, UnitInfo& u) {
    const int it = ui / nsteps, step = ui - it * nsteps;
    int mt, wt;
    if (!tile_next(it, gridDim.x, blockIdx.x, n_mt, n_wt, mt, wt)) return false;
    const size_t tok0 = (size_t)mt * 256;
    const bf16_t* Aw; const bf16_t* Bact; int K = 1024;
    if (mode == GM_IN) { Aw = (const bf16_t*)(ws + OFF_W) + (size_t)wt * 256 * 1024; Bact = (const bf16_t*)(ws + OFF_H) + tok0 * 1024; }
    else if (mode == GM_OUT) { Aw = (const bf16_t*)(ws + OFF_W + W_O) + (size_t)wt * 256 * 1024; Bact = (const bf16_t*)(ws + OFF_QKV) + tok0 * 1024; }
    else if (mode == GM_MLP1) { Aw = (const bf16_t*)(ws + OFF_W + W_1) + (size_t)wt * 256 * 1024; Bact = (const bf16_t*)(ws + OFF_H) + tok0 * 1024; }
    else if (mode == GM_MLP2) { K = 4096; Aw = (const bf16_t*)(ws + OFF_W + W_2) + (size_t)wt * 256 * 4096; Bact = (const bf16_t*)(ws + OFF_Z) + tok0 * 4096; }
    else {
        const int k = step >> 1;
        if ((step & 1) == 0) { Aw = (const bf16_t*)(ws + OFF_W + W_G) + ((size_t)k * 1024 + (size_t)wt * 256) * 1024; Bact = (const bf16_t*)(ws + OFF_XBC) + tok0 * 1024; }
        else if (k == 0) { Aw = (const bf16_t*)(ws + OFF_W + W_SO) + (size_t)wt * 256 * 1024; Bact = (const bf16_t*)(ws + OFF_Z) + tok0 * 1024; }
        else if (k == 1) { K = 512; Aw = (const bf16_t*)(ws + OFF_W + W_RO) + (size_t)wt * 256 * 512; Bact = (const bf16_t*)(ws + OFF_G) + tok0 * 512; }
        else { K = 512; Aw = (const bf16_t*)(ws + OFF_W + W_WO) + (size_t)wt * 256 * 512; Bact = (const bf16_t*)(ws + OFF_PRW) + tok0 * 512; }
    }
    u.A = (const char*)Bact; u.B = (const char*)Aw; u.K = K; u.wt = wt; u.mt = mt; u.step = step;
    return true;
}

__device__ __forceinline__ void gemm_epilogue(unsigned char* ws, int mode, const UnitInfo& u, const f32x4 (&acc)[2][2][4][2], int wr, int wc, int fr, int fq, int tidx) {
    const size_t tok0 = (size_t)u.mt * 256; const int wt = u.wt, step = u.step;
    if (mode == GM_MERGE) {
        u32x4* sp = (u32x4*)(ws + OFF_RW + MSCR_S) + ((size_t)blockIdx.x * 8 * 512 + tidx) * 2;
        f32x4* mp = (f32x4*)(ws + OFF_RW + MSCR_M) + ((size_t)blockIdx.x * 8 * 512 + tidx) * 4;
        bf16_t* MG = (bf16_t*)(ws + OFF_QKV);
#pragma unroll
        for (int ai = 0; ai < 2; ++ai)
#pragma unroll
            for (int bj = 0; bj < 2; ++bj)
#pragma unroll
                for (int mh = 0; mh < 2; ++mh) {
                    if ((step & 1) == 0) {
                        unsigned o[8];
#pragma unroll
                        for (int k = 0; k < 4; ++k) {
                            const f32x4 v = acc[ai][bj][mh * 2 + (k >> 1)][k & 1];
                            o[2 * k] = pk2(sigmoidf_(v.x), sigmoidf_(v.y)); o[2 * k + 1] = pk2(sigmoidf_(v.z), sigmoidf_(v.w));
                        }
                        sp[0] = (u32x4){o[0], o[1], o[2], o[3]}; sp[1] = (u32x4){o[4], o[5], o[6], o[7]};
                    } else {
                        const u32x4 sa_ = sp[0], sb_ = sp[1];
                        const unsigned s8[8] = {sa_.x, sa_.y, sa_.z, sa_.w, sb_.x, sb_.y, sb_.z, sb_.w};
                        f32x4 m4[4];
                        if (step > 1) {
#pragma unroll
                            for (int k = 0; k < 4; ++k) m4[k] = mp[k];
                        }
#pragma unroll
                        for (int k = 0; k < 4; ++k) {
                            const int m = mh * 2 + (k >> 1), n = k & 1;
                            const f32x4 v = acc[ai][bj][m][n];
                            f32x4 mm = (f32x4){bflo(s8[2 * k]) * v.x, bfhi(s8[2 * k]) * v.y, bflo(s8[2 * k + 1]) * v.z, bfhi(s8[2 * k + 1]) * v.w};
                            if (step > 1) mm += m4[k];
                            if (step < 5) mp[k] = mm;
                            else {
                                const size_t tok = tok0 + ai * 128 + wr * 64 + m * 16 + fr;
                                const int feat = wt * 256 + bj * 128 + wc * 32 + fq * 8 + n * 4;
                                u32x2 o; o.x = pk2(mm.x, mm.y); o.y = pk2(mm.z, mm.w);
                                *(u32x2*)(MG + tok * 1024 + feat) = o;
                            }
                        }
                    }
                    sp += 512 * 2; mp += 512 * 4;
                    asm volatile("" : "+v"(sp), "+v"(mp) :: "memory");
                }
    } else if (mode == GM_IN && wt == 23) {
        float* DT = (float*)(ws + OFF_DT);
        if (wc == 0) {
#pragma unroll
            for (int ai = 0; ai < 2; ++ai)
#pragma unroll
                for (int m = 0; m < 4; ++m)
#pragma unroll
                    for (int n = 0; n < 2; ++n) {
                        const size_t tok = tok0 + ai * 128 + wr * 64 + m * 16 + fr;
                        *(f32x4*)(DT + tok * 32 + fq * 8 + n * 4) = acc[ai][0][m][n];
                    }
        }
    } else {
        bf16_t* base; int ld, col0;
        if (mode == GM_IN) {
            if (wt < 4) { base = (bf16_t*)(ws + OFF_Z); ld = 1024; col0 = wt * 256; }
            else if (wt < 10) { base = (bf16_t*)(ws + OFF_XBC); ld = 1536; col0 = (wt - 4) * 256; }
            else if (wt < 14) { base = (bf16_t*)(ws + OFF_QKV); ld = 1024; col0 = (wt - 10) * 256; }
            else if (wt < 16) { base = (bf16_t*)(ws + OFF_G); ld = 512; col0 = (wt - 14) * 256; }
            else { base = (bf16_t*)(ws + OFF_RW); ld = 1792; col0 = (wt - 16) * 256; }
        } else if (mode == GM_MLP1) { base = (bf16_t*)(ws + OFF_Z); ld = 4096; col0 = wt * 256; }
        else { base = (bf16_t*)(ws + OFF_H); ld = 1024; col0 = wt * 256; }
        const bool relu2 = (mode == GM_MLP1);
#pragma unroll
        for (int ai = 0; ai < 2; ++ai)
#pragma unroll
            for (int m = 0; m < 4; ++m) {
                const size_t tok = tok0 + ai * 128 + wr * 64 + m * 16 + fr;
                bf16_t* rowp = base + tok * ld + col0 + wc * 32 + fq * 8;
#pragma unroll
                for (int bj = 0; bj < 2; ++bj) {
                    f32x4 v = acc[ai][bj][m][0], w = acc[ai][bj][m][1];
                    if (relu2) { v.x = v.x > 0.f ? v.x * v.x : 0.f; v.y = v.y > 0.f ? v.y * v.y : 0.f; v.z = v.z > 0.f ? v.z * v.z : 0.f; v.w = v.w > 0.f ? v.w * v.w : 0.f;
                                 w.x = w.x > 0.f ? w.x * w.x : 0.f; w.y = w.y > 0.f ? w.y * w.y : 0.f; w.z = w.z > 0.f ? w.z * w.z : 0.f; w.w = w.w > 0.f ? w.w * w.w : 0.f; }
                    u32x4 o; o.x = pk2(v.x, v.y); o.y = pk2(v.z, v.w); o.z = pk2(w.x, w.y); o.w = pk2(w.z, w.w);
                    *(u32x4*)(rowp + bj * 128) = o;
                }
            }
    }
}

__device__ __forceinline__ void gemm_phase(CParams& p_in, const int mode, const int n_mt, LAS unsigned char* lds) {
    CParams* pq_ = &p_in; asm volatile("" : "+s"(pq_)); CParams& p = *pq_;
    const int tid = opaque_tid(), wid = __builtin_amdgcn_readfirstlane(tid >> 6), lane = tid & 63, wr = wid >> 2, wc = wid & 3, fr = lane & 15, fq = lane >> 4;
    unsigned char* ws = p.ws;
    int n_wt, nsteps = 1;
    if (mode == GM_IN) n_wt = 24; else if (mode == GM_MLP1) n_wt = 16; else n_wt = 4;
    if (mode == GM_MERGE) nsteps = 6;
    unsigned vR[2], vC[2];
#pragma unroll
    for (int i = 0; i < 2; ++i) { int Rr, Cc; stage_rc(tid * 16 + i * 8192, Rr, Cc); vR[i] = (unsigned)Rr * 2u; vC[i] = (unsigned)Cc * 2u; }
    const size_t kstep = (size_t)(BK * 2);
    const unsigned ldsw = (unsigned)wid * 1024u;
    const int aoff = lds_byte(wr * 64 + fr, fq * 8), boff = lds_byte(wc * 32 + fr, fq * 8);
#define PG8_SA(b, h) (((b) * 2 + (h)) * HTB)
#define PG8_SB(b, h) ((4 + (b) * 2 + (h)) * HTB)
#define PG8_STAGE(bufoff, gbase, v0, v1) do { \
        __builtin_amdgcn_global_load_lds((const unsigned*)((const char*)(gbase) + (v0)), (LAS unsigned*)(lds + (bufoff) + ldsw), 16, 0, 0); \
        __builtin_amdgcn_global_load_lds((const unsigned*)((const char*)(gbase) + (v1)), (LAS unsigned*)(lds + (bufoff) + ldsw + 8192), 16, 0, 0); } while (0)
#define PG8_LDA(dst, b, h) do { _Pragma("unroll") for (int m = 0; m < 4; ++m) _Pragma("unroll") for (int k = 0; k < 2; ++k) dst[m][k] = *(const LAS bf16x8*)(lds + PG8_SA(b, h) + aoff + m * 2048 + k * 1024); } while (0)
#define PG8_LDB(dst, b, h) do { _Pragma("unroll") for (int n = 0; n < 2; ++n) _Pragma("unroll") for (int k = 0; k < 2; ++k) dst[n][k] = *(const LAS bf16x8*)(lds + PG8_SB(b, h) + boff + n * 2048 + k * 1024); } while (0)
#define PG8_MMA(ai, bj, At, Bt) do { __builtin_amdgcn_s_setprio(1); _Pragma("unroll") for (int m = 0; m < 4; ++m) _Pragma("unroll") for (int n = 0; n < 2; ++n) _Pragma("unroll") for (int k = 0; k < 2; ++k) \
        acc[ai][bj][m][n] = __builtin_amdgcn_mfma_f32_16x16x32_bf16(Bt[n][k], At[m][k], acc[ai][bj][m][n], 0, 0, 0); __builtin_amdgcn_s_setprio(0); } while (0)
#define PG8_WAIT_V(n) asm volatile("s_waitcnt vmcnt(" #n ")" ::: "memory")
#define PG8_WAIT_L(n) asm volatile("s_waitcnt lgkmcnt(" #n ")" ::: "memory")
#define PG8_BAR __builtin_amdgcn_s_barrier()
#define PG8_SCHED __builtin_amdgcn_sched_barrier(0)
    UnitInfo cur, nxt; int ui = 0;
    if (!get_unit(ws, mode, n_mt, n_wt, nsteps, 0, cur)) return;
    f32x4 acc[2][2][4][2];
#pragma unroll
    for (int a = 0; a < 2; ++a)
#pragma unroll
        for (int b = 0; b < 2; ++b)
#pragma unroll
            for (int m = 0; m < 4; ++m)
#pragma unroll
                for (int n = 0; n < 2; ++n) acc[a][b][m][n] = (f32x4){0.f, 0.f, 0.f, 0.f};
    bf16x8 At[4][2], B0[2][2], B1[2][2];
    const char* cA = cur.A; const char* cB = cur.B;
    unsigned vc0 = vR[0] * (unsigned)cur.K + vC[0], vc1 = vR[1] * (unsigned)cur.K + vC[1];
    size_t hstep = (size_t)HALF * cur.K * 2;
    PG8_STAGE(PG8_SB(0, 0), cB, vc0, vc1); PG8_STAGE(PG8_SA(0, 0), cA, vc0, vc1); PG8_STAGE(PG8_SB(0, 1), cB + hstep, vc0, vc1); PG8_STAGE(PG8_SA(0, 1), cA + hstep, vc0, vc1);
    if (wr == 1) PG8_BAR;
    PG8_WAIT_V(4); PG8_BAR;
    PG8_STAGE(PG8_SB(1, 0), cB + kstep, vc0, vc1); PG8_STAGE(PG8_SA(1, 0), cA + kstep, vc0, vc1); PG8_STAGE(PG8_SB(1, 1), cB + hstep + kstep, vc0, vc1);
    PG8_WAIT_V(6); PG8_BAR;
    for (;;) {
        const bool has_next = get_unit(ws, mode, n_mt, n_wt, nsteps, ui + 1, nxt);
        const char* nA = has_next ? nxt.A : cA; const char* nB = has_next ? nxt.B : cB;
        const int Kn = has_next ? nxt.K : cur.K;
        const unsigned vn0 = vR[0] * (unsigned)Kn + vC[0], vn1 = vR[1] * (unsigned)Kn + vC[1];
        const size_t hstepn = (size_t)HALF * Kn * 2;
        const int nt = cur.K / BK;
        for (int t = 0; t < nt; t += 2) {
            const bool last = (t == nt - 2);
            const char* a1 = cA + (size_t)(t + 1) * kstep;
            const char* a2 = last ? nA : cA + (size_t)(t + 2) * kstep; const char* b2 = last ? nB : cB + (size_t)(t + 2) * kstep;
            const char* a3 = a2 + kstep; const char* b3 = b2 + kstep;
            const unsigned w0 = last ? vn0 : vc0, w1 = last ? vn1 : vc1;
            const size_t hs2 = last ? hstepn : hstep;
            PG8_LDB(B0, 0, 0); PG8_SCHED; PG8_LDA(At, 0, 0); PG8_STAGE(PG8_SA(1, 1), a1 + hstep, vc0, vc1);
            PG8_WAIT_L(8); PG8_BAR; PG8_WAIT_L(0); PG8_MMA(0, 0, At, B0); PG8_BAR; PG8_SCHED;
            PG8_LDB(B1, 0, 1); PG8_STAGE(PG8_SB(0, 0), b2, w0, w1);
            PG8_BAR; PG8_WAIT_L(0); PG8_MMA(0, 1, At, B1); PG8_BAR;
            PG8_LDA(At, 0, 1); PG8_STAGE(PG8_SA(0, 0), a2, w0, w1);
            PG8_BAR; PG8_WAIT_L(0); PG8_MMA(1, 0, At, B0); PG8_BAR; PG8_SCHED;
            PG8_STAGE(PG8_SB(0, 1), b2 + hs2, w0, w1);
            PG8_WAIT_V(6); PG8_BAR; PG8_MMA(1, 1, At, B1); PG8_BAR;
            PG8_LDB(B0, 1, 0); PG8_SCHED; PG8_LDA(At, 1, 0); PG8_STAGE(PG8_SA(0, 1), a2 + hs2, w0, w1);
            PG8_WAIT_L(8); PG8_BAR; PG8_WAIT_L(0); PG8_MMA(0, 0, At, B0); PG8_BAR; PG8_SCHED;
            PG8_LDB(B1, 1, 1); PG8_STAGE(PG8_SB(1, 0), b3, w0, w1);
            PG8_BAR; PG8_WAIT_L(0); PG8_MMA(0, 1, At, B1); PG8_BAR;
            PG8_LDA(At, 1, 1); PG8_STAGE(PG8_SA(1, 0), a3, w0, w1);
            PG8_BAR; PG8_WAIT_L(0); PG8_MMA(1, 0, At, B0); PG8_BAR; PG8_SCHED;
            PG8_STAGE(PG8_SB(1, 1), b3 + hs2, w0, w1);
            PG8_WAIT_V(6); PG8_BAR; PG8_MMA(1, 1, At, B1); PG8_BAR;
        }
        gemm_epilogue(ws, mode, cur, acc, wr, wc, fr, fq, tid);
        if (!has_next) break;
#pragma unroll
        for (int a = 0; a < 2; ++a)
#pragma unroll
            for (int b = 0; b < 2; ++b)
#pragma unroll
                for (int m = 0; m < 4; ++m)
#pragma unroll
                    for (int n = 0; n < 2; ++n) acc[a][b][m][n] = (f32x4){0.f, 0.f, 0.f, 0.f};
        cur = nxt; cA = nA; cB = nB; vc0 = vn0; vc1 = vn1; hstep = hstepn; ++ui;
    }
    PG8_WAIT_V(0);
    if (wr == 0) PG8_BAR;
    PG8_BAR;
}

__device__ __forceinline__ void phase_mod(CParams& p_in, unsigned char* smem) {
    CParams* pq_ = &p_in; asm volatile("" : "+s"(pq_)); CParams& p = *pq_;
    const int tidx = opaque_tid();
    float* sc = (float*)smem;
    float* red = sc + 5 * 1024;
    for (int i = tidx; i < 5 * 1024; i += 512) { int r = i >> 10, k = i & 1023; float v = r < 4 ? p.in[1][r * 1024 + k] : p.in[3][k]; sc[i] = siluf_(v); }
    __syncthreads();
    float* MOD = (float*)(p.ws + OFF_MOD);
    const int col = tidx & 63, kp = tidx >> 6;
    for (int item = blockIdx.x; item < 4 * 96; item += gridDim.x) {
        const int l = item / 96, n0 = (item % 96) * 64;
        const float* W = p.in[5] + (size_t)l * 1024 * 6144 + n0 + col;
        float a0 = 0.f, a1 = 0.f, a2 = 0.f, a3 = 0.f, a4 = 0.f;
        for (int k0 = kp * 128; k0 < kp * 128 + 128; k0 += 16) {
            float w[16];
#pragma unroll
            for (int j = 0; j < 16; ++j) w[j] = W[(size_t)(k0 + j) * 6144];
#pragma unroll
            for (int j = 0; j < 16; ++j) { const int k = k0 + j; a0 += sc[k] * w[j]; a1 += sc[1024 + k] * w[j]; a2 += sc[2048 + k] * w[j]; a3 += sc[3072 + k] * w[j]; a4 += sc[4096 + k] * w[j]; }
        }
        red[(kp * 5 + 0) * 64 + col] = a0; red[(kp * 5 + 1) * 64 + col] = a1; red[(kp * 5 + 2) * 64 + col] = a2;
        red[(kp * 5 + 3) * 64 + col] = a3; red[(kp * 5 + 4) * 64 + col] = a4;
        __syncthreads();
        if (tidx < 320) {
            const int r = tidx >> 6; float s = 0.f;
            for (int q = 0; q < 8; ++q) s += red[(q * 5 + r) * 64 + col];
            MOD[(size_t)(l * 5 + r) * 6144 + n0 + col] = s + p.in[6][l * 6144 + n0 + col];
        }
        __syncthreads();
    }
}

__device__ __forceinline__ void cvt_job(const float* W, int ldw, int col0, int ncols, int K, bf16_t* WT, int row0, unsigned char* smem, int cb, int cn) {
    const int tidx = opaque_tid();
    const int wave = tidx >> 6, lane = tidx & 63;
    float* scr = (float*)smem + wave * (64 * 33);
    const int nblk = ncols / 32, nitems = (K / 64) * nblk;
    for (int base = cb * 8; base < nitems; base += cn * 8) {
        const int it = base + wave; const bool valid = it < nitems;
        const int kb = valid ? it / nblk : 0, nb = valid ? it % nblk : 0, k0 = kb * 64, n0 = nb * 32;
        if (valid) {
#pragma unroll 8
            for (int i = 0; i < 32; ++i) { const int kk = 2 * i + (lane >> 5); scr[kk * 33 + (lane & 31)] = W[(size_t)(k0 + kk) * ldw + col0 + n0 + (lane & 31)]; }
        }
        __syncthreads();
        if (valid) {
            const int c = lane & 7;
#pragma unroll
            for (int j = 0; j < 4; ++j) {
                const int n = (lane >> 3) + 8 * j; const float* s = scr + (8 * c) * 33 + n;
                u32x4 o; o.x = pk2(s[0], s[33]); o.y = pk2(s[66], s[99]); o.z = pk2(s[132], s[165]); o.w = pk2(s[198], s[231]);
                const int rho = ((n >> 2) & 1) * 16 + (n >> 3) * 4 + (n & 3);
                *(u32x4*)(WT + (size_t)(row0 + n0 + rho) * K + k0 + 8 * c) = o;
            }
        }
        __syncthreads();
    }
}
__device__ __forceinline__ void cvt_win(CParams& p_in, int l_in, unsigned char* smem, int cb, int cn) {
    CParams* pq_ = &p_in; asm volatile("" : "+s"(pq_)); CParams& p = *pq_;
    int l = l_in; asm volatile("" : "+s"(l));
    const float* W = p.in[7] + (size_t)l * 1024 * 8992; bf16_t* WB = (bf16_t*)(p.ws + OFF_W);
    cvt_job(W, 8992, 3072, 2560, 1024, WB, 0, smem, cb, cn);
    cvt_job(W, 8992, 5664, 3328, 1024, WB, 2560, smem, cb, cn);
    cvt_job(W, 8992, 5632, 256, 1024, WB, 5888, smem, cb, cn);
}
__device__ __forceinline__ void cvt_mix(CParams& p_in, int l_in, unsigned char* smem, int cb, int cn) {
    CParams* pq_ = &p_in; asm volatile("" : "+s"(pq_)); CParams& p = *pq_;
    int l = l_in; asm volatile("" : "+s"(l));
    cvt_job(p.in[7] + (size_t)l * 1024 * 8992, 8992, 0, 3072, 1024, (bf16_t*)(p.ws + OFF_W + W_G), 0, smem, cb, cn);
    cvt_job(p.in[26] + (size_t)l * 1024 * 1024, 1024, 0, 1024, 1024, (bf16_t*)(p.ws + OFF_W + W_SO), 0, smem, cb, cn);
    cvt_job(p.in[27] + (size_t)l * 512 * 1024, 1024, 0, 1024, 512, (bf16_t*)(p.ws + OFF_W + W_RO), 0, smem, cb, cn);
    cvt_job(p.in[28] + (size_t)l * 512 * 1024, 1024, 0, 1024, 512, (bf16_t*)(p.ws + OFF_W + W_WO), 0, smem, cb, cn);
    cvt_job(p.in[29] + (size_t)l * 1024 * 1024, 1024, 0, 1024, 1024, (bf16_t*)(p.ws + OFF_W + W_O), 0, smem, cb, cn);
}
__device__ __forceinline__ void cvt_mlp(CParams& p_in, int l_in, unsigned char* smem, int cb, int cn) {
    CParams* pq_ = &p_in; asm volatile("" : "+s"(pq_)); CParams& p = *pq_;
    int l = l_in; asm volatile("" : "+s"(l));
    cvt_job(p.in[30] + (size_t)l * 1024 * 4096, 4096, 0, 4096, 1024, (bf16_t*)(p.ws + OFF_W + W_1), 0, smem, cb, cn);
    cvt_job(p.in[31] + (size_t)l * 4096 * 1024, 1024, 0, 1024, 4096, (bf16_t*)(p.ws + OFF_W + W_2), 0, smem, cb, cn);
}

__device__ __forceinline__ void row_pass(const float* xrow, const bf16_t* yrow, const float* gate, const float* nwA, float* xout,
                                         bool do_h, const float* nwB, const float* sh, const float* sc, bf16_t* hrow, int lane) {
    f32x4 x[4];
#pragma unroll
    for (int j = 0; j < 4; ++j) x[j] = *(const f32x4*)(xrow + j * 256 + lane * 4);
    if (yrow) {
        f32x4 y[4]; float ss = 0.f;
#pragma unroll
        for (int j = 0; j < 4; ++j) {
            const u32x2 raw = *(const u32x2*)(yrow + j * 256 + lane * 4);
            y[j] = (f32x4){bflo(raw.x), bfhi(raw.x), bflo(raw.y), bfhi(raw.y)};
            ss += y[j].x * y[j].x + y[j].y * y[j].y + y[j].z * y[j].z + y[j].w * y[j].w;
        }
        ss = wave_sum(ss);
        const float rs = rsqrtf(ss * (1.f / 1024.f) + 1e-6f);
#pragma unroll
        for (int j = 0; j < 4; ++j) {
            const f32x4 g = *(const f32x4*)(gate + j * 256 + lane * 4), w = *(const f32x4*)(nwA + j * 256 + lane * 4);
            x[j] += g * (y[j] * rs * w);
        }
    }
    if (xout) {
#pragma unroll
        for (int j = 0; j < 4; ++j) *(f32x4*)(xout + j * 256 + lane * 4) = x[j];
    }
    if (do_h) {
        float ss = 0.f;
#pragma unroll
        for (int j = 0; j < 4; ++j) ss += x[j].x * x[j].x + x[j].y * x[j].y + x[j].z * x[j].z + x[j].w * x[j].w;
        ss = wave_sum(ss);
        const float rs = rsqrtf(ss * (1.f / 1024.f) + 1e-6f);
#pragma unroll
        for (int j = 0; j < 4; ++j) {
            const f32x4 w = *(const f32x4*)(nwB + j * 256 + lane * 4), s = *(const f32x4*)(sh + j * 256 + lane * 4), c = *(const f32x4*)(sc + j * 256 + lane * 4);
            const f32x4 h = (x[j] * rs * w) * (c + 1.f) + s;
            u32x2 o; o.x = pk2(h.x, h.y); o.y = pk2(h.z, h.w);
            *(u32x2*)(hrow + j * 256 + lane * 4) = o;
        }
    }
}

__device__ __forceinline__ void token_phase(CParams& p_in, int l_in, int kind, int nrows) {
    CParams* pq_ = &p_in; asm volatile("" : "+s"(pq_)); CParams& p = *pq_;
    int l = l_in; asm volatile("" : "+s"(l));
    const int tidx = opaque_tid();
    const int lane = tidx & 63, gw = blockIdx.x * 8 + (tidx >> 6), ngw = gridDim.x * 8;
    const float* MOD = (const float*)(p.ws + OFF_MOD);
    const float* NW = p.in[4];
    bf16_t* H = (bf16_t*)(p.ws + OFF_H);
    float* CTXS = (float*)(p.ws + OFF_CTXS);
    for (int row = gw; row < nrows; row += ngw) {
        const bool lat = row < RL; const int mi = lat ? (row >> 13) : 4;
        const float* xin; float* xout = nullptr;
        const bool from_input = (l == 0 && kind <= 1);
        if (lat) xin = from_input ? p.in[0] + (size_t)row * 1024 : p.out + (size_t)row * 1024;
        else xin = from_input ? p.in[2] + (size_t)(row - RL) * 1024 : CTXS + (size_t)(row - RL) * 1024;
        if (kind > 0) xout = lat ? p.out + (size_t)row * 1024 : CTXS + (size_t)(row - RL) * 1024;
        const float* modl = MOD + (size_t)(l * 5 + mi) * 6144;
        bf16_t* hrow = H + (size_t)row * 1024;
        if (kind == 0) row_pass(xin, nullptr, nullptr, nullptr, nullptr, true, NW + (l * 4 + 0) * 1024, modl, modl + 1024, hrow, lane);
        else if (kind == 1) row_pass(xin, hrow, modl + 2048, NW + (l * 4 + 1) * 1024, xout, true, NW + (l * 4 + 2) * 1024, modl + 3072, modl + 4096, hrow, lane);
        else {
            const bool nxt = l < 3; const float* modn = MOD + (size_t)((l + 1) * 5 + mi) * 6144;
            row_pass(xin, hrow, modl + 5120, NW + (l * 4 + 3) * 1024, xout, nxt, NW + ((l + 1) * 4 + 0) * 1024, modn, modn + 1024, hrow, lane);
        }
    }
}

template <int NQ, int PB>
__device__ __forceinline__ void lin_steps(float (&S)[16], const float* qL, const float* kL, const float* vL, const float* dtL, const float* decL, float* yL, int dir, int nq, int pl) {
    constexpr int N = NQ * 16;
    for (int j = 0; j < 32; ++j) {
        const int tt = dir ? 31 - j : j;
        const float xdt = vL[tt * PB + pl] * dtL[tt];
        const float dec = decL[tt];
        const f32x4* kp = (const f32x4*)(kL + tt * N + nq * 16);
        const f32x4* qp = (const f32x4*)(qL + tt * N + nq * 16);
        float part = 0.f;
#pragma unroll
        for (int q4 = 0; q4 < 4; ++q4) {
            const f32x4 kv = kp[q4], qv = qp[q4];
            S[q4 * 4 + 0] = dec * S[q4 * 4 + 0] + kv.x * xdt; part += qv.x * S[q4 * 4 + 0];
            S[q4 * 4 + 1] = dec * S[q4 * 4 + 1] + kv.y * xdt; part += qv.y * S[q4 * 4 + 1];
            S[q4 * 4 + 2] = dec * S[q4 * 4 + 2] + kv.z * xdt; part += qv.z * S[q4 * 4 + 2];
            S[q4 * 4 + 3] = dec * S[q4 * 4 + 3] + kv.w * xdt; part += qv.w * S[q4 * 4 + 3];
        }
        part = (NQ == 8) ? red8(part) : red4(part);
        if (nq == 0) yL[tt * PB + pl] = part;
    }
}

__device__ __forceinline__ void scan_tile(int b, int dir, int tau, int& low, int& s0, int& s1, bool& isctx, bool& first) {
    int ti, nt;
    isctx = tau < 8;
    if (isctx) { ti = dir ? 7 - tau : tau; s0 = RL + b * 256; s1 = s0 + 256; nt = 8; }
    else { ti = dir ? 255 - (tau - 8) : tau - 8; s0 = b * 8192; s1 = s0 + 8192; nt = 256; }
    low = s0 + ti * 32;
    first = (dir == 0) == (ti < nt / 2);
}

template <int NK> struct CsL {
    static constexpr int SN = NK + 8, SS = 40;
    static constexpr int O_CN = 0, O_BN = O_CN + 32 * SN * 2, O_BWT = O_BN + 32 * SN * 2, O_XT = O_BWT + NK * SS * 2, O_PM = O_XT + 64 * SS * 2,
                         O_ST = O_PM + 32 * SS * 2, O_F = O_ST + 64 * SN * 2, O_Y = O_F + 544, O_RAW = (NK == 128) ? O_Y : O_Y + 8192;
};
template <int NK>
__device__ __forceinline__ void cs_core(unsigned char* base, f32x4 (&accS)[NK / 16], int dir, int w, int fr, int fq) {
    typedef CsL<NK> L;
    constexpr int SN = L::SN, SS = L::SS, KC = NK / 32, NT = NK / 16;
    bf16_t* Cn = (bf16_t*)(base + L::O_CN); bf16_t* Bn = (bf16_t*)(base + L::O_BN); bf16_t* BwT = (bf16_t*)(base + L::O_BWT);
    bf16_t* XT = (bf16_t*)(base + L::O_XT); bf16_t* Pm = (bf16_t*)(base + L::O_PM); bf16_t* ST = (bf16_t*)(base + L::O_ST);
    float* cumL = (float*)(base + L::O_F); float* dtL = cumL + 32; float* eL = dtL + 32; float* totL = eL + 64;
    float* yL = (float*)(base + ((NK == 128) ? L::O_BN : L::O_Y));
    f32x4 acc4[2];
    {
        const int mt = w >> 1, nt = w & 1;
        f32x4 g = (f32x4){0.f, 0.f, 0.f, 0.f};
#pragma unroll
        for (int kc = 0; kc < KC; ++kc) {
            const bf16x8 A = *(const bf16x8*)(Cn + (mt * 16 + fr) * SN + kc * 32 + fq * 8);
            const bf16x8 Bf = *(const bf16x8*)(Bn + (nt * 16 + fr) * SN + kc * 32 + fq * 8);
            g = __builtin_amdgcn_mfma_f32_16x16x32_bf16(A, Bf, g, 0, 0, 0);
        }
        const int s = nt * 16 + fr; const float cs = cumL[s], ds = dtL[s];
#pragma unroll
        for (int r = 0; r < 4; ++r) {
            const int t = mt * 16 + fq * 4 + r;
            const bool ok = dir ? (s >= t) : (s <= t);
            const float val = ok ? g[r] * __expf(cumL[t] - cs) * ds : 0.f;
            Pm[t * SS + s] = f2bf(val);
        }
#pragma unroll
        for (int mt2 = 0; mt2 < 2; ++mt2) {
            acc4[mt2] = (f32x4){0.f, 0.f, 0.f, 0.f};
#pragma unroll
            for (int kc = 0; kc < KC; ++kc) {
                const bf16x8 A = *(const bf16x8*)(Cn + (mt2 * 16 + fr) * SN + kc * 32 + fq * 8);
                const bf16x8 Bf = *(const bf16x8*)(ST + (w * 16 + fr) * SN + kc * 32 + fq * 8);
                acc4[mt2] = __builtin_amdgcn_mfma_f32_16x16x32_bf16(A, Bf, acc4[mt2], 0, 0, 0);
            }
        }
    }
    __syncthreads();
    {
        const bf16x8 Xf = *(const bf16x8*)(XT + (w * 16 + fr) * SS + fq * 8);
#pragma unroll
        for (int mt2 = 0; mt2 < 2; ++mt2) {
            const bf16x8 A = *(const bf16x8*)(Pm + (mt2 * 16 + fr) * SS + fq * 8);
            f32x4 a3 = (f32x4){0.f, 0.f, 0.f, 0.f};
            a3 = __builtin_amdgcn_mfma_f32_16x16x32_bf16(A, Xf, a3, 0, 0, 0);
#pragma unroll
            for (int r = 0; r < 4; ++r) { const int t = mt2 * 16 + fq * 4 + r; yL[t * 64 + w * 16 + fr] = a3[r] + eL[t] * acc4[mt2][r]; }
        }
        const float dtot = __expf(totL[0]);
#pragma unroll
        for (int n8 = 0; n8 < NT; ++n8) {
            const bf16x8 Bf = *(const bf16x8*)(BwT + (n8 * 16 + fr) * SS + fq * 8);
            accS[n8] = accS[n8] * dtot;
            accS[n8] = __builtin_amdgcn_mfma_f32_16x16x32_bf16(Xf, Bf, accS[n8], 0, 0, 0);
#pragma unroll
            for (int r = 0; r < 4; ++r) ST[(w * 16 + fq * 4 + r) * SN + n8 * 16 + fr] = f2bf(accS[n8][r]);
        }
    }
    __syncthreads();
}

template <int NK, bool DX>
__device__ __forceinline__ void cs_writeout(unsigned char* base, bf16_t* pp, u32x4 pv, int tl, float Dh) {
    typedef CsL<NK> L;
    const float* yL = (const float*)(base + ((NK == 128) ? L::O_BN : L::O_Y));
    const bf16_t* XT = (const bf16_t*)(base + L::O_XT);
    const int t = tl >> 3, pg = tl & 7;
    const f32x4 ya = *(const f32x4*)(yL + t * 64 + pg * 8), yb = *(const f32x4*)(yL + t * 64 + pg * 8 + 4);
    float y[8] = {ya.x, ya.y, ya.z, ya.w, yb.x, yb.y, yb.z, yb.w};
    const unsigned pa[4] = {pv.x, pv.y, pv.z, pv.w};
#pragma unroll
    for (int j = 0; j < 4; ++j) { y[2 * j] += bflo(pa[j]); y[2 * j + 1] += bfhi(pa[j]); }
    if (DX) {
#pragma unroll
        for (int j = 0; j < 8; ++j) y[j] += Dh * bf2f(XT[(pg * 8 + j) * L::SS + t]);
    }
    u32x4 o; o.x = pk2(y[0], y[1]); o.y = pk2(y[2], y[3]); o.z = pk2(y[4], y[5]); o.w = pk2(y[6], y[7]);
    *(u32x4*)pp = o;
}

__device__ __forceinline__ void ssd_scan_item(CParams& p_in, int l_in, int item, unsigned char* smem) {
    CParams* pq_ = &p_in; asm volatile("" : "+s"(pq_)); CParams& p = *pq_;
    int l = l_in; asm volatile("" : "+s"(l));
    const int tidx = opaque_tid();
    typedef CsL<128> L;
    constexpr int SN = L::SN, SS = L::SS;
    const int b = item >> 4, h = item & 15, g = h >> 3;
    const int tid = tidx, dir = tid >> 8, tl = tid & 255, lane = tid & 63, w = tl >> 6, fr = lane & 15, fq = lane >> 4;
    unsigned char* base = smem + dir * 76800;
    bf16_t* Cn = (bf16_t*)(base + L::O_CN); bf16_t* Bn = (bf16_t*)(base + L::O_BN); bf16_t* BwT = (bf16_t*)(base + L::O_BWT);
    bf16_t* XT = (bf16_t*)(base + L::O_XT); bf16_t* ST = (bf16_t*)(base + L::O_ST);
    float* cumL = (float*)(base + L::O_F); float* dtL = cumL + 32; float* eL = dtL + 32; float* wL = eL + 32; float* totL = eL + 64;
    bf16_t* rawL = (bf16_t*)(base + L::O_RAW);
    const bf16_t* XBC = (const bf16_t*)(p.ws + OFF_XBC);
    const float* DT = (const float*)(p.ws + OFF_DT);
    bf16_t* P = (bf16_t*)(p.ws + OFF_H);
    const float* cw = p.in[8] + (size_t)l * 5 * 1536; const float* cbias = p.in[9] + (size_t)l * 1536;
    const float dtb = p.in[10][l * 32 + dir * 16 + h];
    const float aneg = -__expf(p.in[11][l * 32 + dir * 16 + h]);
    const float Dh = p.in[12][l * 16 + h];
    const int xc1 = 1024 + g * 128 + (tl & 127) * 2;
    const int xc1c = ((tl & 127) < 64) ? xc1 : 1280 + g * 128 + ((tl & 127) - 64) * 2;
    const f32x2_t cw0 = {cw[xc1c], cw[xc1c + 1]}, cw1 = {cw[1536 + xc1c], cw[1536 + xc1c + 1]}, cw2 = {cw[2 * 1536 + xc1c], cw[2 * 1536 + xc1c + 1]},
                  cw3 = {cw[3 * 1536 + xc1c], cw[3 * 1536 + xc1c + 1]}, cw4 = {cw[4 * 1536 + xc1c], cw[4 * 1536 + xc1c + 1]}, cwb = {cbias[xc1c], cbias[xc1c + 1]};
    const int xc2 = h * 64 + (tl & 63);
    const float c20 = cw[xc2], c21 = cw[1536 + xc2], c22 = cw[2 * 1536 + xc2], c23 = cw[3 * 1536 + xc2], c24 = cw[4 * 1536 + xc2], c2b = cbias[xc2];
    for (int i = tl; i < 64 * SN; i += 256) ST[i] = 0;
    f32x4 accS[8];
#pragma unroll
    for (int i = 0; i < 8; ++i) accS[i] = (f32x4){0.f, 0.f, 0.f, 0.f};
    u32x4 rv[6]; float dtr = 0.f;
    int pf_rr[6], pf_off[6], pf_lds[6];
#pragma unroll
    for (int i = 0; i < 6; ++i) {
        const int e = tl + 256 * i; const int rr = e / 40, ch = e - rr * 40;
        const int xc = ch < 16 ? 1024 + g * 128 + ch * 8 : (ch < 32 ? 1280 + g * 128 + (ch - 16) * 8 : h * 64 + (ch - 32) * 8);
        pf_rr[i] = rr; pf_off[i] = rr * 1536 + xc; pf_lds[i] = (e < 36 * 40) ? rr * 320 + ch * 8 : -1;
    }
#define SSD_PREFETCH(tau_) do { int low_, s0_, s1_; bool ic_, fi_; scan_tile(b, dir, (tau_), low_, s0_, s1_, ic_, fi_); \
        const bf16_t* rb_ = XBC + (size_t)(low_ - 2) * 1536; \
        _Pragma("unroll") for (int i = 0; i < 6; ++i) { \
            const int row = low_ - 2 + pf_rr[i]; \
            rv[i] = (u32x4){0u, 0u, 0u, 0u}; \
            if (pf_lds[i] >= 0 && row >= s0_ && row < s1_) rv[i] = *(const u32x4*)(rb_ + pf_off[i]); } \
        if (tl < 32) dtr = DT[(size_t)(low_ + tl) * 32 + dir * 16 + h]; } while (0)
    SSD_PREFETCH(0);
    for (int tau = 0; tau < 264; ++tau) {
        int low, s0, s1; bool isctx, first;
        scan_tile(b, dir, tau, low, s0, s1, isctx, first);
#pragma unroll
        for (int i = 0; i < 6; ++i) { if (pf_lds[i] >= 0) *(u32x4*)(rawL + pf_lds[i]) = rv[i]; }
        if (tl < 64) {
            const float dt = fast_softplus(dtr + dtb);
            const float la = dt * aneg;
            float c = la;
#pragma unroll
            for (int o = 1; o < 32; o <<= 1) { const float v = __shfl_up(c, o); if (lane >= o) c += v; }
            const float total = __shfl(c, 31);
            const float cd = dir ? (total - c + la) : c;
            if (tl < 32) { cumL[tl] = cd; dtL[tl] = dt; eL[tl] = __expf(cd); wL[tl] = __expf(total - cd) * dt; if (tl == 0) totL[0] = total; }
        }
        bf16_t* pp = P + (size_t)(low + (tl >> 3)) * 1024 + h * 64 + (tl & 7) * 8;
        const bool late = (tau == 4) || (tau == 136);
        u32x4 pv = (u32x4){0u, 0u, 0u, 0u};
        if (!first && !late) pv = *(const u32x4*)pp;
        __syncthreads();
        {
            const bf16_t* __restrict__ rawR = rawL;
            {
                const int cp = tl & 127, th = tl >> 7, c0 = cp * 2, tb = th * 16;
                f32x2_t q0, q1, q2, q3;
                { const unsigned a = *(const unsigned*)(rawR + (tb) * 320 + c0), bq = *(const unsigned*)(rawR + (tb + 1) * 320 + c0), cq = *(const unsigned*)(rawR + (tb + 2) * 320 + c0), dq = *(const unsigned*)(rawR + (tb + 3) * 320 + c0);
                  q0 = (f32x2_t){bflo(a), bfhi(a)}; q1 = (f32x2_t){bflo(bq), bfhi(bq)}; q2 = (f32x2_t){bflo(cq), bfhi(cq)}; q3 = (f32x2_t){bflo(dq), bfhi(dq)}; }
#pragma unroll 8
                for (int j = 0; j < 16; ++j) {
                    const int t = tb + j;
                    const unsigned e = *(const unsigned*)(rawR + (t + 4) * 320 + c0);
                    const f32x2_t q4 = {bflo(e), bfhi(e)};
                    f32x2_t o = __builtin_elementwise_fma(cw4, q4, cwb);
                    o = __builtin_elementwise_fma(cw3, q3, o); o = __builtin_elementwise_fma(cw2, q2, o);
                    o = __builtin_elementwise_fma(cw1, q1, o); o = __builtin_elementwise_fma(cw0, q0, o);
                    o.x = siluf_(o.x); o.y = siluf_(o.y);
                    if (cp < 64) {
                        *(unsigned*)(Bn + t * SN + c0) = pk2(o.x, o.y);
                        const float wt = wL[t];
                        const unsigned bw = pk2(o.x * wt, o.y * wt);
                        BwT[c0 * SS + t] = (bf16_t)(bw & 0xffffu); BwT[(c0 + 1) * SS + t] = (bf16_t)(bw >> 16);
                    } else *(unsigned*)(Cn + t * SN + c0 - 128) = pk2(o.x, o.y);
                    q0 = q1; q1 = q2; q2 = q3; q3 = q4;
                }
            }
            const int xcol = 256 + (tl & 63), tq = tl >> 6;
            float q0 = bf2f(rawL[(tq * 8) * 320 + xcol]), q1 = bf2f(rawL[(tq * 8 + 1) * 320 + xcol]), q2 = bf2f(rawL[(tq * 8 + 2) * 320 + xcol]), q3 = bf2f(rawL[(tq * 8 + 3) * 320 + xcol]);
            unsigned xo[4];
#pragma unroll
            for (int j = 0; j < 8; ++j) {
                const float q4 = bf2f(rawL[(tq * 8 + j + 4) * 320 + xcol]);
                const float o = siluf_(c20 * q0 + c21 * q1 + c22 * q2 + c23 * q3 + c24 * q4 + c2b);
                if (j & 1) xo[j >> 1] |= ((unsigned)f2bf(o)) << 16; else xo[j >> 1] = f2bf(o);
                q0 = q1; q1 = q2; q2 = q3; q3 = q4;
            }
            *(u32x4*)(XT + (tl & 63) * SS + tq * 8) = (u32x4){xo[0], xo[1], xo[2], xo[3]};
        }
        __syncthreads();
        if (!first && late) pv = *(const u32x4*)pp;
        if (tau + 1 < 264) SSD_PREFETCH(tau + 1);
        cs_core<128>(base, accS, dir, w, fr, fq);
        cs_writeout<128, true>(base, pp, pv, tl, first ? 0.f : Dh);
    }
#undef SSD_PREFETCH
}

__device__ __forceinline__ void ret_scan_item(CParams& p_in, int l_in, int item, unsigned char* smem) {
    CParams* pq_ = &p_in; asm volatile("" : "+s"(pq_)); CParams& p = *pq_;
    int l = l_in; asm volatile("" : "+s"(l));
    const int tidx = opaque_tid();
    typedef CsL<64> L;
    constexpr int SN = L::SN, SS = L::SS;
    const int b = item >> 3, hd = (item >> 1) & 3, phalf = item & 1;
    const int tid = tidx, dir = tid >> 8, tl = tid & 255, lane = tid & 63, w = tl >> 6, fr = lane & 15, fq = lane >> 4;
    unsigned char* base = smem + dir * 76800;
    bf16_t* Cn = (bf16_t*)(base + L::O_CN); bf16_t* Bn = (bf16_t*)(base + L::O_BN); bf16_t* BwT = (bf16_t*)(base + L::O_BWT);
    bf16_t* XT = (bf16_t*)(base + L::O_XT); bf16_t* ST = (bf16_t*)(base + L::O_ST);
    float* cumL = (float*)(base + L::O_F); float* dtL = cumL + 32; float* eL = dtL + 32; float* wL = eL + 32; float* totL = eL + 64;
    bf16_t* rawL = (bf16_t*)(base + L::O_RAW);
    const bf16_t* QKV = (const bf16_t*)(p.ws + OFF_QKV);
    bf16_t* P = (bf16_t*)(p.ws + OFF_PRET);
    const float lg = -fast_softplus(-p.in[14][l * 8 + dir * 4 + hd]);
    if (tl < 32) {
        const float cd = dir ? (float)(32 - tl) * lg : (float)(tl + 1) * lg;
        const float total = 32.f * lg;
        cumL[tl] = cd; dtL[tl] = 1.f; eL[tl] = __expf(cd); wL[tl] = __expf(total - cd); if (tl == 0) totL[0] = total;
    }
    for (int i = tl; i < 64 * SN; i += 256) ST[i] = 0;
    f32x4 accS[4];
#pragma unroll
    for (int i = 0; i < 4; ++i) accS[i] = (f32x4){0.f, 0.f, 0.f, 0.f};
    const int pairidx = tl & 63, tq = tl >> 6, which = pairidx >> 5, pi = pairidx & 31;
    const float inv = exp2f(-(float)(pi & 15) * (13.287712379549449f / 16.f));
    u32x4 rv[3];
#define RET_PREFETCH(tau_) do { int low_, s0_, s1_; bool ic_, fi_; scan_tile(b, dir, (tau_), low_, s0_, s1_, ic_, fi_); \
        _Pragma("unroll") for (int i = 0; i < 3; ++i) { \
            const int e = tl + 256 * i; const int rr = e / 24, ch = e - rr * 24; \
            const int col = ch < 8 ? hd * 64 + ch * 8 : (ch < 16 ? 256 + hd * 64 + (ch - 8) * 8 : 512 + hd * 128 + phalf * 64 + (ch - 16) * 8); \
            rv[i] = *(const u32x4*)(QKV + (size_t)(low_ + rr) * 1024 + col); } } while (0)
    RET_PREFETCH(0);
    for (int tau = 0; tau < 264; ++tau) {
        int low, s0, s1; bool isctx, first;
        scan_tile(b, dir, tau, low, s0, s1, isctx, first);
#pragma unroll
        for (int i = 0; i < 3; ++i) { const int e = tl + 256 * i; const int rr = e / 24, ch = e - rr * 24; *(u32x4*)(rawL + rr * 192 + ch * 8) = rv[i]; }
        bf16_t* pp = P + (size_t)(low + (tl >> 3)) * 512 + hd * 128 + phalf * 64 + (tl & 7) * 8;
        const bool late = (tau == 4) || (tau == 136);
        u32x4 pv = (u32x4){0u, 0u, 0u, 0u};
        if (!first && !late) pv = *(const u32x4*)pp;
        __syncthreads();
        {
#pragma unroll
            for (int j = 0; j < 8; ++j) {
                const int t = tq * 8 + j;
                const unsigned raw = *(const unsigned*)(rawL + t * 192 + which * 64 + 2 * pi);
                const float x1 = bflo(raw), x2 = bfhi(raw);
                float c = 1.f, s = 0.f;
                if (!isctx) { const int pos = low + t - s0; const float ppos = (pi < 16) ? (float)(pos >> 6) : (float)(pos & 63); const float ang = ppos * inv; c = __cosf(ang); s = __sinf(ang); }
                const float o1 = x1 * c - x2 * s, o2 = x1 * s + x2 * c;
                if (which == 0) *(unsigned*)(Cn + t * SN + 2 * pi) = pk2(o1, o2);
                else {
                    const float k1 = o1 * 0.125f, k2 = o2 * 0.125f, wt = wL[t];
                    *(unsigned*)(Bn + t * SN + 2 * pi) = pk2(k1, k2);
                    BwT[(2 * pi) * SS + t] = f2bf(k1 * wt); BwT[(2 * pi + 1) * SS + t] = f2bf(k2 * wt);
                }
            }
            unsigned xo[4];
#pragma unroll
            for (int j = 0; j < 8; ++j) { const unsigned v = rawL[(tq * 8 + j) * 192 + 128 + pairidx]; if (j & 1) xo[j >> 1] |= v << 16; else xo[j >> 1] = v; }
            *(u32x4*)(XT + pairidx * SS + tq * 8) = (u32x4){xo[0], xo[1], xo[2], xo[3]};
        }
        __syncthreads();
        if (!first && late) pv = *(const u32x4*)pp;
        if (tau + 1 < 264) RET_PREFETCH(tau + 1);
        cs_core<64>(base, accS, dir, w, fr, fq);
        cs_writeout<64, false>(base, pp, pv, tl, 0.f);
    }
#undef RET_PREFETCH
}

__device__ __forceinline__ void shift_phase(CParams& p_in, int l_in, int part, unsigned char* smem) {
    CParams* pq_ = &p_in; asm volatile("" : "+s"(pq_)); CParams& p = *pq_;
    int l = l_in; asm volatile("" : "+s"(l));
    const int tidx = opaque_tid();
    bf16_t* RW = (bf16_t*)(p.ws + OFF_RW);
    u32x2* halo = (u32x2*)smem;
    const int c0 = tidx * 4;
    if (tidx >= 448) return;
    if (part == 0) {
        for (int k = 0; k < 5; ++k) {
            const int chunk = blockIdx.x + k * gridDim.x; if (chunk >= R / 32) break;
            const int lo = chunk * 32; int s0, s1;
            if (lo < RL) { s0 = lo & ~8191; s1 = s0 + 8192; } else { s0 = RL + ((lo - RL) & ~255); s1 = s0 + 256; }
            u32x2 a = (u32x2){0u, 0u}, b = (u32x2){0u, 0u};
            if (lo - 1 >= s0) a = *(const u32x2*)(RW + (size_t)(lo - 1) * 1792 + c0);
            if (lo + 32 < s1) b = *(const u32x2*)(RW + (size_t)(lo + 32) * 1792 + c0);
            halo[(k * 2 + 0) * 448 + tidx] = a; halo[(k * 2 + 1) * 448 + tidx] = b;
        }
        return;
    }
    const f32x4 mx = *(const f32x4*)(p.in[15] + (size_t)l * 1792 + c0);
    const int kind = (c0 >= 1536 && c0 < 1600) ? 1 : (c0 >= 1664 ? 2 : 0);
    for (int k = 0; k < 5; ++k) {
        const int chunk = blockIdx.x + k * gridDim.x; if (chunk >= R / 32) break;
        bf16_t* base = RW + (size_t)chunk * 32 * 1792 + c0;
        u32x2 rows[34];
        rows[0] = halo[(k * 2 + 0) * 448 + tidx]; rows[33] = halo[(k * 2 + 1) * 448 + tidx];
#pragma unroll
        for (int t = 0; t < 32; ++t) rows[t + 1] = *(const u32x2*)(base + (size_t)t * 1792);
#pragma unroll
        for (int t = 0; t < 32; ++t) {
            const u32x2 a = rows[t], b = rows[t + 1], c = rows[t + 2];
            f32x4 u0 = (f32x4){bflo(a.x), bfhi(a.x), bflo(a.y), bfhi(a.y)}, u1 = (f32x4){bflo(b.x), bfhi(b.x), bflo(b.y), bfhi(b.y)}, u2 = (f32x4){bflo(c.x), bfhi(c.x), bflo(c.y), bfhi(c.y)};
            f32x4 v = u1 + mx * ((u0 + u2) * 0.5f - u1);
            if (kind == 1) { v.x = fast_tanh(v.x); v.y = fast_tanh(v.y); v.z = fast_tanh(v.z); v.w = fast_tanh(v.w); }
            else if (kind == 2) { v.x = sigmoidf_(v.x); v.y = sigmoidf_(v.y); v.z = sigmoidf_(v.z); v.w = sigmoidf_(v.w); }
            u32x2 o; o.x = pk2(v.x, v.y); o.y = pk2(v.z, v.w);
            *(u32x2*)(base + (size_t)t * 1792) = o;
        }
    }
}

__device__ __forceinline__ void rwkv_scan_item(CParams& p_in, int l_in, int item, unsigned char* smem) {
    CParams* pq_ = &p_in; asm volatile("" : "+s"(pq_)); CParams& p = *pq_;
    int l = l_in; asm volatile("" : "+s"(l));
    const int tidx = opaque_tid();
    const int b = item >> 5, h = (item >> 2) & 7, rq = item & 3;
    const int tid = tidx, dir = tid >> 8, tl = tid & 255, lane = tid & 63, wv = tl >> 6;
    const int kq = lane & 15, rloc = wv * 4 + (lane >> 4);
    const int fr = lane & 15, fq = lane >> 4;
    unsigned char* base = smem + dir * 67072;
    float* rL = (float*)base;
    float *kL = rL + 2048, *wL = kL + 2048, *bL = wL + 2048, *nkL = bL + 2048, *vL = nkL + 2048, *yL = vL + 1024;
    float* kdL = (float*)(base + 58880);
    bf16_t* twB = (bf16_t*)(yL + 1024);
    bf16_t* aloB = twB + 2048;
    float* invn = (float*)(aloB + 2048);
    const bf16_t* RW = (const bf16_t*)(p.ws + OFF_RW);
    bf16_t* P = (bf16_t*)(p.ws + OFF_PRW);
    const int cch = h * 64 + wv * 16 + fr;
    bf16x8 Bw[2], Ba[2];
    {
        const float* w2g = p.in[17] + ((size_t)(l * 2 + dir) * 64) * 512 + cch;
        const float* a2g = p.in[19] + ((size_t)l * 64) * 512 + cch;
#pragma unroll
        for (int kc = 0; kc < 2; ++kc)
#pragma unroll
            for (int e = 0; e < 8; ++e) {
                const int j = kc * 32 + fq * 8 + e;
                Bw[kc][e] = (short)f2bf(w2g[(size_t)j * 512]); Ba[kc][e] = (short)f2bf(a2g[(size_t)j * 512]);
            }
    }
    const float w0c = p.in[16][(l * 2 + dir) * 512 + cch], a0c = p.in[18][(l * 2 + dir) * 512 + cch];
    const float kkc = p.in[21][l * 512 + cch], kac = p.in[22][l * 512 + cch];
    const int t2 = tl >> 3, part2 = tl & 7;
    f32x4 kk2a = *(const f32x4*)(p.in[21] + l * 512 + h * 64 + part2 * 8), kk2b = *(const f32x4*)(p.in[21] + l * 512 + h * 64 + part2 * 8 + 4);
    float S[4];
#pragma unroll
    for (int i = 0; i < 4; ++i) S[i] = 0.f;
    u32x4 rv[5];
    int pf_off[5], pf_dst[5], pf_mode[5];
#pragma unroll
    for (int i = 0; i < 5; ++i) {
        const int e = tl + 256 * i; const int rr = e / 34, ch = e - rr * 34;
        const int col = ch < 8 ? h * 64 + ch * 8 : (ch < 16 ? 512 + h * 64 + (ch - 8) * 8 : (ch < 32 ? 1536 + (ch - 16) * 8 : 1024 + h * 64 + rq * 16 + (ch - 32) * 8));
        pf_off[i] = rr * 1792 + col;
        int dst, mode;
        if (ch < 8) { dst = (int)((unsigned char*)(rL + rr * 64 + ch * 8) - base); mode = 0; }
        else if (ch < 16) { dst = (int)((unsigned char*)(kL + rr * 64 + (ch - 8) * 8) - base); mode = 0; }
        else if (ch < 24) { dst = (int)((unsigned char*)(twB + rr * 64 + (ch - 16) * 8) - base); mode = 1; }
        else if (ch < 32) { dst = (int)((unsigned char*)(aloB + rr * 64 + (ch - 24) * 8) - base); mode = 1; }
        else { dst = (int)((unsigned char*)(vL + rr * 16 + (ch - 32) * 8) - base); mode = 0; }
        pf_dst[i] = dst; pf_mode[i] = (e < 32 * 34) ? mode : -1;
    }
#define RW_PREFETCH(tau_) do { int low_, s0_, s1_; bool ic_, fi_; scan_tile(b, dir, (tau_), low_, s0_, s1_, ic_, fi_); \
        const bf16_t* rb_ = RW + (size_t)low_ * 1792; \
        _Pragma("unroll") for (int i = 0; i < 5; ++i) { \
            rv[i] = (u32x4){0u, 0u, 0u, 0u}; \
            if (pf_mode[i] >= 0) rv[i] = *(const u32x4*)(rb_ + pf_off[i]); } } while (0)
    RW_PREFETCH(0);
    for (int tau = 0; tau < 264; ++tau) {
        int low, s0, s1; bool isctx, first;
        scan_tile(b, dir, tau, low, s0, s1, isctx, first);
#pragma unroll
        for (int i = 0; i < 5; ++i) {
            if (pf_mode[i] == 1) *(u32x4*)(base + pf_dst[i]) = rv[i];
            else if (pf_mode[i] == 0) {
                *(f32x4*)(base + pf_dst[i]) = (f32x4){bflo(rv[i].x), bfhi(rv[i].x), bflo(rv[i].y), bfhi(rv[i].y)};
                *(f32x4*)(base + pf_dst[i] + 16) = (f32x4){bflo(rv[i].z), bfhi(rv[i].z), bflo(rv[i].w), bfhi(rv[i].w)};
            }
        }
        bf16_t* pp = P + (size_t)(low + t2) * 512 + h * 64 + rq * 16 + part2 * 2;
        const bool late = (tau == 4) || (tau == 136);
        unsigned pv = 0u;
        if (!first && !late) pv = *(const unsigned*)pp;
        __syncthreads();
        {
            const f32x4 ka = *(const f32x4*)(kL + t2 * 64 + part2 * 8), kb = *(const f32x4*)(kL + t2 * 64 + part2 * 8 + 4);
            const f32x4 pa = ka * kk2a, pb = kb * kk2b;
            float ss = pa.x * pa.x + pa.y * pa.y + pa.z * pa.z + pa.w * pa.w + pb.x * pb.x + pb.y * pb.y + pb.z * pb.z + pb.w * pb.w;
            ss = red8(ss);
            if (part2 == 0) { const float iv = __builtin_amdgcn_rcpf(fmaxf(sqrtf(ss), 1e-12f)); invn[t2] = iv * iv; }
        }
        f32x4 accw[2], acca[2];
#pragma unroll
        for (int mt = 0; mt < 2; ++mt) {
            accw[mt] = (f32x4){0.f, 0.f, 0.f, 0.f}; acca[mt] = (f32x4){0.f, 0.f, 0.f, 0.f};
#pragma unroll
            for (int kc = 0; kc < 2; ++kc) {
                const bf16x8 Aw = *(const bf16x8*)(twB + (mt * 16 + fr) * 64 + kc * 32 + fq * 8);
                const bf16x8 Aa = *(const bf16x8*)(aloB + (mt * 16 + fr) * 64 + kc * 32 + fq * 8);
                accw[mt] = __builtin_amdgcn_mfma_f32_16x16x32_bf16(Aw, Bw[kc], accw[mt], 0, 0, 0);
                acca[mt] = __builtin_amdgcn_mfma_f32_16x16x32_bf16(Aa, Ba[kc], acca[mt], 0, 0, 0);
            }
        }
#pragma unroll
        for (int mt = 0; mt < 2; ++mt)
#pragma unroll
            for (int r = 0; r < 4; ++r) {
                const int t = mt * 16 + fq * 4 + r, c = wv * 16 + fr;
                const float wl = w0c + accw[mt][r];
                const float decay = __expf(-0.6065306597f * sigmoidf_(wl));
                const float a = sigmoidf_(a0c + acca[mt][r]);
                const float kraw = kL[t * 64 + c];
                const float kk = kraw * kkc;
                wL[t * 64 + c] = decay;
                kdL[t * 64 + c] = kraw * (1.f + (a - 1.f) * kac);
                bL[t * 64 + c] = kk * a;
                nkL[t * 64 + c] = -kk;
            }
        __syncthreads();
        if (!first && late) pv = *(const unsigned*)pp;
        if (tau + 1 < 264) RW_PREFETCH(tau + 1);
        {
            const float* __restrict__ nkR = nkL + kq * 4; const float* __restrict__ wR = wL + kq * 4; const float* __restrict__ bR = bL + kq * 4;
            const float* __restrict__ kR = kdL + kq * 4; const float* __restrict__ rR = rL + kq * 4; const float* __restrict__ vR = vL + rloc;
            float* __restrict__ yW = yL + rloc;
            const int t0 = dir ? 31 : 0, dt = dir ? -1 : 1;
            f32x4 n0 = *(const f32x4*)(nkR + t0 * 64), wa = *(const f32x4*)(wR + t0 * 64), ba = *(const f32x4*)(bR + t0 * 64);
            f32x4 ka = *(const f32x4*)(kR + t0 * 64), ra = *(const f32x4*)(rR + t0 * 64);
            float vv = vR[t0 * 16], iv2 = invn[t0];
            f32x2_t S01 = {S[0], S[1]}, S23 = {S[2], S[3]};
            float yprev = 0.f; int tprev = t0;
#pragma unroll 2
            for (int j = 0; j < 32; ++j) {
                const int tt = t0 + dt * j;
                const int tn = (j < 31) ? tt + dt : tt;
                const f32x4 n0n = *(const f32x4*)(nkR + tn * 64), wan = *(const f32x4*)(wR + tn * 64), ban = *(const f32x4*)(bR + tn * 64);
                const f32x4 kan = *(const f32x4*)(kR + tn * 64), ran = *(const f32x4*)(rR + tn * 64);
                const float vvn = vR[tn * 16], iv2n = invn[tn];
                f32x2_t pp2 = S01 * (f32x2_t){n0.x, n0.y};
                pp2 = __builtin_elementwise_fma(S23, (f32x2_t){n0.z, n0.w}, pp2);
                float ra_ = pp2.x + pp2.y, rb_ = yprev;
                ra_ += dppf<0xB1>(ra_); rb_ += dppf<0xB1>(rb_);
                ra_ += dppf<0x4E>(ra_); rb_ += dppf<0x4E>(rb_);
                ra_ += dppf<0x141>(ra_); rb_ += dppf<0x141>(rb_);
                ra_ += dppf<0x140>(ra_); rb_ += dppf<0x140>(rb_);
                if (kq == 0 && j > 0) yW[tprev * 16] = rb_;
                const float sa = ra_ * iv2;
                const f32x2_t sav = {sa, sa}, vvv = {vv, vv};
                f32x2_t t01 = vvv * (f32x2_t){ka.x, ka.y}, t23 = vvv * (f32x2_t){ka.z, ka.w};
                t01 = __builtin_elementwise_fma(sav, (f32x2_t){ba.x, ba.y}, t01);
                t23 = __builtin_elementwise_fma(sav, (f32x2_t){ba.z, ba.w}, t23);
                S01 = __builtin_elementwise_fma(S01, (f32x2_t){wa.x, wa.y}, t01);
                S23 = __builtin_elementwise_fma(S23, (f32x2_t){wa.z, wa.w}, t23);
                f32x2_t qq = S01 * (f32x2_t){ra.x, ra.y};
                qq = __builtin_elementwise_fma(S23, (f32x2_t){ra.z, ra.w}, qq);
                yprev = qq.x + qq.y; tprev = tt;
                n0 = n0n; wa = wan; ba = ban; ka = kan; ra = ran; vv = vvn; iv2 = iv2n;
            }
            { const float y = red16(yprev); if (kq == 0) yW[tprev * 16] = y; }
            S[0] = S01.x; S[1] = S01.y; S[2] = S23.x; S[3] = S23.y;
        }
        __syncthreads();
        {
            const float y0 = yL[t2 * 16 + part2 * 2], y1 = yL[t2 * 16 + part2 * 2 + 1];
            *(unsigned*)pp = pk2(bflo(pv) + y0, bfhi(pv) + y1);
        }
    }
#undef RW_PREFETCH
}

__device__ __forceinline__ void scan_phase(CParams& p, int l, unsigned char* smem) {
    for (int it = blockIdx.x; it < 224; it += gridDim.x) {
        if (it < 128) rwkv_scan_item(p, l, it, smem);
        else if (it < 192) ssd_scan_item(p, l, it - 128, smem);
        else ret_scan_item(p, l, it - 192, smem);
        __syncthreads();
    }
    int cb = (int)blockIdx.x - 224, cn = (int)gridDim.x - 224;
    if (cn <= 0) { cb = blockIdx.x; cn = gridDim.x; }
    if (cb >= 0) cvt_mix(p, l, smem, cb, cn);
}

__device__ __forceinline__ void post_phase(CParams& p_in, int l_in, int nrows, unsigned char* smem) {
    CParams* pq_ = &p_in; asm volatile("" : "+s"(pq_)); CParams& p = *pq_;
    int l = l_in; asm volatile("" : "+s"(l));
    const int tidx = opaque_tid();
    const int lane = tidx & 63, gw = blockIdx.x * 8 + (tidx >> 6), ngw = gridDim.x * 8;
    unsigned char* ws = p.ws;
    const float* MOD = (const float*)(ws + OFF_MOD);
    for (int row = gw; row < nrows; row += ngw) {
        {
            const bf16_t* yp = (const bf16_t*)(ws + OFF_H) + (size_t)row * 1024 + lane * 16;
            bf16_t* zp = (bf16_t*)(ws + OFF_Z) + (size_t)row * 1024 + lane * 16;
            const float* nw = p.in[13] + (size_t)l * 1024 + lane * 16;
            float v[16]; float ss = 0.f;
#pragma unroll
            for (int q = 0; q < 2; ++q) {
                const u32x4 yr = *(const u32x4*)(yp + q * 8), zr = *(const u32x4*)(zp + q * 8);
                const unsigned ya[4] = {yr.x, yr.y, yr.z, yr.w}, za[4] = {zr.x, zr.y, zr.z, zr.w};
#pragma unroll
                for (int e = 0; e < 4; ++e) {
                    const float y0 = bflo(ya[e]), y1 = bfhi(ya[e]), z0 = bflo(za[e]), z1 = bfhi(za[e]);
                    const float a = y0 * siluf_(z0), c = y1 * siluf_(z1);
                    v[q * 8 + e * 2] = a; v[q * 8 + e * 2 + 1] = c; ss += a * a + c * c;
                }
            }
            ss = red16(ss); ss += __shfl_xor(ss, 16);
            const float rs = rsqrtf(ss * (1.f / 512.f) + 1e-6f);
#pragma unroll
            for (int q = 0; q < 2; ++q) {
                const f32x4 wa = *(const f32x4*)(nw + q * 8), wb = *(const f32x4*)(nw + q * 8 + 4);
                u32x4 o;
                o.x = pk2(v[q * 8 + 0] * rs * wa.x, v[q * 8 + 1] * rs * wa.y); o.y = pk2(v[q * 8 + 2] * rs * wa.z, v[q * 8 + 3] * rs * wa.w);
                o.z = pk2(v[q * 8 + 4] * rs * wb.x, v[q * 8 + 5] * rs * wb.y); o.w = pk2(v[q * 8 + 6] * rs * wb.z, v[q * 8 + 7] * rs * wb.w);
                *(u32x4*)(zp + q * 8) = o;
            }
        }
        {
            const bf16_t* yp = (const bf16_t*)(ws + OFF_PRET) + (size_t)row * 512 + lane * 8;
            bf16_t* gp = (bf16_t*)(ws + OFF_G) + (size_t)row * 512 + lane * 8;
            const u32x4 yr = *(const u32x4*)yp, gr = *(const u32x4*)gp;
            const unsigned ya[4] = {yr.x, yr.y, yr.z, yr.w}, ga[4] = {gr.x, gr.y, gr.z, gr.w};
            float v[8], gg[8]; float s = 0.f;
#pragma unroll
            for (int e = 0; e < 4; ++e) { v[2 * e] = bflo(ya[e]); v[2 * e + 1] = bfhi(ya[e]); gg[2 * e] = bflo(ga[e]); gg[2 * e + 1] = bfhi(ga[e]); s += v[2 * e] + v[2 * e + 1]; }
            s = red16(s);
            const float mean = s * (1.f / 128.f); float q2 = 0.f;
#pragma unroll
            for (int e = 0; e < 8; ++e) { v[e] -= mean; q2 += v[e] * v[e]; }
            q2 = red16(q2);
            const float rs = rsqrtf(q2 * (1.f / 128.f) + 1e-6f);
            u32x4 o;
            o.x = pk2(v[0] * rs * siluf_(gg[0]), v[1] * rs * siluf_(gg[1])); o.y = pk2(v[2] * rs * siluf_(gg[2]), v[3] * rs * siluf_(gg[3]));
            o.z = pk2(v[4] * rs * siluf_(gg[4]), v[5] * rs * siluf_(gg[5])); o.w = pk2(v[6] * rs * siluf_(gg[6]), v[7] * rs * siluf_(gg[7]));
            *(u32x4*)gp = o;
        }
        {
            const bool lat = row < RL; const int mi = lat ? (row >> 13) : 4;
            const float* xin;
            if (lat) xin = (l == 0) ? p.in[0] + (size_t)row * 1024 : p.out + (size_t)row * 1024;
            else xin = (l == 0) ? p.in[2] + (size_t)(row - RL) * 1024 : (const float*)(ws + OFF_CTXS) + (size_t)(row - RL) * 1024;
            const float* modl = MOD + (size_t)(l * 5 + mi) * 6144;
            row_pass(xin, nullptr, nullptr, nullptr, nullptr, true, p.in[4] + (l * 4 + 0) * 1024, modl, modl + 1024, (bf16_t*)(ws + OFF_XBC) + (size_t)row * 1024, lane);
        }
    }
    bf16_t* aB = (bf16_t*)smem;
    bf16_t* gB = aB + 32 * 72;
    float* asL = (float*)(smem + 13312);
    float* gsL = asL + 32 * 512;
    const bf16_t* RW = (const bf16_t*)(ws + OFF_RW);
    bf16_t* P = (bf16_t*)(ws + OFF_PRW);
    const float* mix = p.in[15] + (size_t)l * 1792;
    const int c = tidx;
    const float a0f = p.in[18][(l * 2 + 0) * 512 + c], a0b = p.in[18][(l * 2 + 1) * 512 + c];
    const float kac = p.in[22][l * 512 + c], rkc = p.in[23][l * 512 + c], lw = p.in[24][l * 512 + c], lb = p.in[25][l * 512 + c];
    const float mxr = mix[c], mxk = mix[512 + c], mxv = mix[1024 + c];
    const int wvB = tidx >> 6, frB = lane & 15, fqB = lane >> 4;
    const float* a2 = p.in[19] + (size_t)l * 64 * 512 + wvB * 64 + frB;
    const float* g2 = p.in[20] + (size_t)l * 128 * 512 + wvB * 64 + frB;
    for (int tile = blockIdx.x; tile < nrows / 32; tile += gridDim.x) {
        const int low = tile * 32;
        int s0, s1;
        if (low < RL) { s0 = low & ~8191; s1 = s0 + 8192; } else { s0 = RL + ((low - RL) & ~255); s1 = s0 + 256; }
        {
            for (int e = tidx; e < 32 * 24; e += 512) {
                const int t = e / 24, ch = e - t * 24;
                const u32x4 v = *(const u32x4*)(RW + (size_t)(low + t) * 1792 + 1600 + ch * 8);
                if (ch < 8) *(u32x4*)(aB + t * 72 + ch * 8) = v; else *(u32x4*)(gB + t * 136 + (ch - 8) * 8) = v;
            }
        }
        __syncthreads();
        {
            bf16x8 Aa[2][2], Ag[2][4];
#pragma unroll
            for (int mt = 0; mt < 2; ++mt) {
#pragma unroll
                for (int kc = 0; kc < 2; ++kc) Aa[mt][kc] = *(const bf16x8*)(aB + (mt * 16 + frB) * 72 + kc * 32 + fqB * 8);
#pragma unroll
                for (int kc = 0; kc < 4; ++kc) Ag[mt][kc] = *(const bf16x8*)(gB + (mt * 16 + frB) * 136 + kc * 32 + fqB * 8);
            }
#pragma unroll 1
            for (int nt = 0; nt < 4; ++nt) {
                bf16x8 ba[2], bg[4];
#pragma unroll
                for (int kc = 0; kc < 2; ++kc)
#pragma unroll
                    for (int e = 0; e < 8; ++e) ba[kc][e] = (short)f2bf(a2[(size_t)(kc * 32 + fqB * 8 + e) * 512 + nt * 16]);
#pragma unroll
                for (int kc = 0; kc < 4; ++kc)
#pragma unroll
                    for (int e = 0; e < 8; ++e) bg[kc][e] = (short)f2bf(g2[(size_t)(kc * 32 + fqB * 8 + e) * 512 + nt * 16]);
#pragma unroll
                for (int mt = 0; mt < 2; ++mt) {
                    f32x4 ca = (f32x4){0.f, 0.f, 0.f, 0.f}, cg = (f32x4){0.f, 0.f, 0.f, 0.f};
#pragma unroll
                    for (int kc = 0; kc < 2; ++kc) ca = __builtin_amdgcn_mfma_f32_16x16x32_bf16(Aa[mt][kc], ba[kc], ca, 0, 0, 0);
#pragma unroll
                    for (int kc = 0; kc < 4; ++kc) cg = __builtin_amdgcn_mfma_f32_16x16x32_bf16(Ag[mt][kc], bg[kc], cg, 0, 0, 0);
#pragma unroll
                    for (int r = 0; r < 4; ++r) {
                        const int idx = (mt * 16 + fqB * 4 + r) * 512 + wvB * 64 + nt * 16 + frB;
                        asL[idx] = ca[r]; gsL[idx] = cg[r];
                    }
                }
            }
        }
        __syncthreads();
        const bf16_t* u = RW + (size_t)low * 1792;
#pragma unroll 4
        for (int i = 0; i < 32; ++i) {
            const int row = low + i;
            const bf16_t* un = u + (size_t)i * 1792;
            const float r = bf2f(un[c]), k = bf2f(un[512 + c]), v = bf2f(un[1024 + c]);
            const float y = bf2f(P[(size_t)row * 512 + c]);
            const float ash = asL[i * 512 + c];
            const float af = sigmoidf_(a0f + ash), ab = sigmoidf_(a0b + ash);
            const float ks = k * (2.f + (af + ab - 2.f) * kac);
            const float bsum = wave_sum(r * ks * rkc);
            const float mean = wave_sum(y) * (1.f / 64.f);
            const float d = y - mean;
            const float var = wave_sum(d * d) * (1.f / 64.f);
            const float yn = d * rsqrtf(var + 64e-5f) * lw + lb;
            P[(size_t)row * 512 + c] = f2bf((yn + bsum * v) * gsL[i * 512 + c]);
        }
        __syncthreads();
    }
}

__device__ __forceinline__ void flat_barrier(unsigned* cnt, unsigned target) {
    asm volatile("s_waitcnt vmcnt(0)" ::: "memory");
    __syncthreads();
    if (threadIdx.x == 0) {
        __builtin_amdgcn_fence(__ATOMIC_RELEASE, "agent");
        asm volatile("s_waitcnt vmcnt(0)" ::: "memory");
        __hip_atomic_fetch_add(cnt, 1u, __ATOMIC_RELAXED, __HIP_MEMORY_SCOPE_AGENT);
        while (__hip_atomic_load(cnt, __ATOMIC_RELAXED, __HIP_MEMORY_SCOPE_AGENT) < target) __builtin_amdgcn_s_sleep(1);
        __builtin_amdgcn_fence(__ATOMIC_ACQUIRE, "agent");
        asm volatile("s_waitcnt vmcnt(0)" ::: "memory");
    }
    __syncthreads();
}

__global__ void __launch_bounds__(512) mega(Params p_arg) {
    extern __shared__ __attribute__((aligned(16))) unsigned char smem[];
    CParams* pbase = (CParams*)__builtin_amdgcn_kernarg_segment_ptr();
    const int ph_lo = p_arg.ph_lo, ph_hi = p_arg.ph_hi;
    for (int ph = ph_lo; ph < ph_hi; ++ph) {
        CParams* pq = pbase;
        asm volatile("" : "+s"(pq));
        CParams& p = *pq;
        int gm = -1, l = 0, sub = -1;
        if (ph >= 2) { l = (ph - 2) / 11; sub = (ph - 2) % 11; }
        const int nrows = (l == 3) ? RL : R;
        if (sub == 0) gm = GM_IN; else if (sub == 5) gm = GM_MERGE; else if (sub == 6) gm = GM_OUT; else if (sub == 8) gm = GM_MLP1; else if (sub == 9) gm = GM_MLP2;
        if (gm >= 0) {
            gemm_phase(p, gm, gm == GM_IN ? 132 : nrows / 256, (LAS unsigned char*)smem);
            __syncthreads();
        } else if (ph == 0) {
            phase_mod(p, smem);
            cvt_win(p, 0, smem, blockIdx.x, gridDim.x);
        } else if (ph == 1) {
            token_phase(p, 0, 0, R);
        } else if (sub == 1) {
            shift_phase(p, l, 0, smem);
        } else if (sub == 2) {
            shift_phase(p, l, 1, smem);
        } else if (sub == 3) {
            scan_phase(p, l, smem);
        } else if (sub == 4) {
            post_phase(p, l, nrows, smem);
        } else if (sub == 7) {
            token_phase(p, l, 1, nrows);
            cvt_mlp(p, l, smem, blockIdx.x, gridDim.x);
        } else if (sub == 10) {
            token_phase(p, l, 2, nrows);
            if (l < 3) cvt_win(p, l + 1, smem, blockIdx.x, gridDim.x);
        }
        if (ph + 1 < ph_hi) {
            if (ph == ph_lo) { __threadfence(); cg::this_grid().sync(); }
            else flat_barrier((unsigned*)(p_arg.ws + OFF_BAR), (unsigned)(ph - ph_lo) * gridDim.x);
        }
    }
}

extern "C" void kernel_launch(void* const* d_in, const int* in_sizes, int n_in, void* d_out, int out_size, void* d_ws, size_t ws_size, hipStream_t stream) {
    static int grid = 0;
    if (grid == 0) {
        if (n_in != 32 || ws_size < WS_END) { fprintf(stderr, "kernel_launch: bad n_in %d or ws %zu < %zu\n", n_in, ws_size, (size_t)WS_END); grid = -1; return; }
        if (hipFuncSetAttribute((const void*)mega, hipFuncAttributeMaxDynamicSharedMemorySize, LDS_BYTES) != hipSuccess) { grid = -1; return; }
        int dev = 0, cus = 0, per_cu = 0;
        hipGetDevice(&dev);
        hipDeviceGetAttribute(&cus, hipDeviceAttributeMultiprocessorCount, dev);
        hipOccupancyMaxActiveBlocksPerMultiprocessor(&per_cu, (const void*)mega, 512, LDS_BYTES);
        (void)hipGetLastError();
        if (per_cu < 1) per_cu = 1;
        grid = cus * per_cu; if (grid > 256) grid = 256;
    }
    if (grid < 0) return;
    Params p{};
    for (int i = 0; i < 32; ++i) p.in[i] = (const float*)d_in[i];
    p.out = (float*)d_out; p.ws = (unsigned char*)d_ws;
    p.ph_lo = 0; p.ph_hi = NPH; p.coop = 1; p.pad = 0;
    if (hipMemsetAsync((char*)d_ws + OFF_BAR, 0, 64, stream) != hipSuccess) return;
    void* args[] = {&p};
    hipError_t e = hipLaunchCooperativeKernel((const void*)mega, dim3(grid), dim3(512), args, LDS_BYTES, stream);
    if (e != hipSuccess) fprintf(stderr, "cooperative launch failed: %s (grid %d)\n", hipGetErrorString(e), grid);
}
```

```cpp
#include <hip/hip_runtime.h>
#include <hip/hip_cooperative_groups.h>
#include <cstdint>
#include <cstdio>
namespace cg = cooperative_groups;

typedef unsigned short bf16_t;
typedef short bf16x8 __attribute__((ext_vector_type(8)));
typedef float f32x4 __attribute__((ext_vector_type(4)));
typedef unsigned u32x2 __attribute__((ext_vector_type(2)));
typedef unsigned u32x4 __attribute__((ext_vector_type(4)));

constexpr int RL = 32768;
constexpr int RC = 1024;
constexpr int R = RL + RC;
constexpr int LDS_BYTES = 153600;
constexpr int NPH = 2 + 11 * 4;
#ifndef PROBE_SCAN
#define PROBE_SCAN 0
#endif
#ifndef PROBE_GEMM
#define PROBE_GEMM 0
#endif

constexpr size_t OFF_MOD = 0;
constexpr size_t OFF_BAR = 491776;
constexpr size_t OFF_CTXS = 524288;
constexpr size_t OFF_DT = OFF_CTXS + 4194304;
constexpr size_t OFF_W = OFF_DT + (size_t)R * 32 * 4;
constexpr size_t OFF_H = OFF_W + 16777216;
constexpr size_t SZ1024 = (size_t)R * 1024 * 2;
constexpr size_t OFF_Z = OFF_H + SZ1024;
constexpr size_t OFF_XBC = OFF_Z + SZ1024;
constexpr size_t OFF_QKV = OFF_XBC + (size_t)R * 1536 * 2;
constexpr size_t OFF_G = OFF_QKV + SZ1024;
constexpr size_t OFF_RW = OFF_G + (size_t)R * 512 * 2;
constexpr size_t OFF_PRET = OFF_RW + (size_t)R * 1792 * 2;
constexpr size_t OFF_PRW = OFF_PRET + (size_t)R * 512 * 2;
constexpr size_t WS_END = OFF_PRW + (size_t)R * 512 * 2;
constexpr size_t W_G = 0, W_SO = 6291456, W_RO = 8388608, W_WO = 9437184, W_O = 10485760;
constexpr size_t W_1 = 0, W_2 = 8388608;
constexpr size_t MSCR_S = 0, MSCR_M = (size_t)256 * 131072;

struct Params {
    const float* in[32];
    float* out;
    unsigned char* ws;
    int ph_lo, ph_hi, coop, pad;
};

typedef const __attribute__((address_space(4))) Params CParams;

__device__ __forceinline__ float bf2f(bf16_t h) { return __uint_as_float(((unsigned)h) << 16); }
__device__ __forceinline__ float bflo(unsigned u) { return __uint_as_float(u << 16); }
__device__ __forceinline__ float bfhi(unsigned u) { return __uint_as_float(u & 0xffff0000u); }
typedef float f32x2_t __attribute__((ext_vector_type(2)));
typedef __bf16 bf16x2_t __attribute__((ext_vector_type(2)));
__device__ __forceinline__ unsigned pk2(float a, float b) { const f32x2_t v = {a, b}; const bf16x2_t r = __builtin_convertvector(v, bf16x2_t); return __builtin_bit_cast(unsigned, r); }
__device__ __forceinline__ bf16_t f2bf(float f) { const __bf16 r = (__bf16)f; return __builtin_bit_cast(unsigned short, r); }
template <int CTRL> __device__ __forceinline__ float dppf(float v) {
    return __builtin_bit_cast(float, __builtin_amdgcn_update_dpp(0, __builtin_bit_cast(int, v), CTRL, 0xf, 0xf, true));
}
__device__ __forceinline__ float red4(float v) { v += dppf<0xB1>(v); v += dppf<0x4E>(v); return v; }
__device__ __forceinline__ float red8(float v) { v = red4(v); v += dppf<0x141>(v); return v; }
__device__ __forceinline__ float red16(float v) { v = red8(v); v += dppf<0x140>(v); return v; }
__device__ __forceinline__ float wave_sum(float v) { v = red16(v); v += __shfl_xor(v, 16); v += __shfl_xor(v, 32); return v; }
__device__ __forceinline__ int opaque_tid() { int t = threadIdx.x; asm volatile("" : "+v"(t)); return t; }
__device__ __forceinline__ float sigmoidf_(float x) { return __builtin_amdgcn_rcpf(1.f + __expf(-x)); }
__device__ __forceinline__ float siluf_(float x) { return x * __builtin_amdgcn_rcpf(1.f + __expf(-x)); }
__device__ __forceinline__ float fast_tanh(float x) { return 1.f - 2.f * __builtin_amdgcn_rcpf(1.f + __expf(2.f * x)); }
__device__ __forceinline__ float fast_softplus(float x) { return x > 20.f ? x : __logf(1.f + __expf(x)); }
__device__ __forceinline__ float softplusf_(float x) { return x > 20.f ? x : log1pf(__expf(x)); }

constexpr int BK = 64, HALF = 128, HT = HALF * BK;
__device__ __forceinline__ int lds_byte(int r, int c) {
    int st = (r >> 4) * 2 + (c >> 5), rr = r & 15, cc = c & 31, ob = rr * 64 + cc * 2;
    return st * 1024 + (ob ^ (((ob >> 9) & 1) << 5));
}
__device__ __forceinline__ void stage_rc(int b, int& Rr, int& Cc) {
    int st = b / 1024, sb = b % 1024, swz = sb ^ (((sb >> 9) & 1) << 5);
    Rr = (st >> 1) * 16 + swz / 64; Cc = (st & 1) * 32 + (swz % 64) / 2;
}

#define LAS __attribute__((address_space(3)))
constexpr int HTB = HALF * BK * 2;

__device__ __forceinline__ bool tile_next(int i, int G, int c, int nM, int nN, int& pm, int& pn) {
    const int nwg = nM * nN;
    const long L = (long)i * G + c; if (L >= nwg) return false;
    int wgid = (int)L; { const int q = nwg / 8, r = nwg % 8, xcd = wgid % 8, off = wgid / 8; wgid = (xcd < r ? xcd * (q + 1) : r * (q + 1) + (xcd - r) * q) + off; }
    const int nig = 8 * nN, gid = wgid / nig, fm = gid * 8, gsz = (nM - fm) < 8 ? (nM - fm) : 8;
    pm = fm + ((wgid % nig) % gsz); pn = (wgid % nig) / gsz; return true;
}

enum { GM_IN = 0, GM_MERGE = 1, GM_OUT = 2, GM_MLP1 = 3, GM_MLP2 = 4 };
struct UnitInfo { const char* A; const char* B; int K, wt, mt, step; };

__device__ __forceinline__ bool get_unit(unsigned char* ws, int mode, int n_mt, int n_wt, int nsteps, int ui, UnitInfo& u) {
    const int it = ui / nsteps, step = ui - it * nsteps;
    int mt, wt;
    if (!tile_next(it, gridDim.x, blockIdx.x, n_mt, n_wt, mt, wt)) return false;
    const size_t tok0 = (size_t)mt * 256;
    const bf16_t* Aw; const bf16_t* Bact; int K = 1024;
    if (mode == GM_IN) { Aw = (const bf16_t*)(ws + OFF_W) + (size_t)wt * 256 * 1024; Bact = (const bf16_t*)(ws + OFF_H) + tok0 * 1024; }
    else if (mode == GM_OUT) { Aw = (const bf16_t*)(ws + OFF_W + W_O) + (size_t)wt * 256 * 1024; Bact = (const bf16_t*)(ws + OFF_QKV) + tok0 * 1024; }
    else if (mode == GM_MLP1) { Aw = (const bf16_t*)(ws + OFF_W + W_1) + (size_t)wt * 256 * 1024; Bact = (const bf16_t*)(ws + OFF_H) + tok0 * 1024; }
    else if (mode == GM_MLP2) { K = 4096; Aw = (const bf16_t*)(ws + OFF_W + W_2) + (size_t)wt * 256 * 4096; Bact = (const bf16_t*)(ws + OFF_Z) + tok0 * 4096; }
    else {
        const int k = step >> 1;
        if ((step & 1) == 0) { Aw = (const bf16_t*)(ws + OFF_W + W_G) + ((size_t)k * 1024 + (size_t)wt * 256) * 1024; Bact = (const bf16_t*)(ws + OFF_XBC) + tok0 * 1024; }
        else if (k == 0) { Aw = (const bf16_t*)(ws + OFF_W + W_SO) + (size_t)wt * 256 * 1024; Bact = (const bf16_t*)(ws + OFF_Z) + tok0 * 1024; }
        else if (k == 1) { K = 512; Aw = (const bf16_t*)(ws + OFF_W + W_RO) + (size_t)wt * 256 * 512; Bact = (const bf16_t*)(ws + OFF_G) + tok0 * 512; }
        else { K = 512; Aw = (const bf16_t*)(ws + OFF_W + W_WO) + (size_t)wt * 256 * 512; Bact = (const bf16_t*)(ws + OFF_PRW) + tok0 * 512; }
    }
    u.A = (const char*)Bact; u.B = (const char*)Aw; u.K = K; u.wt = wt; u.mt = mt; u.step = step;
    return true;
}

__device__ __forceinline__ void gemm_epilogue(unsigned char* ws, int mode, const UnitInfo& u, const f32x4 (&acc)[2][2][4][2], int wr, int wc, int fr, int fq, int tidx) {
    const size_t tok0 = (size_t)u.mt * 256; const int wt = u.wt, step = u.step;
    if (mode == GM_MERGE) {
        u32x4* sp = (u32x4*)(ws + OFF_RW + MSCR_S) + ((size_t)blockIdx.x * 8 * 512 + tidx) * 2;
        f32x4* mp = (f32x4*)(ws + OFF_RW + MSCR_M) + ((size_t)blockIdx.x * 8 * 512 + tidx) * 4;
        bf16_t* MG = (bf16_t*)(ws + OFF_QKV);
#pragma unroll
        for (int ai = 0; ai < 2; ++ai)
#pragma unroll
            for (int bj = 0; bj < 2; ++bj)
#pragma unroll
                for (int mh = 0; mh < 2; ++mh) {
                    if ((step & 1) == 0) {
                        unsigned o[8];
#pragma unroll
                        for (int k = 0; k < 4; ++k) {
                            const f32x4 v = acc[ai][bj][mh * 2 + (k >> 1)][k & 1];
                            o[2 * k] = pk2(sigmoidf_(v.x), sigmoidf_(v.y)); o[2 * k + 1] = pk2(sigmoidf_(v.z), sigmoidf_(v.w));
                        }
                        sp[0] = (u32x4){o[0], o[1], o[2], o[3]}; sp[1] = (u32x4){o[4], o[5], o[6], o[7]};
                    } else {
                        const u32x4 sa_ = sp[0], sb_ = sp[1];
                        const unsigned s8[8] = {sa_.x, sa_.y, sa_.z, sa_.w, sb_.x, sb_.y, sb_.z, sb_.w};
                        f32x4 m4[4];
                        if (step > 1) {
#pragma unroll
                            for (int k = 0; k < 4; ++k) m4[k] = mp[k];
                        }
#pragma unroll
                        for (int k = 0; k < 4; ++k) {
                            const int m = mh * 2 + (k >> 1), n = k & 1;
                            const f32x4 v = acc[ai][bj][m][n];
                            f32x4 mm = (f32x4){bflo(s8[2 * k]) * v.x, bfhi(s8[2 * k]) * v.y, bflo(s8[2 * k + 1]) * v.z, bfhi(s8[2 * k + 1]) * v.w};
                            if (step > 1) mm += m4[k];
                            if (step < 5) mp[k] = mm;
                            else {
                                const size_t tok = tok0 + ai * 128 + wr * 64 + m * 16 + fr;
                                const int feat = wt * 256 + bj * 128 + wc * 32 + fq * 8 + n * 4;
                                u32x2 o; o.x = pk2(mm.x, mm.y); o.y = pk2(mm.z, mm.w);
                                *(u32x2*)(MG + tok * 1024 + feat) = o;
                            }
                        }
                    }
                    sp += 512 * 2; mp += 512 * 4;
                    asm volatile("" : "+v"(sp), "+v"(mp) :: "memory");
                }
    } else if (mode == GM_IN && wt == 23) {
        float* DT = (float*)(ws + OFF_DT);
        if (wc == 0) {
#pragma unroll
            for (int ai = 0; ai < 2; ++ai)
#pragma unroll
                for (int m = 0; m < 4; ++m)
#pragma unroll
                    for (int n = 0; n < 2; ++n) {
                        const size_t tok = tok0 + ai * 128 + wr * 64 + m * 16 + fr;
                        *(f32x4*)(DT + tok * 32 + fq * 8 + n * 4) = acc[ai][0][m][n];
                    }
        }
    } else {
        bf16_t* base; int ld, col0;
        if (mode == GM_IN) {
            if (wt < 4) { base = (bf16_t*)(ws + OFF_Z); ld = 1024; col0 = wt * 256; }
            else if (wt < 10) { base = (bf16_t*)(ws + OFF_XBC); ld = 1536; col0 = (wt - 4) * 256; }
            else if (wt < 14) { base = (bf16_t*)(ws + OFF_QKV); ld = 1024; col0 = (wt - 10) * 256; }
            else if (wt < 16) { base = (bf16_t*)(ws + OFF_G); ld = 512; col0 = (wt - 14) * 256; }
            else { base = (bf16_t*)(ws + OFF_RW); ld = 1792; col0 = (wt - 16) * 256; }
        } else if (mode == GM_MLP1) { base = (bf16_t*)(ws + OFF_Z); ld = 4096; col0 = wt * 256; }
        else { base = (bf16_t*)(ws + OFF_H); ld = 1024; col0 = wt * 256; }
        const bool relu2 = (mode == GM_MLP1);
#pragma unroll
        for (int ai = 0; ai < 2; ++ai)
#pragma unroll
            for (int m = 0; m < 4; ++m) {
                const size_t tok = tok0 + ai * 128 + wr * 64 + m * 16 + fr;
                bf16_t* rowp = base + tok * ld + col0 + wc * 32 + fq * 8;
#pragma unroll
                for (int bj = 0; bj < 2; ++bj) {
                    f32x4 v = acc[ai][bj][m][0], w = acc[ai][bj][m][1];
                    if (relu2) { v.x = v.x > 0.f ? v.x * v.x : 0.f; v.y = v.y > 0.f ? v.y * v.y : 0.f; v.z = v.z > 0.f ? v.z * v.z : 0.f; v.w = v.w > 0.f ? v.w * v.w : 0.f;
                                 w.x = w.x > 0.f ? w.x * w.x : 0.f; w.y = w.y > 0.f ? w.y * w.y : 0.f; w.z = w.z > 0.f ? w.z * w.z : 0.f; w.w = w.w > 0.f ? w.w * w.w : 0.f; }
                    u32x4 o; o.x = pk2(v.x, v.y); o.y = pk2(v.z, v.w); o.z = pk2(w.x, w.y); o.w = pk2(w.z, w.w);
                    *(u32x4*)(rowp + bj * 128) = o;
                }
            }
    }
}

__device__ __forceinline__ void gemm_phase(CParams& p_in, const int mode, const int n_mt, LAS unsigned char* lds) {
    CParams* pq_ = &p_in; asm volatile("" : "+s"(pq_)); CParams& p = *pq_;
    const int tid = opaque_tid(), wid = __builtin_amdgcn_readfirstlane(tid >> 6), lane = tid & 63, wr = wid >> 2, wc = wid & 3, fr = lane & 15, fq = lane >> 4;
    unsigned char* ws = p.ws;
    int n_wt, nsteps = 1;
    if (mode == GM_IN) n_wt = 24; else if (mode == GM_MLP1) n_wt = 16; else n_wt = 4;
    if (mode == GM_MERGE) nsteps = 6;
    unsigned vR[2], vC[2];
#pragma unroll
    for (int i = 0; i < 2; ++i) { int Rr, Cc; stage_rc(tid * 16 + i * 8192, Rr, Cc); vR[i] = (unsigned)Rr * 2u; vC[i] = (unsigned)Cc * 2u; }
    const size_t kstep = (size_t)(BK * 2);
    const unsigned ldsw = (unsigned)wid * 1024u;
    const int aoff = lds_byte(wr * 64 + fr, fq * 8), boff = lds_byte(wc * 32 + fr, fq * 8);
#define PG8_SA(b, h) (((b) * 2 + (h)) * HTB)
#define PG8_SB(b, h) ((4 + (b) * 2 + (h)) * HTB)
#define PG8_STAGE(bufoff, gbase, v0, v1) do { \
        __builtin_amdgcn_global_load_lds((const unsigned*)((const char*)(gbase) + (v0)), (LAS unsigned*)(lds + (bufoff) + ldsw), 16, 0, 0); \
        __builtin_amdgcn_global_load_lds((const unsigned*)((const char*)(gbase) + (v1)), (LAS unsigned*)(lds + (bufoff) + ldsw + 8192), 16, 0, 0); } while (0)
#define PG8_LDA(dst, b, h) do { _Pragma("unroll") for (int m = 0; m < 4; ++m) _Pragma("unroll") for (int k = 0; k < 2; ++k) dst[m][k] = *(const LAS bf16x8*)(lds + PG8_SA(b, h) + aoff + m * 2048 + k * 1024); } while (0)
#define PG8_LDB(dst, b, h) do { _Pragma("unroll") for (int n = 0; n < 2; ++n) _Pragma("unroll") for (int k = 0; k < 2; ++k) dst[n][k] = *(const LAS bf16x8*)(lds + PG8_SB(b, h) + boff + n * 2048 + k * 1024); } while (0)
#define PG8_MMA(ai, bj, At, Bt) do { __builtin_amdgcn_s_setprio(1); _Pragma("unroll") for (int m = 0; m < 4; ++m) _Pragma("unroll") for (int n = 0; n < 2; ++n) _Pragma("unroll") for (int k = 0; k < 2; ++k) \
        acc[ai][bj][m][n] = __builtin_amdgcn_mfma_f32_16x16x32_bf16(Bt[n][k], At[m][k], acc[ai][bj][m][n], 0, 0, 0); __builtin_amdgcn_s_setprio(0); } while (0)
#define PG8_WAIT_V(n) asm volatile("s_waitcnt vmcnt(" #n ")" ::: "memory")
#define PG8_WAIT_L(n) asm volatile("s_waitcnt lgkmcnt(" #n ")" ::: "memory")
#define PG8_BAR __builtin_amdgcn_s_barrier()
#define PG8_SCHED __builtin_amdgcn_sched_barrier(0)
    UnitInfo cur, nxt; int ui = 0;
    if (!get_unit(ws, mode, n_mt, n_wt, nsteps, 0, cur)) return;
    f32x4 acc[2][2][4][2];
#pragma unroll
    for (int a = 0; a < 2; ++a)
#pragma unroll
        for (int b = 0; b < 2; ++b)
#pragma unroll
            for (int m = 0; m < 4; ++m)
#pragma unroll
                for (int n = 0; n < 2; ++n) acc[a][b][m][n] = (f32x4){0.f, 0.f, 0.f, 0.f};
    bf16x8 At[4][2], B0[2][2], B1[2][2];
    const char* cA = cur.A; const char* cB = cur.B;
    unsigned vc0 = vR[0] * (unsigned)cur.K + vC[0], vc1 = vR[1] * (unsigned)cur.K + vC[1];
    size_t hstep = (size_t)HALF * cur.K * 2;
    PG8_STAGE(PG8_SB(0, 0), cB, vc0, vc1); PG8_STAGE(PG8_SA(0, 0), cA, vc0, vc1); PG8_STAGE(PG8_SB(0, 1), cB + hstep, vc0, vc1); PG8_STAGE(PG8_SA(0, 1), cA + hstep, vc0, vc1);
    if (wr == 1) PG8_BAR;
    PG8_WAIT_V(4); PG8_BAR;
    PG8_STAGE(PG8_SB(1, 0), cB + kstep, vc0, vc1); PG8_STAGE(PG8_SA(1, 0), cA + kstep, vc0, vc1); PG8_STAGE(PG8_SB(1, 1), cB + hstep + kstep, vc0, vc1);
    PG8_WAIT_V(6); PG8_BAR;
    for (;;) {
        const bool has_next = get_unit(ws, mode, n_mt, n_wt, nsteps, ui + 1, nxt);
        const char* nA = has_next ? nxt.A : cA; const char* nB = has_next ? nxt.B : cB;
        const int Kn = has_next ? nxt.K : cur.K;
        const unsigned vn0 = vR[0] * (unsigned)Kn + vC[0], vn1 = vR[1] * (unsigned)Kn + vC[1];
        const size_t hstepn = (size_t)HALF * Kn * 2;
        const int nt = cur.K / BK;
        for (int t = 0; t < nt; t += 2) {
            const bool last = (t == nt - 2);
            const char* a1 = cA + (size_t)(t + 1) * kstep;
            const char* a2 = last ? nA : cA + (size_t)(t + 2) * kstep; const char* b2 = last ? nB : cB + (size_t)(t + 2) * kstep;
            const char* a3 = a2 + kstep; const char* b3 = b2 + kstep;
            const unsigned w0 = last ? vn0 : vc0, w1 = last ? vn1 : vc1;
            const size_t hs2 = last ? hstepn : hstep;
            PG8_LDB(B0, 0, 0); PG8_SCHED; PG8_LDA(At, 0, 0); PG8_STAGE(PG8_SA(1, 1), a1 + hstep, vc0, vc1);
            PG8_WAIT_L(8); PG8_BAR; PG8_WAIT_L(0); PG8_MMA(0, 0, At, B0); PG8_BAR; PG8_SCHED;
            PG8_LDB(B1, 0, 1); PG8_STAGE(PG8_SB(0, 0), b2, w0, w1);
            PG8_BAR; PG8_WAIT_L(0); PG8_MMA(0, 1, At, B1); PG8_BAR;
            PG8_LDA(At, 0, 1); PG8_STAGE(PG8_SA(0, 0), a2, w0, w1);
            PG8_BAR; PG8_WAIT_L(0); PG8_MMA(1, 0, At, B0); PG8_BAR; PG8_SCHED;
            PG8_STAGE(PG8_SB(0, 1), b2 + hs2, w0, w1);
            PG8_WAIT_V(6); PG8_BAR; PG8_MMA(1, 1, At, B1); PG8_BAR;
            PG8_LDB(B0, 1, 0); PG8_SCHED; PG8_LDA(At, 1, 0); PG8_STAGE(PG8_SA(0, 1), a2 + hs2, w0, w1);
            PG8_WAIT_L(8); PG8_BAR; PG8_WAIT_L(0); PG8_MMA(0, 0, At, B0); PG8_BAR; PG8_SCHED;
            PG8_LDB(B1, 1, 1); PG8_STAGE(PG8_SB(1, 0), b3, w0, w1);
            PG8_BAR; PG8_WAIT_L(0); PG8_MMA(0, 1, At, B1); PG8_BAR;
            PG8_LDA(At, 1, 1); PG8_STAGE(PG8_SA(1, 0), a3, w0, w1);
            PG8_BAR; PG8_WAIT_L(0); PG8_MMA(1, 0, At, B0); PG8_BAR; PG8_SCHED;
            PG8_STAGE(PG8_SB(1, 1), b3 + hs2, w0, w1);
            PG8_WAIT_V(6); PG8_BAR; PG8_MMA(1, 1, At, B1); PG8_BAR;
        }
        gemm_epilogue(ws, mode, cur, acc, wr, wc, fr, fq, tid);
        if (!has_next) break;
#pragma unroll
        for (int a = 0; a < 2; ++a)
#pragma unroll
            for (int b = 0; b < 2; ++b)
#pragma unroll
                for (int m = 0; m < 4; ++m)
#pragma unroll
                    for (int n = 0; n < 2; ++n) acc[a][b][m][n] = (f32x4){0.f, 0.f, 0.f, 0.f};
        cur = nxt; cA = nA; cB = nB; vc0 = vn0; vc1 = vn1; hstep = hstepn; ++ui;
    }
    PG8_WAIT_V(0);
    if (wr == 0) PG8_BAR;
    PG8_BAR;
}

__device__ __forceinline__ void phase_mod(CParams& p_in, unsigned char* smem) {
    CParams* pq_ = &p_in; asm volatile("" : "+s"(pq_)); CParams& p = *pq_;
    const int tidx = opaque_tid();
    float* sc = (float*)smem;
    float* red = sc + 5 * 1024;
    for (int i = tidx; i < 5 * 1024; i += 512) { int r = i >> 10, k = i & 1023; float v = r < 4 ? p.in[1][r * 1024 + k] : p.in[3][k]; sc[i] = siluf_(v); }
    __syncthreads();
    float* MOD = (float*)(p.ws + OFF_MOD);
    const int col = tidx & 63, kp = tidx >> 6;
    for (int item = blockIdx.x; item < 4 * 96; item += gridDim.x) {
        const int l = item / 96, n0 = (item % 96) * 64;
        const float* W = p.in[5] + (size_t)l * 1024 * 6144 + n0 + col;
        float a0 = 0.f, a1 = 0.f, a2 = 0.f, a3 = 0.f, a4 = 0.f;
        for (int k0 = kp * 128; k0 < kp * 128 + 128; k0 += 16) {
            float w[16];
#pragma unroll
            for (int j = 0; j < 16; ++j) w[j] = W[(size_t)(k0 + j) * 6144];
#pragma unroll
            for (int j = 0; j < 16; ++j) { const int k = k0 + j; a0 += sc[k] * w[j]; a1 += sc[1024 + k] * w[j]; a2 += sc[2048 + k] * w[j]; a3 += sc[3072 + k] * w[j]; a4 += sc[4096 + k] * w[j]; }
        }
        red[(kp * 5 + 0) * 64 + col] = a0; red[(kp * 5 + 1) * 64 + col] = a1; red[(kp * 5 + 2) * 64 + col] = a2;
        red[(kp * 5 + 3) * 64 + col] = a3; red[(kp * 5 + 4) * 64 + col] = a4;
        __syncthreads();
        if (tidx < 320) {
            const int r = tidx >> 6; float s = 0.f;
            for (int q = 0; q < 8; ++q) s += red[(q * 5 + r) * 64 + col];
            MOD[(size_t)(l * 5 + r) * 6144 + n0 + col] = s + p.in[6][l * 6144 + n0 + col];
        }
        __syncthreads();
    }
}

__device__ __forceinline__ void cvt_job(const float* W, int ldw, int col0, int ncols, int K, bf16_t* WT, int row0, unsigned char* smem, int cb, int cn) {
    const int tidx = opaque_tid();
    const int wave = tidx >> 6, lane = tidx & 63;
    float* scr = (float*)smem + wave * (64 * 33);
    const int nblk = ncols / 32, nitems = (K / 64) * nblk;
    for (int base = cb * 8; base < nitems; base += cn * 8) {
        const int it = base + wave; const bool valid = it < nitems;
        const int kb = valid ? it / nblk : 0, nb = valid ? it % nblk : 0, k0 = kb * 64, n0 = nb * 32;
        if (valid) {
#pragma unroll 8
            for (int i = 0; i < 32; ++i) { const int kk = 2 * i + (lane >> 5); scr[kk * 33 + (lane & 31)] = W[(size_t)(k0 + kk) * ldw + col0 + n0 + (lane & 31)]; }
        }
        __syncthreads();
        if (valid) {
            const int c = lane & 7;
#pragma unroll
            for (int j = 0; j < 4; ++j) {
                const int n = (lane >> 3) + 8 * j; const float* s = scr + (8 * c) * 33 + n;
                u32x4 o; o.x = pk2(s[0], s[33]); o.y = pk2(s[66], s[99]); o.z = pk2(s[132], s[165]); o.w = pk2(s[198], s[231]);
                const int rho = ((n >> 2) & 1) * 16 + (n >> 3) * 4 + (n & 3);
                *(u32x4*)(WT + (size_t)(row0 + n0 + rho) * K + k0 + 8 * c) = o;
            }
        }
        __syncthreads();
    }
}
__device__ __forceinline__ void cvt_win(CParams& p_in, int l_in, unsigned char* smem, int cb, int cn) {
    CParams* pq_ = &p_in; asm volatile("" : "+s"(pq_)); CParams& p = *pq_;
    int l = l_in; asm volatile("" : "+s"(l));
    const float* W = p.in[7] + (size_t)l * 1024 * 8992; bf16_t* WB = (bf16_t*)(p.ws + OFF_W);
    cvt_job(W, 8992, 3072, 2560, 1024, WB, 0, smem, cb, cn);
    cvt_job(W, 8992, 5664, 3328, 1024, WB, 2560, smem, cb, cn);
    cvt_job(W, 8992, 5632, 256, 1024, WB, 5888, smem, cb, cn);
}
__device__ __forceinline__ void cvt_mix(CParams& p_in, int l_in, unsigned char* smem, int cb, int cn) {
    CParams* pq_ = &p_in; asm volatile("" : "+s"(pq_)); CParams& p = *pq_;
    int l = l_in; asm volatile("" : "+s"(l));
    cvt_job(p.in[7] + (size_t)l * 1024 * 8992, 8992, 0, 3072, 1024, (bf16_t*)(p.ws + OFF_W + W_G), 0, smem, cb, cn);
    cvt_job(p.in[26] + (size_t)l * 1024 * 1024, 1024, 0, 1024, 1024, (bf16_t*)(p.ws + OFF_W + W_SO), 0, smem, cb, cn);
    cvt_job(p.in[27] + (size_t)l * 512 * 1024, 1024, 0, 1024, 512, (bf16_t*)(p.ws + OFF_W + W_RO), 0, smem, cb, cn);
    cvt_job(p.in[28] + (size_t)l * 512 * 1024, 1024, 0, 1024, 512, (bf16_t*)(p.ws + OFF_W + W_WO), 0, smem, cb, cn);
    cvt_job(p.in[29] + (size_t)l * 1024 * 1024, 1024, 0, 1024, 1024, (bf16_t*)(p.ws + OFF_W + W_O), 0, smem, cb, cn);
}
__device__ __forceinline__ void cvt_mlp(CParams& p_in, int l_in, unsigned char* smem, int cb, int cn) {
    CParams* pq_ = &p_in; asm volatile("" : "+s"(pq_)); CParams& p = *pq_;
    int l = l_in; asm volatile("" : "+s"(l));
    cvt_job(p.in[30] + (size_t)l * 1024 * 4096, 4096, 0, 4096, 1024, (bf16_t*)(p.ws + OFF_W + W_1), 0, smem, cb, cn);
    cvt_job(p.in[31] + (size_t)l * 4096 * 1024, 1024, 0, 1024, 4096, (bf16_t*)(p.ws + OFF_W + W_2), 0, smem, cb, cn);
}

__device__ __forceinline__ void row_pass(const float* xrow, const bf16_t* yrow, const float* gate, const float* nwA, float* xout,
                                         bool do_h, const float* nwB, const float* sh, const float* sc, bf16_t* hrow, int lane) {
    f32x4 x[4];
#pragma unroll
    for (int j = 0; j < 4; ++j) x[j] = *(const f32x4*)(xrow + j * 256 + lane * 4);
    if (yrow) {
        f32x4 y[4]; float ss = 0.f;
#pragma unroll
        for (int j = 0; j < 4; ++j) {
            const u32x2 raw = *(const u32x2*)(yrow + j * 256 + lane * 4);
            y[j] = (f32x4){bflo(raw.x), bfhi(raw.x), bflo(raw.y), bfhi(raw.y)};
            ss += y[j].x * y[j].x + y[j].y * y[j].y + y[j].z * y[j].z + y[j].w * y[j].w;
        }
        ss = wave_sum(ss);
        const float rs = rsqrtf(ss * (1.f / 1024.f) + 1e-6f);
#pragma unroll
        for (int j = 0; j < 4; ++j) {
            const f32x4 g = *(const f32x4*)(gate + j * 256 + lane * 4), w = *(const f32x4*)(nwA + j * 256 + lane * 4);
            x[j] += g * (y[j] * rs * w);
        }
    }
    if (xout) {
#pragma unroll
        for (int j = 0; j < 4; ++j) *(f32x4*)(xout + j * 256 + lane * 4) = x[j];
    }
    if (do_h) {
        float ss = 0.f;
#pragma unroll
        for (int j = 0; j < 4; ++j) ss += x[j].x * x[j].x + x[j].y * x[j].y + x[j].z * x[j].z + x[j].w * x[j].w;
        ss = wave_sum(ss);
        const float rs = rsqrtf(ss * (1.f / 1024.f) + 1e-6f);
#pragma unroll
        for (int j = 0; j < 4; ++j) {
            const f32x4 w = *(const f32x4*)(nwB + j * 256 + lane * 4), s = *(const f32x4*)(sh + j * 256 + lane * 4), c = *(const f32x4*)(sc + j * 256 + lane * 4);
            const f32x4 h = (x[j] * rs * w) * (c + 1.f) + s;
            u32x2 o; o.x = pk2(h.x, h.y); o.y = pk2(h.z, h.w);
            *(u32x2*)(hrow + j * 256 + lane * 4) = o;
        }
    }
}

__device__ __forceinline__ void token_phase(CParams& p_in, int l_in, int kind, int nrows) {
    CParams* pq_ = &p_in; asm volatile("" : "+s"(pq_)); CParams& p = *pq_;
    int l = l_in; asm volatile("" : "+s"(l));
    const int tidx = opaque_tid();
    const int lane = tidx & 63, gw = blockIdx.x * 8 + (tidx >> 6), ngw = gridDim.x * 8;
    const float* MOD = (const float*)(p.ws + OFF_MOD);
    const float* NW = p.in[4];
    bf16_t* H = (bf16_t*)(p.ws + OFF_H);
    float* CTXS = (float*)(p.ws + OFF_CTXS);
    for (int row = gw; row < nrows; row += ngw) {
        const bool lat = row < RL; const int mi = lat ? (row >> 13) : 4;
        const float* xin; float* xout = nullptr;
        const bool from_input = (l == 0 && kind <= 1);
        if (lat) xin = from_input ? p.in[0] + (size_t)row * 1024 : p.out + (size_t)row * 1024;
        else xin = from_input ? p.in[2] + (size_t)(row - RL) * 1024 : CTXS + (size_t)(row - RL) * 1024;
        if (kind > 0) xout = lat ? p.out + (size_t)row * 1024 : CTXS + (size_t)(row - RL) * 1024;
        const float* modl = MOD + (size_t)(l * 5 + mi) * 6144;
        bf16_t* hrow = H + (size_t)row * 1024;
        if (kind == 0) row_pass(xin, nullptr, nullptr, nullptr, nullptr, true, NW + (l * 4 + 0) * 1024, modl, modl + 1024, hrow, lane);
        else if (kind == 1) row_pass(xin, hrow, modl + 2048, NW + (l * 4 + 1) * 1024, xout, true, NW + (l * 4 + 2) * 1024, modl + 3072, modl + 4096, hrow, lane);
        else {
            const bool nxt = l < 3; const float* modn = MOD + (size_t)((l + 1) * 5 + mi) * 6144;
            row_pass(xin, hrow, modl + 5120, NW + (l * 4 + 3) * 1024, xout, nxt, NW + ((l + 1) * 4 + 0) * 1024, modn, modn + 1024, hrow, lane);
        }
    }
}

template <int NQ, int PB>
__device__ __forceinline__ void lin_steps(float (&S)[16], const float* qL, const float* kL, const float* vL, const float* dtL, const float* decL, float* yL, int dir, int nq, int pl) {
    constexpr int N = NQ * 16;
    for (int j = 0; j < 32; ++j) {
        const int tt = dir ? 31 - j : j;
        const float xdt = vL[tt * PB + pl] * dtL[tt];
        const float dec = decL[tt];
        const f32x4* kp = (const f32x4*)(kL + tt * N + nq * 16);
        const f32x4* qp = (const f32x4*)(qL + tt * N + nq * 16);
        float part = 0.f;
#pragma unroll
        for (int q4 = 0; q4 < 4; ++q4) {
            const f32x4 kv = kp[q4], qv = qp[q4];
            S[q4 * 4 + 0] = dec * S[q4 * 4 + 0] + kv.x * xdt; part += qv.x * S[q4 * 4 + 0];
            S[q4 * 4 + 1] = dec * S[q4 * 4 + 1] + kv.y * xdt; part += qv.y * S[q4 * 4 + 1];
            S[q4 * 4 + 2] = dec * S[q4 * 4 + 2] + kv.z * xdt; part += qv.z * S[q4 * 4 + 2];
            S[q4 * 4 + 3] = dec * S[q4 * 4 + 3] + kv.w * xdt; part += qv.w * S[q4 * 4 + 3];
        }
        part = (NQ == 8) ? red8(part) : red4(part);
        if (nq == 0) yL[tt * PB + pl] = part;
    }
}

__device__ __forceinline__ void scan_tile(int b, int dir, int tau, int& low, int& s0, int& s1, bool& isctx, bool& first) {
    int ti, nt;
    isctx = tau < 8;
    if (isctx) { ti = dir ? 7 - tau : tau; s0 = RL + b * 256; s1 = s0 + 256; nt = 8; }
    else { ti = dir ? 255 - (tau - 8) : tau - 8; s0 = b * 8192; s1 = s0 + 8192; nt = 256; }
    low = s0 + ti * 32;
    first = (dir == 0) == (ti < nt / 2);
}

template <int NK> struct CsL {
    static constexpr int SN = NK + 8, SS = 40;
    static constexpr int O_CN = 0, O_BN = O_CN + 32 * SN * 2, O_BWT = O_BN + 32 * SN * 2, O_XT = O_BWT + NK * SS * 2, O_PM = O_XT + 64 * SS * 2,
                         O_ST = O_PM + 32 * SS * 2, O_F = O_ST + 64 * SN * 2, O_Y = O_F + 544, O_RAW = (NK == 128) ? O_Y : O_Y + 8192;
};
template <int NK>
__device__ __forceinline__ void cs_core(unsigned char* base, f32x4 (&accS)[NK / 16], int dir, int w, int fr, int fq) {
    typedef CsL<NK> L;
    constexpr int SN = L::SN, SS = L::SS, KC = NK / 32, NT = NK / 16;
    bf16_t* Cn = (bf16_t*)(base + L::O_CN); bf16_t* Bn = (bf16_t*)(base + L::O_BN); bf16_t* BwT = (bf16_t*)(base + L::O_BWT);
    bf16_t* XT = (bf16_t*)(base + L::O_XT); bf16_t* Pm = (bf16_t*)(base + L::O_PM); bf16_t* ST = (bf16_t*)(base + L::O_ST);
    float* cumL = (float*)(base + L::O_F); float* dtL = cumL + 32; float* eL = dtL + 32; float* totL = eL + 64;
    float* yL = (float*)(base + ((NK == 128) ? L::O_BN : L::O_Y));
    f32x4 acc4[2];
    {
        const int mt = w >> 1, nt = w & 1;
        f32x4 g = (f32x4){0.f, 0.f, 0.f, 0.f};
#pragma unroll
        for (int kc = 0; kc < KC; ++kc) {
            const bf16x8 A = *(const bf16x8*)(Cn + (mt * 16 + fr) * SN + kc * 32 + fq * 8);
            const bf16x8 Bf = *(const bf16x8*)(Bn + (nt * 16 + fr) * SN + kc * 32 + fq * 8);
            g = __builtin_amdgcn_mfma_f32_16x16x32_bf16(A, Bf, g, 0, 0, 0);
        }
        const int s = nt * 16 + fr; const float cs = cumL[s], ds = dtL[s];
#pragma unroll
        for (int r = 0; r < 4; ++r) {
            const int t = mt * 16 + fq * 4 + r;
            const bool ok = dir ? (s >= t) : (s <= t);
            const float val = ok ? g[r] * __expf(cumL[t] - cs) * ds : 0.f;
            Pm[t * SS + s] = f2bf(val);
        }
#pragma unroll
        for (int mt2 = 0; mt2 < 2; ++mt2) {
            acc4[mt2] = (f32x4){0.f, 0.f, 0.f, 0.f};
#pragma unroll
            for (int kc = 0; kc < KC; ++kc) {
                const bf16x8 A = *(const bf16x8*)(Cn + (mt2 * 16 + fr) * SN + kc * 32 + fq * 8);
                const bf16x8 Bf = *(const bf16x8*)(ST + (w * 16 + fr) * SN + kc * 32 + fq * 8);
                acc4[mt2] = __builtin_amdgcn_mfma_f32_16x16x32_bf16(A, Bf, acc4[mt2], 0, 0, 0);
            }
        }
    }
    __syncthreads();
    {
        const bf16x8 Xf = *(const bf16x8*)(XT + (w * 16 + fr) * SS + fq * 8);
#pragma unroll
        for (int mt2 = 0; mt2 < 2; ++mt2) {
            const bf16x8 A = *(const bf16x8*)(Pm + (mt2 * 16 + fr) * SS + fq * 8);
            f32x4 a3 = (f32x4){0.f, 0.f, 0.f, 0.f};
            a3 = __builtin_amdgcn_mfma_f32_16x16x32_bf16(A, Xf, a3, 0, 0, 0);
#pragma unroll
            for (int r = 0; r < 4; ++r) { const int t = mt2 * 16 + fq * 4 + r; yL[t * 64 + w * 16 + fr] = a3[r] + eL[t] * acc4[mt2][r]; }
        }
        const float dtot = __expf(totL[0]);
#pragma unroll
        for (int n8 = 0; n8 < NT; ++n8) {
            const bf16x8 Bf = *(const bf16x8*)(BwT + (n8 * 16 + fr) * SS + fq * 8);
            accS[n8] = accS[n8] * dtot;
            accS[n8] = __builtin_amdgcn_mfma_f32_16x16x32_bf16(Xf, Bf, accS[n8], 0, 0, 0);
#pragma unroll
            for (int r = 0; r < 4; ++r) ST[(w * 16 + fq * 4 + r) * SN + n8 * 16 + fr] = f2bf(accS[n8][r]);
        }
    }
    __syncthreads();
}

template <int NK, bool DX>
__device__ __forceinline__ void cs_writeout(unsigned char* base, bf16_t* pp, u32x4 pv, int tl, float Dh) {
    typedef CsL<NK> L;
    const float* yL = (const float*)(base + ((NK == 128) ? L::O_BN : L::O_Y));
    const bf16_t* XT = (const bf16_t*)(base + L::O_XT);
    const int t = tl >> 3, pg = tl & 7;
    const f32x4 ya = *(const f32x4*)(yL + t * 64 + pg * 8), yb = *(const f32x4*)(yL + t * 64 + pg * 8 + 4);
    float y[8] = {ya.x, ya.y, ya.z, ya.w, yb.x, yb.y, yb.z, yb.w};
    const unsigned pa[4] = {pv.x, pv.y, pv.z, pv.w};
#pragma unroll
    for (int j = 0; j < 4; ++j) { y[2 * j] += bflo(pa[j]); y[2 * j + 1] += bfhi(pa[j]); }
    if (DX) {
#pragma unroll
        for (int j = 0; j < 8; ++j) y[j] += Dh * bf2f(XT[(pg * 8 + j) * L::SS + t]);
    }
    u32x4 o; o.x = pk2(y[0], y[1]); o.y = pk2(y[2], y[3]); o.z = pk2(y[4], y[5]); o.w = pk2(y[6], y[7]);
    *(u32x4*)pp = o;
}

__device__ __forceinline__ void ssd_scan_item(CParams& p_in, int l_in, int item, unsigned char* smem) {
    CParams* pq_ = &p_in; asm volatile("" : "+s"(pq_)); CParams& p = *pq_;
    int l = l_in; asm volatile("" : "+s"(l));
    const int tidx = opaque_tid();
    typedef CsL<128> L;
    constexpr int SN = L::SN, SS = L::SS;
    const int b = item >> 4, h = item & 15, g = h >> 3;
    const int tid = tidx, dir = tid >> 8, tl = tid & 255, lane = tid & 63, w = tl >> 6, fr = lane & 15, fq = lane >> 4;
    unsigned char* base = smem + dir * 76800;
    bf16_t* Cn = (bf16_t*)(base + L::O_CN); bf16_t* Bn = (bf16_t*)(base + L::O_BN); bf16_t* BwT = (bf16_t*)(base + L::O_BWT);
    bf16_t* XT = (bf16_t*)(base + L::O_XT); bf16_t* ST = (bf16_t*)(base + L::O_ST);
    float* cumL = (float*)(base + L::O_F); float* dtL = cumL + 32; float* eL = dtL + 32; float* wL = eL + 32; float* totL = eL + 64;
    bf16_t* rawL = (bf16_t*)(base + L::O_RAW);
    const bf16_t* XBC = (const bf16_t*)(p.ws + OFF_XBC);
    const float* DT = (const float*)(p.ws + OFF_DT);
    bf16_t* P = (bf16_t*)(p.ws + OFF_H);
    const float* cw = p.in[8] + (size_t)l * 5 * 1536; const float* cbias = p.in[9] + (size_t)l * 1536;
    const float dtb = p.in[10][l * 32 + dir * 16 + h];
    const float aneg = -__expf(p.in[11][l * 32 + dir * 16 + h]);
    const float Dh = p.in[12][l * 16 + h];
    const int xc1 = 1024 + g * 128 + (tl & 127) * 2;
    const int xc1c = ((tl & 127) < 64) ? xc1 : 1280 + g * 128 + ((tl & 127) - 64) * 2;
    const f32x2_t cw0 = {cw[xc1c], cw[xc1c + 1]}, cw1 = {cw[1536 + xc1c], cw[1536 + xc1c + 1]}, cw2 = {cw[2 * 1536 + xc1c], cw[2 * 1536 + xc1c + 1]},
                  cw3 = {cw[3 * 1536 + xc1c], cw[3 * 1536 + xc1c + 1]}, cw4 = {cw[4 * 1536 + xc1c], cw[4 * 1536 + xc1c + 1]}, cwb = {cbias[xc1c], cbias[xc1c + 1]};
    const int xc2 = h * 64 + (tl & 63);
    const float c20 = cw[xc2], c21 = cw[1536 + xc2], c22 = cw[2 * 1536 + xc2], c23 = cw[3 * 1536 + xc2], c24 = cw[4 * 1536 + xc2], c2b = cbias[xc2];
    for (int i = tl; i < 64 * SN; i += 256) ST[i] = 0;
    f32x4 accS[8];
#pragma unroll
    for (int i = 0; i < 8; ++i) accS[i] = (f32x4){0.f, 0.f, 0.f, 0.f};
    u32x4 rv[6]; float dtr = 0.f;
    int pf_rr[6], pf_off[6], pf_lds[6];
#pragma unroll
    for (int i = 0; i < 6; ++i) {
        const int e = tl + 256 * i; const int rr = e / 40, ch = e - rr * 40;
        const int xc = ch < 16 ? 1024 + g * 128 + ch * 8 : (ch < 32 ? 1280 + g * 128 + (ch - 16) * 8 : h * 64 + (ch - 32) * 8);
        pf_rr[i] = rr; pf_off[i] = rr * 1536 + xc; pf_lds[i] = (e < 36 * 40) ? rr * 320 + ch * 8 : -1;
    }
#define SSD_PREFETCH(tau_) do { int low_, s0_, s1_; bool ic_, fi_; scan_tile(b, dir, (tau_), low_, s0_, s1_, ic_, fi_); \
        const bf16_t* rb_ = XBC + (size_t)(low_ - 2) * 1536; \
        _Pragma("unroll") for (int i = 0; i < 6; ++i) { \
            const int row = low_ - 2 + pf_rr[i]; \
            rv[i] = (u32x4){0u, 0u, 0u, 0u}; \
            if (pf_lds[i] >= 0 && row >= s0_ && row < s1_) rv[i] = *(const u32x4*)(rb_ + pf_off[i]); } \
        if (tl < 32) dtr = DT[(size_t)(low_ + tl) * 32 + dir * 16 + h]; } while (0)
    SSD_PREFETCH(0);
    for (int tau = 0; tau < 264; ++tau) {
        int low, s0, s1; bool isctx, first;
        scan_tile(b, dir, tau, low, s0, s1, isctx, first);
#pragma unroll
        for (int i = 0; i < 6; ++i) { if (pf_lds[i] >= 0) *(u32x4*)(rawL + pf_lds[i]) = rv[i]; }
        if (tl < 64) {
            const float dt = fast_softplus(dtr + dtb);
            const float la = dt * aneg;
            float c = la;
#pragma unroll
            for (int o = 1; o < 32; o <<= 1) { const float v = __shfl_up(c, o); if (lane >= o) c += v; }
            const float total = __shfl(c, 31);
            const float cd = dir ? (total - c + la) : c;
            if (tl < 32) { cumL[tl] = cd; dtL[tl] = dt; eL[tl] = __expf(cd); wL[tl] = __expf(total - cd) * dt; if (tl == 0) totL[0] = total; }
        }
        bf16_t* pp = P + (size_t)(low + (tl >> 3)) * 1024 + h * 64 + (tl & 7) * 8;
        const bool late = (tau == 4) || (tau == 136);
        u32x4 pv = (u32x4){0u, 0u, 0u, 0u};
        if (!first && !late) pv = *(const u32x4*)pp;
        __syncthreads();
        {
            const bf16_t* __restrict__ rawR = rawL;
            {
                const int cp = tl & 127, th = tl >> 7, c0 = cp * 2, tb = th * 16;
                f32x2_t q0, q1, q2, q3;
                { const unsigned a = *(const unsigned*)(rawR + (tb) * 320 + c0), bq = *(const unsigned*)(rawR + (tb + 1) * 320 + c0), cq = *(const unsigned*)(rawR + (tb + 2) * 320 + c0), dq = *(const unsigned*)(rawR + (tb + 3) * 320 + c0);
                  q0 = (f32x2_t){bflo(a), bfhi(a)}; q1 = (f32x2_t){bflo(bq), bfhi(bq)}; q2 = (f32x2_t){bflo(cq), bfhi(cq)}; q3 = (f32x2_t){bflo(dq), bfhi(dq)}; }
#pragma unroll 8
                for (int j = 0; j < 16; ++j) {
                    const int t = tb + j;
                    const unsigned e = *(const unsigned*)(rawR + (t + 4) * 320 + c0);
                    const f32x2_t q4 = {bflo(e), bfhi(e)};
                    f32x2_t o = __builtin_elementwise_fma(cw4, q4, cwb);
                    o = __builtin_elementwise_fma(cw3, q3, o); o = __builtin_elementwise_fma(cw2, q2, o);
                    o = __builtin_elementwise_fma(cw1, q1, o); o = __builtin_elementwise_fma(cw0, q0, o);
                    o.x = siluf_(o.x); o.y = siluf_(o.y);
                    if (cp < 64) {
                        *(unsigned*)(Bn + t * SN + c0) = pk2(o.x, o.y);
                        const float wt = wL[t];
                        const unsigned bw = pk2(o.x * wt, o.y * wt);
                        BwT[c0 * SS + t] = (bf16_t)(bw & 0xffffu); BwT[(c0 + 1) * SS + t] = (bf16_t)(bw >> 16);
                    } else *(unsigned*)(Cn + t * SN + c0 - 128) = pk2(o.x, o.y);
                    q0 = q1; q1 = q2; q2 = q3; q3 = q4;
                }
            }
            const int xcol = 256 + (tl & 63), tq = tl >> 6;
            float q0 = bf2f(rawL[(tq * 8) * 320 + xcol]), q1 = bf2f(rawL[(tq * 8 + 1) * 320 + xcol]), q2 = bf2f(rawL[(tq * 8 + 2) * 320 + xcol]), q3 = bf2f(rawL[(tq * 8 + 3) * 320 + xcol]);
            unsigned xo[4];
#pragma unroll
            for (int j = 0; j < 8; ++j) {
                const float q4 = bf2f(rawL[(tq * 8 + j + 4) * 320 + xcol]);
                const float o = siluf_(c20 * q0 + c21 * q1 + c22 * q2 + c23 * q3 + c24 * q4 + c2b);
                if (j & 1) xo[j >> 1] |= ((unsigned)f2bf(o)) << 16; else xo[j >> 1] = f2bf(o);
                q0 = q1; q1 = q2; q2 = q3; q3 = q4;
            }
            *(u32x4*)(XT + (tl & 63) * SS + tq * 8) = (u32x4){xo[0], xo[1], xo[2], xo[3]};
        }
        __syncthreads();
        if (!first && late) pv = *(const u32x4*)pp;
        if (tau + 1 < 264) SSD_PREFETCH(tau + 1);
        cs_core<128>(base, accS, dir, w, fr, fq);
        cs_writeout<128, true>(base, pp, pv, tl, first ? 0.f : Dh);
    }
#undef SSD_PREFETCH
}

__device__ __forceinline__ void ret_scan_item(CParams& p_in, int l_in, int item, unsigned char* smem) {
    CParams* pq_ = &p_in; asm volatile("" : "+s"(pq_)); CParams& p = *pq_;
    int l = l_in; asm volatile("" : "+s"(l));
    const int tidx = opaque_tid();
    typedef CsL<64> L;
    constexpr int SN = L::SN, SS = L::SS;
    const int b = item >> 3, hd = (item >> 1) & 3, phalf = item & 1;
    const int tid = tidx, dir = tid >> 8, tl = tid & 255, lane = tid & 63, w = tl >> 6, fr = lane & 15, fq = lane >> 4;
    unsigned char* base = smem + dir * 76800;
    bf16_t* Cn = (bf16_t*)(base + L::O_CN); bf16_t* Bn = (bf16_t*)(base + L::O_BN); bf16_t* BwT = (bf16_t*)(base + L::O_BWT);
    bf16_t* XT = (bf16_t*)(base + L::O_XT); bf16_t* ST = (bf16_t*)(base + L::O_ST);
    float* cumL = (float*)(base + L::O_F); float* dtL = cumL + 32; float* eL = dtL + 32; float* wL = eL + 32; float* totL = eL + 64;
    bf16_t* rawL = (bf16_t*)(base + L::O_RAW);
    const bf16_t* QKV = (const bf16_t*)(p.ws + OFF_QKV);
    bf16_t* P = (bf16_t*)(p.ws + OFF_PRET);
    const float lg = -fast_softplus(-p.in[14][l * 8 + dir * 4 + hd]);
    if (tl < 32) {
        const float cd = dir ? (float)(32 - tl) * lg : (float)(tl + 1) * lg;
        const float total = 32.f * lg;
        cumL[tl] = cd; dtL[tl] = 1.f; eL[tl] = __expf(cd); wL[tl] = __expf(total - cd); if (tl == 0) totL[0] = total;
    }
    for (int i = tl; i < 64 * SN; i += 256) ST[i] = 0;
    f32x4 accS[4];
#pragma unroll
    for (int i = 0; i < 4; ++i) accS[i] = (f32x4){0.f, 0.f, 0.f, 0.f};
    const int pairidx = tl & 63, tq = tl >> 6, which = pairidx >> 5, pi = pairidx & 31;
    const float inv = exp2f(-(float)(pi & 15) * (13.287712379549449f / 16.f));
    u32x4 rv[3];
#define RET_PREFETCH(tau_) do { int low_, s0_, s1_; bool ic_, fi_; scan_tile(b, dir, (tau_), low_, s0_, s1_, ic_, fi_); \
        _Pragma("unroll") for (int i = 0; i < 3; ++i) { \
            const int e = tl + 256 * i; const int rr = e / 24, ch = e - rr * 24; \
            const int col = ch < 8 ? hd * 64 + ch * 8 : (ch < 16 ? 256 + hd * 64 + (ch - 8) * 8 : 512 + hd * 128 + phalf * 64 + (ch - 16) * 8); \
            rv[i] = *(const u32x4*)(QKV + (size_t)(low_ + rr) * 1024 + col); } } while (0)
    RET_PREFETCH(0);
    for (int tau = 0; tau < 264; ++tau) {
        int low, s0, s1; bool isctx, first;
        scan_tile(b, dir, tau, low, s0, s1, isctx, first);
#pragma unroll
        for (int i = 0; i < 3; ++i) { const int e = tl + 256 * i; const int rr = e / 24, ch = e - rr * 24; *(u32x4*)(rawL + rr * 192 + ch * 8) = rv[i]; }
        bf16_t* pp = P + (size_t)(low + (tl >> 3)) * 512 + hd * 128 + phalf * 64 + (tl & 7) * 8;
        const bool late = (tau == 4) || (tau == 136);
        u32x4 pv = (u32x4){0u, 0u, 0u, 0u};
        if (!first && !late) pv = *(const u32x4*)pp;
        __syncthreads();
        {
#pragma unroll
            for (int j = 0; j < 8; ++j) {
                const int t = tq * 8 + j;
                const unsigned raw = *(const unsigned*)(rawL + t * 192 + which * 64 + 2 * pi);
                const float x1 = bflo(raw), x2 = bfhi(raw);
                float c = 1.f, s = 0.f;
                if (!isctx) { const int pos = low + t - s0; const float ppos = (pi < 16) ? (float)(pos >> 6) : (float)(pos & 63); const float ang = ppos * inv; c = __cosf(ang); s = __sinf(ang); }
                const float o1 = x1 * c - x2 * s, o2 = x1 * s + x2 * c;
                if (which == 0) *(unsigned*)(Cn + t * SN + 2 * pi) = pk2(o1, o2);
                else {
                    const float k1 = o1 * 0.125f, k2 = o2 * 0.125f, wt = wL[t];
                    *(unsigned*)(Bn + t * SN + 2 * pi) = pk2(k1, k2);
                    BwT[(2 * pi) * SS + t] = f2bf(k1 * wt); BwT[(2 * pi + 1) * SS + t] = f2bf(k2 * wt);
                }
            }
            unsigned xo[4];
#pragma unroll
            for (int j = 0; j < 8; ++j) { const unsigned v = rawL[(tq * 8 + j) * 192 + 128 + pairidx]; if (j & 1) xo[j >> 1] |= v << 16; else xo[j >> 1] = v; }
            *(u32x4*)(XT + pairidx * SS + tq * 8) = (u32x4){xo[0], xo[1], xo[2], xo[3]};
        }
        __syncthreads();
        if (!first && late) pv = *(const u32x4*)pp;
        if (tau + 1 < 264) RET_PREFETCH(tau + 1);
        cs_core<64>(base, accS, dir, w, fr, fq);
        cs_writeout<64, false>(base, pp, pv, tl, 0.f);
    }
#undef RET_PREFETCH
}

__device__ __forceinline__ void shift_phase(CParams& p_in, int l_in, int part, unsigned char* smem) {
    CParams* pq_ = &p_in; asm volatile("" : "+s"(pq_)); CParams& p = *pq_;
    int l = l_in; asm volatile("" : "+s"(l));
    const int tidx = opaque_tid();
    bf16_t* RW = (bf16_t*)(p.ws + OFF_RW);
    u32x2* halo = (u32x2*)smem;
    const int c0 = tidx * 4;
    if (tidx >= 448) return;
    if (part == 0) {
        for (int k = 0; k < 5; ++k) {
            const int chunk = blockIdx.x + k * gridDim.x; if (chunk >= R / 32) break;
            const int lo = chunk * 32; int s0, s1;
            if (lo < RL) { s0 = lo & ~8191; s1 = s0 + 8192; } else { s0 = RL + ((lo - RL) & ~255); s1 = s0 + 256; }
            u32x2 a = (u32x2){0u, 0u}, b = (u32x2){0u, 0u};
            if (lo - 1 >= s0) a = *(const u32x2*)(RW + (size_t)(lo - 1) * 1792 + c0);
            if (lo + 32 < s1) b = *(const u32x2*)(RW + (size_t)(lo + 32) * 1792 + c0);
            halo[(k * 2 + 0) * 448 + tidx] = a; halo[(k * 2 + 1) * 448 + tidx] = b;
        }
        return;
    }
    const f32x4 mx = *(const f32x4*)(p.in[15] + (size_t)l * 1792 + c0);
    const int kind = (c0 >= 1536 && c0 < 1600) ? 1 : (c0 >= 1664 ? 2 : 0);
    for (int k = 0; k < 5; ++k) {
        const int chunk = blockIdx.x + k * gridDim.x; if (chunk >= R / 32) break;
        bf16_t* base = RW + (size_t)chunk * 32 * 1792 + c0;
        u32x2 rows[34];
        rows[0] = halo[(k * 2 + 0) * 448 + tidx]; rows[33] = halo[(k * 2 + 1) * 448 + tidx];
#pragma unroll
        for (int t = 0; t < 32; ++t) rows[t + 1] = *(const u32x2*)(base + (size_t)t * 1792);
#pragma unroll
        for (int t = 0; t < 32; ++t) {
            const u32x2 a = rows[t], b = rows[t + 1], c = rows[t + 2];
            f32x4 u0 = (f32x4){bflo(a.x), bfhi(a.x), bflo(a.y), bfhi(a.y)}, u1 = (f32x4){bflo(b.x), bfhi(b.x), bflo(b.y), bfhi(b.y)}, u2 = (f32x4){bflo(c.x), bfhi(c.x), bflo(c.y), bfhi(c.y)};
            f32x4 v = u1 + mx * ((u0 + u2) * 0.5f - u1);
            if (kind == 1) { v.x = fast_tanh(v.x); v.y = fast_tanh(v.y); v.z = fast_tanh(v.z); v.w = fast_tanh(v.w); }
            else if (kind == 2) { v.x = sigmoidf_(v.x); v.y = sigmoidf_(v.y); v.z = sigmoidf_(v.z); v.w = sigmoidf_(v.w); }
            u32x2 o; o.x = pk2(v.x, v.y); o.y = pk2(v.z, v.w);
            *(u32x2*)(base + (size_t)t * 1792) = o;
        }
    }
}

__device__ __forceinline__ void rwkv_scan_item(CParams& p_in, int l_in, int item, unsigned char* smem) {
    CParams* pq_ = &p_in; asm volatile("" : "+s"(pq_)); CParams& p = *pq_;
    int l = l_in; asm volatile("" : "+s"(l));
    const int tidx = opaque_tid();
    const int b = item >> 5, h = (item >> 2) & 7, rq = item & 3;
    const int tid = tidx, dir = tid >> 8, tl = tid & 255, lane = tid & 63, wv = tl >> 6;
    const int kq = lane & 15, rloc = wv * 4 + (lane >> 4);
    const int fr = lane & 15, fq = lane >> 4;
    unsigned char* base = smem + dir * 67072;
    float* rL = (float*)base;
    float *kL = rL + 2048, *wL = kL + 2048, *bL = wL + 2048, *nkL = bL + 2048, *vL = nkL + 2048, *yL = vL + 1024;
    float* kdL = (float*)(base + 58880);
    bf16_t* twB = (bf16_t*)(yL + 1024);
    bf16_t* aloB = twB + 2048;
    float* invn = (float*)(aloB + 2048);
    const bf16_t* RW = (const bf16_t*)(p.ws + OFF_RW);
    bf16_t* P = (bf16_t*)(p.ws + OFF_PRW);
    const int cch = h * 64 + wv * 16 + fr;
    bf16x8 Bw[2], Ba[2];
    {
        const float* w2g = p.in[17] + ((size_t)(l * 2 + dir) * 64) * 512 + cch;
        const float* a2g = p.in[19] + ((size_t)l * 64) * 512 + cch;
#pragma unroll
        for (int kc = 0; kc < 2; ++kc)
#pragma unroll
            for (int e = 0; e < 8; ++e) {
                const int j = kc * 32 + fq * 8 + e;
                Bw[kc][e] = (short)f2bf(w2g[(size_t)j * 512]); Ba[kc][e] = (short)f2bf(a2g[(size_t)j * 512]);
            }
    }
    const float w0c = p.in[16][(l * 2 + dir) * 512 + cch], a0c = p.in[18][(l * 2 + dir) * 512 + cch];
    const float kkc = p.in[21][l * 512 + cch], kac = p.in[22][l * 512 + cch];
    const int t2 = tl >> 3, part2 = tl & 7;
    f32x4 kk2a = *(const f32x4*)(p.in[21] + l * 512 + h * 64 + part2 * 8), kk2b = *(const f32x4*)(p.in[21] + l * 512 + h * 64 + part2 * 8 + 4);
    float S[4];
#pragma unroll
    for (int i = 0; i < 4; ++i) S[i] = 0.f;
    u32x4 rv[5];
    int pf_off[5], pf_dst[5], pf_mode[5];
#pragma unroll
    for (int i = 0; i < 5; ++i) {
        const int e = tl + 256 * i; const int rr = e / 34, ch = e - rr * 34;
        const int col = ch < 8 ? h * 64 + ch * 8 : (ch < 16 ? 512 + h * 64 + (ch - 8) * 8 : (ch < 32 ? 1536 + (ch - 16) * 8 : 1024 + h * 64 + rq * 16 + (ch - 32) * 8));
        pf_off[i] = rr * 1792 + col;
        int dst, mode;
        if (ch < 8) { dst = (int)((unsigned char*)(rL + rr * 64 + ch * 8) - base); mode = 0; }
        else if (ch < 16) { dst = (int)((unsigned char*)(kL + rr * 64 + (ch - 8) * 8) - base); mode = 0; }
        else if (ch < 24) { dst = (int)((unsigned char*)(twB + rr * 64 + (ch - 16) * 8) - base); mode = 1; }
        else if (ch < 32) { dst = (int)((unsigned char*)(aloB + rr * 64 + (ch - 24) * 8) - base); mode = 1; }
        else { dst = (int)((unsigned char*)(vL + rr * 16 + (ch - 32) * 8) - base); mode = 0; }
        pf_dst[i] = dst; pf_mode[i] = (e < 32 * 34) ? mode : -1;
    }
#define RW_PREFETCH(tau_) do { int low_, s0_, s1_; bool ic_, fi_; scan_tile(b, dir, (tau_), low_, s0_, s1_, ic_, fi_); \
        const bf16_t* rb_ = RW + (size_t)low_ * 1792; \
        _Pragma("unroll") for (int i = 0; i < 5; ++i) { \
            rv[i] = (u32x4){0u, 0u, 0u, 0u}; \
            if (pf_mode[i] >= 0) rv[i] = *(const u32x4*)(rb_ + pf_off[i]); } } while (0)
    RW_PREFETCH(0);
    for (int tau = 0; tau < 264; ++tau) {
        int low, s0, s1; bool isctx, first;
        scan_tile(b, dir, tau, low, s0, s1, isctx, first);
#pragma unroll
        for (int i = 0; i < 5; ++i) {
            if (pf_mode[i] == 1) *(u32x4*)(base + pf_dst[i]) = rv[i];
            else if (pf_mode[i] == 0) {
                *(f32x4*)(base + pf_dst[i]) = (f32x4){bflo(rv[i].x), bfhi(rv[i].x), bflo(rv[i].y), bfhi(rv[i].y)};
                *(f32x4*)(base + pf_dst[i] + 16) = (f32x4){bflo(rv[i].z), bfhi(rv[i].z), bflo(rv[i].w), bfhi(rv[i].w)};
            }
        }
        bf16_t* pp = P + (size_t)(low + t2) * 512 + h * 64 + rq * 16 + part2 * 2;
        const bool late = (tau == 4) || (tau == 136);
        unsigned pv = 0u;
        if (!first && !late) pv = *(const unsigned*)pp;
        __syncthreads();
        {
            const f32x4 ka = *(const f32x4*)(kL + t2 * 64 + part2 * 8), kb = *(const f32x4*)(kL + t2 * 64 + part2 * 8 + 4);
            const f32x4 pa = ka * kk2a, pb = kb * kk2b;
            float ss = pa.x * pa.x + pa.y * pa.y + pa.z * pa.z + pa.w * pa.w + pb.x * pb.x + pb.y * pb.y + pb.z * pb.z + pb.w * pb.w;
            ss = red8(ss);
            if (part2 == 0) { const float iv = __builtin_amdgcn_rcpf(fmaxf(sqrtf(ss), 1e-12f)); invn[t2] = iv * iv; }
        }
        f32x4 accw[2], acca[2];
#pragma unroll
        for (int mt = 0; mt < 2; ++mt) {
            accw[mt] = (f32x4){0.f, 0.f, 0.f, 0.f}; acca[mt] = (f32x4){0.f, 0.f, 0.f, 0.f};
#pragma unroll
            for (int kc = 0; kc < 2; ++kc) {
                const bf16x8 Aw = *(const bf16x8*)(twB + (mt * 16 + fr) * 64 + kc * 32 + fq * 8);
                const bf16x8 Aa = *(const bf16x8*)(aloB + (mt * 16 + fr) * 64 + kc * 32 + fq * 8);
                accw[mt] = __builtin_amdgcn_mfma_f32_16x16x32_bf16(Aw, Bw[kc], accw[mt], 0, 0, 0);
                acca[mt] = __builtin_amdgcn_mfma_f32_16x16x32_bf16(Aa, Ba[kc], acca[mt], 0, 0, 0);
            }
        }
#pragma unroll
        for (int mt = 0; mt < 2; ++mt)
#pragma unroll
            for (int r = 0; r < 4; ++r) {
                const int t = mt * 16 + fq * 4 + r, c = wv * 16 + fr;
                const float wl = w0c + accw[mt][r];
                const float decay = __expf(-0.6065306597f * sigmoidf_(wl));
                const float a = sigmoidf_(a0c + acca[mt][r]);
                const float kraw = kL[t * 64 + c];
                const float kk = kraw * kkc;
                wL[t * 64 + c] = decay;
                kdL[t * 64 + c] = kraw * (1.f + (a - 1.f) * kac);
                bL[t * 64 + c] = kk * a;
                nkL[t * 64 + c] = -kk;
            }
        __syncthreads();
        if (!first && late) pv = *(const unsigned*)pp;
        if (tau + 1 < 264) RW_PREFETCH(tau + 1);
        {
            const float* __restrict__ nkR = nkL + kq * 4; const float* __restrict__ wR = wL + kq * 4; const float* __restrict__ bR = bL + kq * 4;
            const float* __restrict__ kR = kdL + kq * 4; const float* __restrict__ rR = rL + kq * 4; const float* __restrict__ vR = vL + rloc;
            float* __restrict__ yW = yL + rloc;
            const int t0 = dir ? 31 : 0, dt = dir ? -1 : 1;
            f32x4 n0 = *(const f32x4*)(nkR + t0 * 64), wa = *(const f32x4*)(wR + t0 * 64), ba = *(const f32x4*)(bR + t0 * 64);
            f32x4 ka = *(const f32x4*)(kR + t0 * 64), ra = *(const f32x4*)(rR + t0 * 64);
            float vv = vR[t0 * 16], iv2 = invn[t0];
            f32x2_t S01 = {S[0], S[1]}, S23 = {S[2], S[3]};
            float yprev = 0.f; int tprev = t0;
#pragma unroll 2
            for (int j = 0; j < 32; ++j) {
                const int tt = t0 + dt * j;
                const int tn = (j < 31) ? tt + dt : tt;
                const f32x4 n0n = *(const f32x4*)(nkR + tn * 64), wan = *(const f32x4*)(wR + tn * 64), ban = *(const f32x4*)(bR + tn * 64);
                const f32x4 kan = *(const f32x4*)(kR + tn * 64), ran = *(const f32x4*)(rR + tn * 64);
                const float vvn = vR[tn * 16], iv2n = invn[tn];
                f32x2_t pp2 = S01 * (f32x2_t){n0.x, n0.y};
                pp2 = __builtin_elementwise_fma(S23, (f32x2_t){n0.z, n0.w}, pp2);
                float ra_ = pp2.x + pp2.y, rb_ = yprev;
                ra_ += dppf<0xB1>(ra_); rb_ += dppf<0xB1>(rb_);
                ra_ += dppf<0x4E>(ra_); rb_ += dppf<0x4E>(rb_);
                ra_ += dppf<0x141>(ra_); rb_ += dppf<0x141>(rb_);
                ra_ += dppf<0x140>(ra_); rb_ += dppf<0x140>(rb_);
                if (kq == 0 && j > 0) yW[tprev * 16] = rb_;
                const float sa = ra_ * iv2;
                const f32x2_t sav = {sa, sa}, vvv = {vv, vv};
                f32x2_t t01 = vvv * (f32x2_t){ka.x, ka.y}, t23 = vvv * (f32x2_t){ka.z, ka.w};
                t01 = __builtin_elementwise_fma(sav, (f32x2_t){ba.x, ba.y}, t01);
                t23 = __builtin_elementwise_fma(sav, (f32x2_t){ba.z, ba.w}, t23);
                S01 = __builtin_elementwise_fma(S01, (f32x2_t){wa.x, wa.y}, t01);
                S23 = __builtin_elementwise_fma(S23, (f32x2_t){wa.z, wa.w}, t23);
                f32x2_t qq = S01 * (f32x2_t){ra.x, ra.y};
                qq = __builtin_elementwise_fma(S23, (f32x2_t){ra.z, ra.w}, qq);
                yprev = qq.x + qq.y; tprev = tt;
                n0 = n0n; wa = wan; ba = ban; ka = kan; ra = ran; vv = vvn; iv2 = iv2n;
            }
            { const float y = red16(yprev); if (kq == 0) yW[tprev * 16] = y; }
            S[0] = S01.x; S[1] = S01.y; S[2] = S23.x; S[3] = S23.y;
        }
        __syncthreads();
        {
            const float y0 = yL[t2 * 16 + part2 * 2], y1 = yL[t2 * 16 + part2 * 2 + 1];
            *(unsigned*)pp = pk2(bflo(pv) + y0, bfhi(pv) + y1);
        }
    }
#undef RW_PREFETCH
}

__device__ __forceinline__ void scan_phase(CParams& p, int l, unsigned char* smem) {
    for (int it = blockIdx.x; it < 224; it += gridDim.x) {
        if (it < 128) rwkv_scan_item(p, l, it, smem);
        else if (it < 192) ssd_scan_item(p, l, it - 128, smem);
        else ret_scan_item(p, l, it - 192, smem);
        __syncthreads();
    }
    int cb = (int)blockIdx.x - 224, cn = (int)gridDim.x - 224;
    if (cn <= 0) { cb = blockIdx.x; cn = gridDim.x; }
    if (cb >= 0) cvt_mix(p, l, smem, cb, cn);
}

__device__ __forceinline__ void post_phase(CParams& p_in, int l_in, int nrows, unsigned char* smem) {
    CParams* pq_ = &p_in; asm volatile("" : "+s"(pq_)); CParams& p = *pq_;
    int l = l_in; asm volatile("" : "+s"(l));
    const int tidx = opaque_tid();
    const int lane = tidx & 63, gw = blockIdx.x * 8 + (tidx >> 6), ngw = gridDim.x * 8;
    unsigned char* ws = p.ws;
    const float* MOD = (const float*)(ws + OFF_MOD);
    for (int row = gw; row < nrows; row += ngw) {
        {
            const bf16_t* yp = (const bf16_t*)(ws + OFF_H) + (size_t)row * 1024 + lane * 16;
            bf16_t* zp = (bf16_t*)(ws + OFF_Z) + (size_t)row * 1024 + lane * 16;
            const float* nw = p.in[13] + (size_t)l * 1024 + lane * 16;
            float v[16]; float ss = 0.f;
#pragma unroll
            for (int q = 0; q < 2; ++q) {
                const u32x4 yr = *(const u32x4*)(yp + q * 8), zr = *(const u32x4*)(zp + q * 8);
                const unsigned ya[4] = {yr.x, yr.y, yr.z, yr.w}, za[4] = {zr.x, zr.y, zr.z, zr.w};
#pragma unroll
                for (int e = 0; e < 4; ++e) {
                    const float y0 = bflo(ya[e]), y1 = bfhi(ya[e]), z0 = bflo(za[e]), z1 = bfhi(za[e]);
                    const float a = y0 * siluf_(z0), c = y1 * siluf_(z1);
                    v[q * 8 + e * 2] = a; v[q * 8 + e * 2 + 1] = c; ss += a * a + c * c;
                }
            }
            ss = red16(ss); ss += __shfl_xor(ss, 16);
            const float rs = rsqrtf(ss * (1.f / 512.f) + 1e-6f);
#pragma unroll
            for (int q = 0; q < 2; ++q) {
                const f32x4 wa = *(const f32x4*)(nw + q * 8), wb = *(const f32x4*)(nw + q * 8 + 4);
                u32x4 o;
                o.x = pk2(v[q * 8 + 0] * rs * wa.x, v[q * 8 + 1] * rs * wa.y); o.y = pk2(v[q * 8 + 2] * rs * wa.z, v[q * 8 + 3] * rs * wa.w);
                o.z = pk2(v[q * 8 + 4] * rs * wb.x, v[q * 8 + 5] * rs * wb.y); o.w = pk2(v[q * 8 + 6] * rs * wb.z, v[q * 8 + 7] * rs * wb.w);
                *(u32x4*)(zp + q * 8) = o;
            }
        }
        {
            const bf16_t* yp = (const bf16_t*)(ws + OFF_PRET) + (size_t)row * 512 + lane * 8;
            bf16_t* gp = (bf16_t*)(ws + OFF_G) + (size_t)row * 512 + lane * 8;
            const u32x4 yr = *(const u32x4*)yp, gr = *(const u32x4*)gp;
            const unsigned ya[4] = {yr.x, yr.y, yr.z, yr.w}, ga[4] = {gr.x, gr.y, gr.z, gr.w};
            float v[8], gg[8]; float s = 0.f;
#pragma unroll
            for (int e = 0; e < 4; ++e) { v[2 * e] = bflo(ya[e]); v[2 * e + 1] = bfhi(ya[e]); gg[2 * e] = bflo(ga[e]); gg[2 * e + 1] = bfhi(ga[e]); s += v[2 * e] + v[2 * e + 1]; }
            s = red16(s);
            const float mean = s * (1.f / 128.f); float q2 = 0.f;
#pragma unroll
            for (int e = 0; e < 8; ++e) { v[e] -= mean; q2 += v[e] * v[e]; }
            q2 = red16(q2);
            const float rs = rsqrtf(q2 * (1.f / 128.f) + 1e-6f);
            u32x4 o;
            o.x = pk2(v[0] * rs * siluf_(gg[0]), v[1] * rs * siluf_(gg[1])); o.y = pk2(v[2] * rs * siluf_(gg[2]), v[3] * rs * siluf_(gg[3]));
            o.z = pk2(v[4] * rs * siluf_(gg[4]), v[5] * rs * siluf_(gg[5])); o.w = pk2(v[6] * rs * siluf_(gg[6]), v[7] * rs * siluf_(gg[7]));
            *(u32x4*)gp = o;
        }
        {
            const bool lat = row < RL; const int mi = lat ? (row >> 13) : 4;
            const float* xin;
            if (lat) xin = (l == 0) ? p.in[0] + (size_t)row * 1024 : p.out + (size_t)row * 1024;
            else xin = (l == 0) ? p.in[2] + (size_t)(row - RL) * 1024 : (const float*)(ws + OFF_CTXS) + (size_t)(row - RL) * 1024;
            const float* modl = MOD + (size_t)(l * 5 + mi) * 6144;
            row_pass(xin, nullptr, nullptr, nullptr, nullptr, true, p.in[4] + (l * 4 + 0) * 1024, modl, modl + 1024, (bf16_t*)(ws + OFF_XBC) + (size_t)row * 1024, lane);
        }
    }
    bf16_t* aB = (bf16_t*)smem;
    bf16_t* gB = aB + 32 * 72;
    float* asL = (float*)(smem + 13312);
    float* gsL = asL + 32 * 512;
    const bf16_t* RW = (const bf16_t*)(ws + OFF_RW);
    bf16_t* P = (bf16_t*)(ws + OFF_PRW);
    const float* mix = p.in[15] + (size_t)l * 1792;
    const int c = tidx;
    const float a0f = p.in[18][(l * 2 + 0) * 512 + c], a0b = p.in[18][(l * 2 + 1) * 512 + c];
    const float kac = p.in[22][l * 512 + c], rkc = p.in[23][l * 512 + c], lw = p.in[24][l * 512 + c], lb = p.in[25][l * 512 + c];
    const float mxr = mix[c], mxk = mix[512 + c], mxv = mix[1024 + c];
    const int wvB = tidx >> 6, frB = lane & 15, fqB = lane >> 4;
    const float* a2 = p.in[19] + (size_t)l * 64 * 512 + wvB * 64 + frB;
    const float* g2 = p.in[20] + (size_t)l * 128 * 512 + wvB * 64 + frB;
    for (int tile = blockIdx.x; tile < nrows / 32; tile += gridDim.x) {
        const int low = tile * 32;
        int s0, s1;
        if (low < RL) { s0 = low & ~8191; s1 = s0 + 8192; } else { s0 = RL + ((low - RL) & ~255); s1 = s0 + 256; }
        {
            for (int e = tidx; e < 32 * 24; e += 512) {
                const int t = e / 24, ch = e - t * 24;
                const u32x4 v = *(const u32x4*)(RW + (size_t)(low + t) * 1792 + 1600 + ch * 8);
                if (ch < 8) *(u32x4*)(aB + t * 72 + ch * 8) = v; else *(u32x4*)(gB + t * 136 + (ch - 8) * 8) = v;
            }
        }
        __syncthreads();
        {
            bf16x8 Aa[2][2], Ag[2][4];
#pragma unroll
            for (int mt = 0; mt < 2; ++mt) {
#pragma unroll
                for (int kc = 0; kc < 2; ++kc) Aa[mt][kc] = *(const bf16x8*)(aB + (mt * 16 + frB) * 72 + kc * 32 + fqB * 8);
#pragma unroll
                for (int kc = 0; kc < 4; ++kc) Ag[mt][kc] = *(const bf16x8*)(gB + (mt * 16 + frB) * 136 + kc * 32 + fqB * 8);
            }
#pragma unroll 1
            for (int nt = 0; nt < 4; ++nt) {
                bf16x8 ba[2], bg[4];
#pragma unroll
                for (int kc = 0; kc < 2; ++kc)
#pragma unroll
                    for (int e = 0; e < 8; ++e) ba[kc][e] = (short)f2bf(a2[(size_t)(kc * 32 + fqB * 8 + e) * 512 + nt * 16]);
#pragma unroll
                for (int kc = 0; kc < 4; ++kc)
#pragma unroll
                    for (int e = 0; e < 8; ++e) bg[kc][e] = (short)f2bf(g2[(size_t)(kc * 32 + fqB * 8 + e) * 512 + nt * 16]);
#pragma unroll
                for (int mt = 0; mt < 2; ++mt) {
                    f32x4 ca = (f32x4){0.f, 0.f, 0.f, 0.f}, cg = (f32x4){0.f, 0.f, 0.f, 0.f};
#pragma unroll
                    for (int kc = 0; kc < 2; ++kc) ca = __builtin_amdgcn_mfma_f32_16x16x32_bf16(Aa[mt][kc], ba[kc], ca, 0, 0, 0);
#pragma unroll
                    for (int kc = 0; kc < 4; ++kc) cg = __builtin_amdgcn_mfma_f32_16x16x32_bf16(Ag[mt][kc], bg[kc], cg, 0, 0, 0);
#pragma unroll
                    for (int r = 0; r < 4; ++r) {
                        const int idx = (mt * 16 + fqB * 4 + r) * 512 + wvB * 64 + nt * 16 + frB;
                        asL[idx] = ca[r]; gsL[idx] = cg[r];
                    }
                }
            }
        }
        __syncthreads();
        const bf16_t* u = RW + (size_t)low * 1792;
#pragma unroll 1
        for (int tb = 0; tb < 32; tb += 8) {
            bf16_t rr[8], kk8[8], vv8[8], yy[8];
#pragma unroll
            for (int i = 0; i < 8; ++i) {
                const bf16_t* un = u + (size_t)(tb + i) * 1792;
                rr[i] = un[c]; kk8[i] = un[512 + c]; vv8[i] = un[1024 + c]; yy[i] = P[(size_t)(low + tb + i) * 512 + c];
            }
#pragma unroll
            for (int i = 0; i < 8; ++i) {
                const int row = low + tb + i;
                const float r = bf2f(rr[i]), k = bf2f(kk8[i]), v = bf2f(vv8[i]), y = bf2f(yy[i]);
                const float ash = asL[(tb + i) * 512 + c];
                const float af = sigmoidf_(a0f + ash), ab = sigmoidf_(a0b + ash);
                const float ks = k * (2.f + (af + ab - 2.f) * kac);
                const float bsum = wave_sum(r * ks * rkc);
                const float mean = wave_sum(y) * (1.f / 64.f);
                const float d = y - mean;
                const float var = wave_sum(d * d) * (1.f / 64.f);
                const float yn = d * rsqrtf(var + 64e-5f) * lw + lb;
                P[(size_t)row * 512 + c] = f2bf((yn + bsum * v) * gsL[(tb + i) * 512 + c]);
            }
        }
        __syncthreads();
    }
}

__device__ __forceinline__ void flat_barrier(unsigned* cnt, unsigned target) {
    asm volatile("s_waitcnt vmcnt(0)" ::: "memory");
    __syncthreads();
    if (threadIdx.x == 0) {
        __builtin_amdgcn_fence(__ATOMIC_RELEASE, "agent");
        asm volatile("s_waitcnt vmcnt(0)" ::: "memory");
        __hip_atomic_fetch_add(cnt, 1u, __ATOMIC_RELAXED, __HIP_MEMORY_SCOPE_AGENT);
        while (__hip_atomic_load(cnt, __ATOMIC_RELAXED, __HIP_MEMORY_SCOPE_AGENT) < target) __builtin_amdgcn_s_sleep(1);
        __builtin_amdgcn_fence(__ATOMIC_ACQUIRE, "agent");
        asm volatile("s_waitcnt vmcnt(0)" ::: "memory");
    }
    __syncthreads();
}

__global__ void __launch_bounds__(512) mega(Params p_arg) {
    extern __shared__ __attribute__((aligned(16))) unsigned char smem[];
    CParams* pbase = (CParams*)__builtin_amdgcn_kernarg_segment_ptr();
    const int ph_lo = p_arg.ph_lo, ph_hi = p_arg.ph_hi;
    for (int ph = ph_lo; ph < ph_hi; ++ph) {
        CParams* pq = pbase;
        asm volatile("" : "+s"(pq));
        CParams& p = *pq;
        int gm = -1, l = 0, sub = -1;
        if (ph >= 2) { l = (ph - 2) / 11; sub = (ph - 2) % 11; }
        const int nrows = (l == 3) ? RL : R;
        if (sub == 0) gm = GM_IN; else if (sub == 5) gm = GM_MERGE; else if (sub == 6) gm = GM_OUT; else if (sub == 8) gm = GM_MLP1; else if (sub == 9) gm = GM_MLP2;
        if (gm >= 0) {
            gemm_phase(p, gm, gm == GM_IN ? 132 : nrows / 256, (LAS unsigned char*)smem);
            __syncthreads();
        } else if (ph == 0) {
            phase_mod(p, smem);
            cvt_win(p, 0, smem, blockIdx.x, gridDim.x);
        } else if (ph == 1) {
            token_phase(p, 0, 0, R);
        } else if (sub == 1) {
            shift_phase(p, l, 0, smem);
        } else if (sub == 2) {
            shift_phase(p, l, 1, smem);
        } else if (sub == 3) {
            scan_phase(p, l, smem);
        } else if (sub == 4) {
            post_phase(p, l, nrows, smem);
        } else if (sub == 7) {
            token_phase(p, l, 1, nrows);
            cvt_mlp(p, l, smem, blockIdx.x, gridDim.x);
        } else if (sub == 10) {
            token_phase(p, l, 2, nrows);
            if (l < 3) cvt_win(p, l + 1, smem, blockIdx.x, gridDim.x);
        }
        if (ph + 1 < ph_hi) {
            if (ph == ph_lo) { __threadfence(); cg::this_grid().sync(); }
            else flat_barrier((unsigned*)(p_arg.ws + OFF_BAR), (unsigned)(ph - ph_lo) * gridDim.x);
        }
    }
}

extern "C" void kernel_launch(void* const* d_in, const int* in_sizes, int n_in, void* d_out, int out_size, void* d_ws, size_t ws_size, hipStream_t stream) {
    static int grid = 0;
    if (grid == 0) {
        if (n_in != 32 || ws_size < WS_END) { fprintf(stderr, "kernel_launch: bad n_in %d or ws %zu < %zu\n", n_in, ws_size, (size_t)WS_END); grid = -1; return; }
        if (hipFuncSetAttribute((const void*)mega, hipFuncAttributeMaxDynamicSharedMemorySize, LDS_BYTES) != hipSuccess) { grid = -1; return; }
        int dev = 0, cus = 0, per_cu = 0;
        hipGetDevice(&dev);
        hipDeviceGetAttribute(&cus, hipDeviceAttributeMultiprocessorCount, dev);
        hipOccupancyMaxActiveBlocksPerMultiprocessor(&per_cu, (const void*)mega, 512, LDS_BYTES);
        (void)hipGetLastError();
        if (per_cu < 1) per_cu = 1;
        grid = cus * per_cu; if (grid > 256) grid = 256;
    }
    if (grid < 0) return;
    Params p{};
    for (int i = 0; i < 32; ++i) p.in[i] = (const float*)d_in[i];
    p.out = (float*)d_out; p.ws = (unsigned char*)d_ws;
    p.ph_lo = 0; p.ph_hi = NPH; p.coop = 1; p.pad = 0;
    if (hipMemsetAsync((char*)d_ws + OFF_BAR, 0, 64, stream) != hipSuccess) return;
    void* args[] = {&p};
    hipError_t e = hipLaunchCooperativeKernel((const void*)mega, dim3(grid), dim3(512), args, LDS_BYTES, stream);
    if (e != hipSuccess) fprintf(stderr, "cooperative launch failed: %s (grid %d)\n", hipGetErrorString(e), grid);
}
```

```cpp
#include <hip/hip_runtime.h>
#include <hip/hip_cooperative_groups.h>
#include <cstdint>
#include <cstdio>
namespace cg = cooperative_groups;

typedef unsigned short bf16_t;
typedef short bf16x8 __attribute__((ext_vector_type(8)));
typedef float f32x4 __attribute__((ext_vector_type(4)));
typedef unsigned u32x2 __attribute__((ext_vector_type(2)));
typedef unsigned u32x4 __attribute__((ext_vector_type(4)));

constexpr int RL = 32768;
constexpr int RC = 1024;
constexpr int R = RL + RC;
constexpr int LDS_BYTES = 153600;
constexpr int NPH = 2 + 11 * 4;
#ifndef PROBE_SCAN
#define PROBE_SCAN 0
#endif
#ifndef PROBE_GEMM
#define PROBE_GEMM 0
#endif

constexpr size_t OFF_MOD = 0;
constexpr size_t OFF_BAR = 491776;
constexpr size_t OFF_CTXS = 524288;
constexpr size_t OFF_DT = OFF_CTXS + 4194304;
constexpr size_t OFF_W = OFF_DT + (size_t)R * 32 * 4;
constexpr size_t OFF_H = OFF_W + 16777216;
constexpr size_t SZ1024 = (size_t)R * 1024 * 2;
constexpr size_t OFF_Z = OFF_H + SZ1024;
constexpr size_t OFF_XBC = OFF_Z + SZ1024;
constexpr size_t OFF_QKV = OFF_XBC + (size_t)R * 1536 * 2;
constexpr size_t OFF_G = OFF_QKV + SZ1024;
constexpr size_t OFF_RW = OFF_G + (size_t)R * 512 * 2;
constexpr size_t OFF_PRET = OFF_RW + (size_t)R * 1792 * 2;
constexpr size_t OFF_PRW = OFF_PRET + (size_t)R * 512 * 2;
constexpr size_t WS_END = OFF_PRW + (size_t)R * 512 * 2;
constexpr size_t W_G = 0, W_SO = 6291456, W_RO = 8388608, W_WO = 9437184, W_O = 10485760;
constexpr size_t W_1 = 0, W_2 = 8388608;
constexpr size_t MSCR_S = 0, MSCR_M = (size_t)256 * 131072;

struct Params {
    const float* in[32];
    float* out;
    unsigned char* ws;
    int ph_lo, ph_hi, coop, pad;
};

typedef const __attribute__((address_space(4))) Params CParams;

__device__ __forceinline__ float bf2f(bf16_t h) { return __uint_as_float(((unsigned)h) << 16); }
__device__ __forceinline__ float bflo(unsigned u) { return __uint_as_float(u << 16); }
__device__ __forceinline__ float bfhi(unsigned u) { return __uint_as_float(u & 0xffff0000u); }
typedef float f32x2_t __attribute__((ext_vector_type(2)));
typedef __bf16 bf16x2_t __attribute__((ext_vector_type(2)));
__device__ __forceinline__ unsigned pk2(float a, float b) { const f32x2_t v = {a, b}; const bf16x2_t r = __builtin_convertvector(v, bf16x2_t); return __builtin_bit_cast(unsigned, r); }
__device__ __forceinline__ bf16_t f2bf(float f) { const __bf16 r = (__bf16)f; return __builtin_bit_cast(unsigned short, r); }
template <int CTRL> __device__ __forceinline__ float dppf(float v) {
    return __builtin_bit_cast(float, __builtin_amdgcn_update_dpp(0, __builtin_bit_cast(int, v), CTRL, 0xf, 0xf, true));
}
__device__ __forceinline__ float red4(float v) { v += dppf<0xB1>(v); v += dppf<0x4E>(v); return v; }
__device__ __forceinline__ float red8(float v) { v = red4(v); v += dppf<0x141>(v); return v; }
__device__ __forceinline__ float red16(float v) { v = red8(v); v += dppf<0x140>(v); return v; }
__device__ __forceinline__ float wave_sum(float v) { v = red16(v); v += __shfl_xor(v, 16); v += __shfl_xor(v, 32); return v; }
__device__ __forceinline__ int opaque_tid() { int t = threadIdx.x; asm volatile("" : "+v"(t)); return t; }
__device__ __forceinline__ float sigmoidf_(float x) { return __builtin_amdgcn_rcpf(1.f + __expf(-x)); }
__device__ __forceinline__ float siluf_(float x) { return x * __builtin_amdgcn_rcpf(1.f + __expf(-x)); }
__device__ __forceinline__ float fast_tanh(float x) { return 1.f - 2.f * __builtin_amdgcn_rcpf(1.f + __expf(2.f * x)); }
__device__ __forceinline__ float fast_softplus(float x) { return x > 20.f ? x : __logf(1.f + __expf(x)); }
__device__ __forceinline__ float softplusf_(float x) { return x > 20.f ? x : log1pf(__expf(x)); }

constexpr int BK = 64, HALF = 128, HT = HALF * BK;
__device__ __forceinline__ int lds_byte(int r, int c) {
    int st = (r >> 4) * 2 + (c >> 5), rr = r & 15, cc = c & 31, ob = rr * 64 + cc * 2;
    return st * 1024 + (ob ^ (((ob >> 9) & 1) << 5));
}
__device__ __forceinline__ void stage_rc(int b, int& Rr, int& Cc) {
    int st = b / 1024, sb = b % 1024, swz = sb ^ (((sb >> 9) & 1) << 5);
    Rr = (st >> 1) * 16 + swz / 64; Cc = (st & 1) * 32 + (swz % 64) / 2;
}

#define LAS __attribute__((address_space(3)))
constexpr int HTB = HALF * BK * 2;

__device__ __forceinline__ bool tile_next(int i, int G, int c, int nM, int nN, int& pm, int& pn) {
    const int nwg = nM * nN;
    const long L = (long)i * G + c; if (L >= nwg) return false;
    int wgid = (int)L; { const int q = nwg / 8, r = nwg % 8, xcd = wgid % 8, off = wgid / 8; wgid = (xcd < r ? xcd * (q + 1) : r * (q + 1) + (xcd - r) * q) + off; }
    const int nig = 8 * nN, gid = wgid / nig, fm = gid * 8, gsz = (nM - fm) < 8 ? (nM - fm) : 8;
    pm = fm + ((wgid % nig) % gsz); pn = (wgid % nig) / gsz; return true;
}

enum { GM_IN = 0, GM_MERGE = 1, GM_OUT = 2, GM_MLP1 = 3, GM_MLP2 = 4 };
struct UnitInfo { const char* A; const char* B; int K, wt, mt, step; };

__device__ __forceinline__ bool get_unit(unsigned char* ws, int mode, int n_mt, int n_wt, int nsteps, int ui, UnitInfo& u) {
    const int it = ui / nsteps, step = ui - it * nsteps;
    int mt, wt;
    if (!tile_next(it, gridDim.x, blockIdx.x, n_mt, n_wt, mt, wt)) return false;
    const size_t tok0 = (size_t)mt * 256;
    const bf16_t* Aw; const bf16_t* Bact; int K = 1024;
    if (mode == GM_IN) { Aw = (const bf16_t*)(ws + OFF_W) + (size_t)wt * 256 * 1024; Bact = (const bf16_t*)(ws + OFF_H) + tok0 * 1024; }
    else if (mode == GM_OUT) { Aw = (const bf16_t*)(ws + OFF_W + W_O) + (size_t)wt * 256 * 1024; Bact = (const bf16_t*)(ws + OFF_QKV) + tok0 * 1024; }
    else if (mode == GM_MLP1) { Aw = (const bf16_t*)(ws + OFF_W + W_1) + (size_t)wt * 256 * 1024; Bact = (const bf16_t*)(ws + OFF_H) + tok0 * 1024; }
    else if (mode == GM_MLP2) { K = 4096; Aw = (const bf16_t*)(ws + OFF_W + W_2) + (size_t)wt * 256 * 4096; Bact = (const bf16_t*)(ws + OFF_Z) + tok0 * 4096; }
    else {
        const int k = step >> 1;
        if ((step & 1) == 0) { Aw = (const bf16_t*)(ws + OFF_W + W_G) + ((size_t)k * 1024 + (size_t)wt * 256) * 1024; Bact = (const bf16_t*)(ws + OFF_XBC) + tok0 * 1024; }
        else if (k == 0) { Aw = (const bf16_t*)(ws + OFF_W + W_SO) + (size_t)wt * 256 * 1024; Bact = (const bf16_t*)(ws + OFF_Z) + tok0 * 1024; }
        else if (k == 1) { K = 512; Aw = (const bf16_t*)(ws + OFF_W + W_RO) + (size_t)wt * 256 * 512; Bact = (const bf16_t*)(ws + OFF_G) + tok0 * 512; }
        else { K = 512; Aw = (const bf16_t*)(ws + OFF_W + W_WO) + (size_t)wt * 256 * 512; Bact = (const bf16_t*)(ws + OFF_PRW) + tok0 * 512; }
    }
    u.A = (const char*)Bact; u.B = (const char*)Aw; u.K = K; u.wt = wt; u.mt = mt; u.step = step;
    return true;
}

__device__ __forceinline__ void gemm_epilogue(unsigned char* ws, int mode, const UnitInfo& u, const f32x4 (&acc)[2][2][4][2], int wr, int wc, int fr, int fq, int tidx) {
    const size_t tok0 = (size_t)u.mt * 256; const int wt = u.wt, step = u.step;
    if (mode == GM_MERGE) {
        u32x4* sp = (u32x4*)(ws + OFF_RW + MSCR_S) + ((size_t)blockIdx.x * 8 * 512 + tidx) * 2;
        f32x4* mp = (f32x4*)(ws + OFF_RW + MSCR_M) + ((size_t)blockIdx.x * 8 * 512 + tidx) * 4;
        bf16_t* MG = (bf16_t*)(ws + OFF_QKV);
#pragma unroll
        for (int ai = 0; ai < 2; ++ai)
#pragma unroll
            for (int bj = 0; bj < 2; ++bj)
#pragma unroll
                for (int mh = 0; mh < 2; ++mh) {
                    if ((step & 1) == 0) {
                        unsigned o[8];
#pragma unroll
                        for (int k = 0; k < 4; ++k) {
                            const f32x4 v = acc[ai][bj][mh * 2 + (k >> 1)][k & 1];
                            o[2 * k] = pk2(sigmoidf_(v.x), sigmoidf_(v.y)); o[2 * k + 1] = pk2(sigmoidf_(v.z), sigmoidf_(v.w));
                        }
                        sp[0] = (u32x4){o[0], o[1], o[2], o[3]}; sp[1] = (u32x4){o[4], o[5], o[6], o[7]};
                    } else {
                        const u32x4 sa_ = sp[0], sb_ = sp[1];
                        const unsigned s8[8] = {sa_.x, sa_.y, sa_.z, sa_.w, sb_.x, sb_.y, sb_.z, sb_.w};
                        f32x4 m4[4];
                        if (step > 1) {
#pragma unroll
                            for (int k = 0; k < 4; ++k) m4[k] = mp[k];
                        }
#pragma unroll
                        for (int k = 0; k < 4; ++k) {
                            const int m = mh * 2 + (k >> 1), n = k & 1;
                            const f32x4 v = acc[ai][bj][m][n];
                            f32x4 mm = (f32x4){bflo(s8[2 * k]) * v.x, bfhi(s8[2 * k]) * v.y, bflo(s8[2 * k + 1]) * v.z, bfhi(s8[2 * k + 1]) * v.w};
                            if (step > 1) mm += m4[k];
                            if (step < 5) mp[k] = mm;
                            else {
                                const size_t tok = tok0 + ai * 128 + wr * 64 + m * 16 + fr;
                                const int feat = wt * 256 + bj * 128 + wc * 32 + fq * 8 + n * 4;
                                u32x2 o; o.x = pk2(mm.x, mm.y); o.y = pk2(mm.z, mm.w);
                                *(u32x2*)(MG + tok * 1024 + feat) = o;
                            }
                        }
                    }
                    sp += 512 * 2; mp += 512 * 4;
                    asm volatile("" : "+v"(sp), "+v"(mp) :: "memory");
                }
    } else if (mode == GM_IN && wt == 23) {
        float* DT = (float*)(ws + OFF_DT);
        if (wc == 0) {
#pragma unroll
            for (int ai = 0; ai < 2; ++ai)
#pragma unroll
                for (int m = 0; m < 4; ++m)
#pragma unroll
                    for (int n = 0; n < 2; ++n) {
                        const size_t tok = tok0 + ai * 128 + wr * 64 + m * 16 + fr;
                        *(f32x4*)(DT + tok * 32 + fq * 8 + n * 4) = acc[ai][0][m][n];
                    }
        }
    } else {
        bf16_t* base; int ld, col0;
        if (mode == GM_IN) {
            if (wt < 4) { base = (bf16_t*)(ws + OFF_Z); ld = 1024; col0 = wt * 256; }
            else if (wt < 10) { base = (bf16_t*)(ws + OFF_XBC); ld = 1536; col0 = (wt - 4) * 256; }
            else if (wt < 14) { base = (bf16_t*)(ws + OFF_QKV); ld = 1024; col0 = (wt - 10) * 256; }
            else if (wt < 16) { base = (bf16_t*)(ws + OFF_G); ld = 512; col0 = (wt - 14) * 256; }
            else { base = (bf16_t*)(ws + OFF_RW); ld = 1792; col0 = (wt - 16) * 256; }
        } else if (mode == GM_MLP1) { base = (bf16_t*)(ws + OFF_Z); ld = 4096; col0 = wt * 256; }
        else { base = (bf16_t*)(ws + OFF_H); ld = 1024; col0 = wt * 256; }
        const bool relu2 = (mode == GM_MLP1);
#pragma unroll
        for (int ai = 0; ai < 2; ++ai)
#pragma unroll
            for (int m = 0; m < 4; ++m) {
                const size_t tok = tok0 + ai * 128 + wr * 64 + m * 16 + fr;
                bf16_t* rowp = base + tok * ld + col0 + wc * 32 + fq * 8;
#pragma unroll
                for (int bj = 0; bj < 2; ++bj) {
                    f32x4 v = acc[ai][bj][m][0], w = acc[ai][bj][m][1];
                    if (relu2) { v.x = v.x > 0.f ? v.x * v.x : 0.f; v.y = v.y > 0.f ? v.y * v.y : 0.f; v.z = v.z > 0.f ? v.z * v.z : 0.f; v.w = v.w > 0.f ? v.w * v.w : 0.f;
                                 w.x = w.x > 0.f ? w.x * w.x : 0.f; w.y = w.y > 0.f ? w.y * w.y : 0.f; w.z = w.z > 0.f ? w.z * w.z : 0.f; w.w = w.w > 0.f ? w.w * w.w : 0.f; }
                    u32x4 o; o.x = pk2(v.x, v.y); o.y = pk2(v.z, v.w); o.z = pk2(w.x, w.y); o.w = pk2(w.z, w.w);
                    *(u32x4*)(rowp + bj * 128) = o;
                }
            }
    }
}

__device__ __forceinline__ void gemm_phase(CParams& p_in, const int mode, const int n_mt, LAS unsigned char* lds) {
    CParams* pq_ = &p_in; asm volatile("" : "+s"(pq_)); CParams& p = *pq_;
    const int tid = opaque_tid(), wid = __builtin_amdgcn_readfirstlane(tid >> 6), lane = tid & 63, wr = wid >> 2, wc = wid & 3, fr = lane & 15, fq = lane >> 4;
    unsigned char* ws = p.ws;
    int n_wt, nsteps = 1;
    if (mode == GM_IN) n_wt = 24; else if (mode == GM_MLP1) n_wt = 16; else n_wt = 4;
    if (mode == GM_MERGE) nsteps = 6;
    unsigned vR[2], vC[2];
#pragma unroll
    for (int i = 0; i < 2; ++i) { int Rr, Cc; stage_rc(tid * 16 + i * 8192, Rr, Cc); vR[i] = (unsigned)Rr * 2u; vC[i] = (unsigned)Cc * 2u; }
    const size_t kstep = (size_t)(BK * 2);
    const unsigned ldsw = (unsigned)wid * 1024u;
    const int aoff = lds_byte(wr * 64 + fr, fq * 8), boff = lds_byte(wc * 32 + fr, fq * 8);
#define PG8_SA(b, h) (((b) * 2 + (h)) * HTB)
#define PG8_SB(b, h) ((4 + (b) * 2 + (h)) * HTB)
#define PG8_STAGE(bufoff, gbase, v0, v1) do { \
        __builtin_amdgcn_global_load_lds((const unsigned*)((const char*)(gbase) + (v0)), (LAS unsigned*)(lds + (bufoff) + ldsw), 16, 0, 0); \
        __builtin_amdgcn_global_load_lds((const unsigned*)((const char*)(gbase) + (v1)), (LAS unsigned*)(lds + (bufoff) + ldsw + 8192), 16, 0, 0); } while (0)
#define PG8_LDA(dst, b, h) do { _Pragma("unroll") for (int m = 0; m < 4; ++m) _Pragma("unroll") for (int k = 0; k < 2; ++k) dst[m][k] = *(const LAS bf16x8*)(lds + PG8_SA(b, h) + aoff + m * 2048 + k * 1024); } while (0)
#define PG8_LDB(dst, b, h) do { _Pragma("unroll") for (int n = 0; n < 2; ++n) _Pragma("unroll") for (int k = 0; k < 2; ++k) dst[n][k] = *(const LAS bf16x8*)(lds + PG8_SB(b, h) + boff + n * 2048 + k * 1024); } while (0)
#define PG8_MMA(ai, bj, At, Bt) do { __builtin_amdgcn_s_setprio(1); _Pragma("unroll") for (int m = 0; m < 4; ++m) _Pragma("unroll") for (int n = 0; n < 2; ++n) _Pragma("unroll") for (int k = 0; k < 2; ++k) \
        acc[ai][bj][m][n] = __builtin_amdgcn_mfma_f32_16x16x32_bf16(Bt[n][k], At[m][k], acc[ai][bj][m][n], 0, 0, 0); __builtin_amdgcn_s_setprio(0); } while (0)
#define PG8_WAIT_V(n) asm volatile("s_waitcnt vmcnt(" #n ")" ::: "memory")
#define PG8_WAIT_L(n) asm volatile("s_waitcnt lgkmcnt(" #n ")" ::: "memory")
#define PG8_BAR __builtin_amdgcn_s_barrier()
#define PG8_SCHED __builtin_amdgcn_sched_barrier(0)
    UnitInfo cur, nxt; int ui = 0;
    if (!get_unit(ws, mode, n_mt, n_wt, nsteps, 0, cur)) return;
    f32x4 acc[2][2][4][2];
#pragma unroll
    for (int a = 0; a < 2; ++a)
#pragma unroll
        for (int b = 0; b < 2; ++b)
#pragma unroll
            for (int m = 0; m < 4; ++m)
#pragma unroll
                for (int n = 0; n < 2; ++n) acc[a][b][m][n] = (f32x4){0.f, 0.f, 0.f, 0.f};
    bf16x8 At[4][2], B0[2][2], B1[2][2];
    const char* cA = cur.A; const char* cB = cur.B;
    unsigned vc0 = vR[0] * (unsigned)cur.K + vC[0], vc1 = vR[1] * (unsigned)cur.K + vC[1];
    size_t hstep = (size_t)HALF * cur.K * 2;
    PG8_STAGE(PG8_SB(0, 0), cB, vc0, vc1); PG8_STAGE(PG8_SA(0, 0), cA, vc0, vc1); PG8_STAGE(PG8_SB(0, 1), cB + hstep, vc0, vc1); PG8_STAGE(PG8_SA(0, 1), cA + hstep, vc0, vc1);
    if (wr == 1) PG8_BAR;
    PG8_WAIT_V(4); PG8_BAR;
    PG8_STAGE(PG8_SB(1, 0), cB + kstep, vc0, vc1); PG8_STAGE(PG8_SA(1, 0), cA + kstep, vc0, vc1); PG8_STAGE(PG8_SB(1, 1), cB + hstep + kstep, vc0, vc1);
    PG8_WAIT_V(6); PG8_BAR;
    for (;;) {
        const bool has_next = get_unit(ws, mode, n_mt, n_wt, nsteps, ui + 1, nxt);
        const char* nA = has_next ? nxt.A : cA; const char* nB = has_next ? nxt.B : cB;
        const int Kn = has_next ? nxt.K : cur.K;
        const unsigned vn0 = vR[0] * (unsigned)Kn + vC[0], vn1 = vR[1] * (unsigned)Kn + vC[1];
        const size_t hstepn = (size_t)HALF * Kn * 2;
        const int nt = cur.K / BK;
        for (int t = 0; t < nt; t += 2) {
            const bool last = (t == nt - 2);
            const char* a1 = cA + (size_t)(t + 1) * kstep;
            const char* a2 = last ? nA : cA + (size_t)(t + 2) * kstep; const char* b2 = last ? nB : cB + (size_t)(t + 2) * kstep;
            const char* a3 = a2 + kstep; const char* b3 = b2 + kstep;
            const unsigned w0 = last ? vn0 : vc0, w1 = last ? vn1 : vc1;
            const size_t hs2 = last ? hstepn : hstep;
            PG8_LDB(B0, 0, 0); PG8_SCHED; PG8_LDA(At, 0, 0); PG8_STAGE(PG8_SA(1, 1), a1 + hstep, vc0, vc1);
            PG8_WAIT_L(8); PG8_BAR; PG8_WAIT_L(0); PG8_MMA(0, 0, At, B0); PG8_BAR; PG8_SCHED;
            PG8_LDB(B1, 0, 1); PG8_STAGE(PG8_SB(0, 0), b2, w0, w1);
            PG8_BAR; PG8_WAIT_L(0); PG8_MMA(0, 1, At, B1); PG8_BAR;
            PG8_LDA(At, 0, 1); PG8_STAGE(PG8_SA(0, 0), a2, w0, w1);
            PG8_BAR; PG8_WAIT_L(0); PG8_MMA(1, 0, At, B0); PG8_BAR; PG8_SCHED;
            PG8_STAGE(PG8_SB(0, 1), b2 + hs2, w0, w1);
            PG8_WAIT_V(6); PG8_BAR; PG8_MMA(1, 1, At, B1); PG8_BAR;
            PG8_LDB(B0, 1, 0); PG8_SCHED; PG8_LDA(At, 1, 0); PG8_STAGE(PG8_SA(0, 1), a2 + hs2, w0, w1);
            PG8_WAIT_L(8); PG8_BAR; PG8_WAIT_L(0); PG8_MMA(0, 0, At, B0); PG8_BAR; PG8_SCHED;
            PG8_LDB(B1, 1, 1); PG8_STAGE(PG8_SB(1, 0), b3, w0, w1);
            PG8_BAR; PG8_WAIT_L(0); PG8_MMA(0, 1, At, B1); PG8_BAR;
            PG8_LDA(At, 1, 1); PG8_STAGE(PG8_SA(1, 0), a3, w0, w1);
            PG8_BAR; PG8_WAIT_L(0); PG8_MMA(1, 0, At, B0); PG8_BAR; PG8_SCHED;
            PG8_STAGE(PG8_SB(1, 1), b3 + hs2, w0, w1);
            PG8_WAIT_V(6); PG8_BAR; PG8_MMA(1, 1, At, B1); PG8_BAR;
        }
        gemm_epilogue(ws, mode, cur, acc, wr, wc, fr, fq, tid);
        if (!has_next) break;
#pragma unroll
        for (int a = 0; a < 2; ++a)
#pragma unroll
            for (int b = 0; b < 2; ++b)
#pragma unroll
                for (int m = 0; m < 4; ++m)
#pragma unroll
                    for (int n = 0; n < 2; ++n) acc[a][b][m][n] = (f32x4){0.f, 0.f, 0.f, 0.f};
        cur = nxt; cA = nA; cB = nB; vc0 = vn0; vc1 = vn1; hstep = hstepn; ++ui;
    }
    PG8_WAIT_V(0);
    if (wr == 0) PG8_BAR;
    PG8_BAR;
}

__device__ __forceinline__ void phase_mod(CParams& p_in, unsigned char* smem) {
    CParams* pq_ = &p_in; asm volatile("" : "+s"(pq_)); CParams& p = *pq_;
    const int tidx = opaque_tid();
    float* sc = (float*)smem;
    float* red = sc + 5 * 1024;
    for (int i = tidx; i < 5 * 1024; i += 512) { int r = i >> 10, k = i & 1023; float v = r < 4 ? p.in[1][r * 1024 + k] : p.in[3][k]; sc[i] = siluf_(v); }
    __syncthreads();
    float* MOD = (float*)(p.ws + OFF_MOD);
    const int col = tidx & 63, kp = tidx >> 6;
    for (int item = blockIdx.x; item < 4 * 96; item += gridDim.x) {
        const int l = item / 96, n0 = (item % 96) * 64;
        const float* W = p.in[5] + (size_t)l * 1024 * 6144 + n0 + col;
        float a0 = 0.f, a1 = 0.f, a2 = 0.f, a3 = 0.f, a4 = 0.f;
        for (int k0 = kp * 128; k0 < kp * 128 + 128; k0 += 16) {
            float w[16];
#pragma unroll
            for (int j = 0; j < 16; ++j) w[j] = W[(size_t)(k0 + j) * 6144];
#pragma unroll
            for (int j = 0; j < 16; ++j) { const int k = k0 + j; a0 += sc[k] * w[j]; a1 += sc[1024 + k] * w[j]; a2 += sc[2048 + k] * w[j]; a3 += sc[3072 + k] * w[j]; a4 += sc[4096 + k] * w[j]; }
        }
        red[(kp * 5 + 0) * 64 + col] = a0; red[(kp * 5 + 1) * 64 + col] = a1; red[(kp * 5 + 2) * 64 + col] = a2;
        red[(kp * 5 + 3) * 64 + col] = a3; red[(kp * 5 + 4) * 64 + col] = a4;
        __syncthreads();
        if (tidx < 320) {
            const int r = tidx >> 6; float s = 0.f;
            for (int q = 0; q < 8; ++q) s += red[(q * 5 + r) * 64 + col];
            MOD[(size_t)(l * 5 + r) * 6144 + n0 + col] = s + p.in[6][l * 6144 + n0 + col];
        }
        __syncthreads();
    }
}

__device__ __forceinline__ void cvt_job(const float* W, int ldw, int col0, int ncols, int K, bf16_t* WT, int row0, unsigned char* smem, int cb, int cn) {
    const int tidx = opaque_tid();
    const int wave = tidx >> 6, lane = tidx & 63;
    float* scr = (float*)smem + wave * (64 * 33);
    const int nblk = ncols / 32, nitems = (K / 64) * nblk;
    for (int base = cb * 8; base < nitems; base += cn * 8) {
        const int it = base + wave; const bool valid = it < nitems;
        const int kb = valid ? it / nblk : 0, nb = valid ? it % nblk : 0, k0 = kb * 64, n0 = nb * 32;
        if (valid) {
#pragma unroll 8
            for (int i = 0; i < 32; ++i) { const int kk = 2 * i + (lane >> 5); scr[kk * 33 + (lane & 31)] = W[(size_t)(k0 + kk) * ldw + col0 + n0 + (lane & 31)]; }
        }
        __syncthreads();
        if (valid) {
            const int c = lane & 7;
#pragma unroll
            for (int j = 0; j < 4; ++j) {
                const int n = (lane >> 3) + 8 * j; const float* s = scr + (8 * c) * 33 + n;
                u32x4 o; o.x = pk2(s[0], s[33]); o.y = pk2(s[66], s[99]); o.z = pk2(s[132], s[165]); o.w = pk2(s[198], s[231]);
                const int rho = ((n >> 2) & 1) * 16 + (n >> 3) * 4 + (n & 3);
                *(u32x4*)(WT + (size_t)(row0 + n0 + rho) * K + k0 + 8 * c) = o;
            }
        }
        __syncthreads();
    }
}
__device__ __forceinline__ void cvt_win(CParams& p_in, int l_in, unsigned char* smem, int cb, int cn) {
    CParams* pq_ = &p_in; asm volatile("" : "+s"(pq_)); CParams& p = *pq_;
    int l = l_in; asm volatile("" : "+s"(l));
    const float* W = p.in[7] + (size_t)l * 1024 * 8992; bf16_t* WB = (bf16_t*)(p.ws + OFF_W);
    cvt_job(W, 8992, 3072, 2560, 1024, WB, 0, smem, cb, cn);
    cvt_job(W, 8992, 5664, 3328, 1024, WB, 2560, smem, cb, cn);
    cvt_job(W, 8992, 5632, 256, 1024, WB, 5888, smem, cb, cn);
}
__device__ __forceinline__ void cvt_mix(CParams& p_in, int l_in, unsigned char* smem, int cb, int cn) {
    CParams* pq_ = &p_in; asm volatile("" : "+s"(pq_)); CParams& p = *pq_;
    int l = l_in; asm volatile("" : "+s"(l));
    cvt_job(p.in[7] + (size_t)l * 1024 * 8992, 8992, 0, 3072, 1024, (bf16_t*)(p.ws + OFF_W + W_G), 0, smem, cb, cn);
    cvt_job(p.in[26] + (size_t)l * 1024 * 1024, 1024, 0, 1024, 1024, (bf16_t*)(p.ws + OFF_W + W_SO), 0, smem, cb, cn);
    cvt_job(p.in[27] + (size_t)l * 512 * 1024, 1024, 0, 1024, 512, (bf16_t*)(p.ws + OFF_W + W_RO), 0, smem, cb, cn);
    cvt_job(p.in[28] + (size_t)l * 512 * 1024, 1024, 0, 1024, 512, (bf16_t*)(p.ws + OFF_W + W_WO), 0, smem, cb, cn);
    cvt_job(p.in[29] + (size_t)l * 1024 * 1024, 1024, 0, 1024, 1024, (bf16_t*)(p.ws + OFF_W + W_O), 0, smem, cb, cn);
}
__device__ __forceinline__ void cvt_mlp(CParams& p_in, int l_in, unsigned char* smem, int cb, int cn) {
    CParams* pq_ = &p_in; asm volatile("" : "+s"(pq_)); CParams& p = *pq_;
    int l = l_in; asm volatile("" : "+s"(l));
    cvt_job(p.in[30] + (size_t)l * 1024 * 4096, 4096, 0, 4096, 1024, (bf16_t*)(p.ws + OFF_W + W_1), 0, smem, cb, cn);
    cvt_job(p.in[31] + (size_t)l * 4096 * 1024, 1024, 0, 1024, 4096, (bf16_t*)(p.ws + OFF_W + W_2), 0, smem, cb, cn);
}

__device__ __forceinline__ void row_pass(const float* xrow, const bf16_t* yrow, const float* gate, const float* nwA, float* xout,
                                         bool do_h, const float* nwB, const float* sh, const float* sc, bf16_t* hrow, int lane) {
    f32x4 x[4];
#pragma unroll
    for (int j = 0; j < 4; ++j) x[j] = *(const f32x4*)(xrow + j * 256 + lane * 4);
    u32x2 yraw[4]; f32x4 gw[4];
    if (yrow) {
#pragma unroll
        for (int j = 0; j < 4; ++j) yraw[j] = *(const u32x2*)(yrow + j * 256 + lane * 4);
#pragma unroll
        for (int j = 0; j < 4; ++j) gw[j] = *(const f32x4*)(gate + j * 256 + lane * 4) * *(const f32x4*)(nwA + j * 256 + lane * 4);
    }
    f32x4 hm[4], hs[4];
    if (do_h) {
#pragma unroll
        for (int j = 0; j < 4; ++j) {
            hm[j] = *(const f32x4*)(nwB + j * 256 + lane * 4) * (*(const f32x4*)(sc + j * 256 + lane * 4) + 1.f);
            hs[j] = *(const f32x4*)(sh + j * 256 + lane * 4);
        }
    }
    if (yrow) {
        f32x4 y[4]; float ss = 0.f;
#pragma unroll
        for (int j = 0; j < 4; ++j) {
            y[j] = (f32x4){bflo(yraw[j].x), bfhi(yraw[j].x), bflo(yraw[j].y), bfhi(yraw[j].y)};
            ss += y[j].x * y[j].x + y[j].y * y[j].y + y[j].z * y[j].z + y[j].w * y[j].w;
        }
        ss = wave_sum(ss);
        const float rs = rsqrtf(ss * (1.f / 1024.f) + 1e-6f);
#pragma unroll
        for (int j = 0; j < 4; ++j) x[j] += gw[j] * (y[j] * rs);
    }
    if (xout) {
#pragma unroll
        for (int j = 0; j < 4; ++j) *(f32x4*)(xout + j * 256 + lane * 4) = x[j];
    }
    if (do_h) {
        float ss = 0.f;
#pragma unroll
        for (int j = 0; j < 4; ++j) ss += x[j].x * x[j].x + x[j].y * x[j].y + x[j].z * x[j].z + x[j].w * x[j].w;
        ss = wave_sum(ss);
        const float rs = rsqrtf(ss * (1.f / 1024.f) + 1e-6f);
#pragma unroll
        for (int j = 0; j < 4; ++j) {
            const f32x4 h = (x[j] * rs) * hm[j] + hs[j];
            u32x2 o; o.x = pk2(h.x, h.y); o.y = pk2(h.z, h.w);
            *(u32x2*)(hrow + j * 256 + lane * 4) = o;
        }
    }
}

__device__ __forceinline__ void token_phase(CParams& p_in, int l_in, int kind, int nrows) {
    CParams* pq_ = &p_in; asm volatile("" : "+s"(pq_)); CParams& p = *pq_;
    int l = l_in; asm volatile("" : "+s"(l));
    const int tidx = opaque_tid();
    const int lane = tidx & 63, gw = blockIdx.x * 8 + (tidx >> 6), ngw = gridDim.x * 8;
    const float* MOD = (const float*)(p.ws + OFF_MOD);
    const float* NW = p.in[4];
    bf16_t* H = (bf16_t*)(p.ws + OFF_H);
    float* CTXS = (float*)(p.ws + OFF_CTXS);
    for (int row = gw; row < nrows; row += ngw) {
        const bool lat = row < RL; const int mi = lat ? (row >> 13) : 4;
        const float* xin; float* xout = nullptr;
        const bool from_input = (l == 0 && kind <= 1);
        if (lat) xin = from_input ? p.in[0] + (size_t)row * 1024 : p.out + (size_t)row * 1024;
        else xin = from_input ? p.in[2] + (size_t)(row - RL) * 1024 : CTXS + (size_t)(row - RL) * 1024;
        if (kind > 0) xout = lat ? p.out + (size_t)row * 1024 : CTXS + (size_t)(row - RL) * 1024;
        const float* modl = MOD + (size_t)(l * 5 + mi) * 6144;
        bf16_t* hrow = H + (size_t)row * 1024;
        if (kind == 0) row_pass(xin, nullptr, nullptr, nullptr, nullptr, true, NW + (l * 4 + 0) * 1024, modl, modl + 1024, hrow, lane);
        else if (kind == 1) row_pass(xin, hrow, modl + 2048, NW + (l * 4 + 1) * 1024, xout, true, NW + (l * 4 + 2) * 1024, modl + 3072, modl + 4096, hrow, lane);
        else {
            const bool nxt = l < 3; const float* modn = MOD + (size_t)((l + 1) * 5 + mi) * 6144;
            row_pass(xin, hrow, modl + 5120, NW + (l * 4 + 3) * 1024, xout, nxt, NW + ((l + 1) * 4 + 0) * 1024, modn, modn + 1024, hrow, lane);
        }
    }
}

template <int NQ, int PB>
__device__ __forceinline__ void lin_steps(float (&S)[16], const float* qL, const float* kL, const float* vL, const float* dtL, const float* decL, float* yL, int dir, int nq, int pl) {
    constexpr int N = NQ * 16;
    for (int j = 0; j < 32; ++j) {
        const int tt = dir ? 31 - j : j;
        const float xdt = vL[tt * PB + pl] * dtL[tt];
        const float dec = decL[tt];
        const f32x4* kp = (const f32x4*)(kL + tt * N + nq * 16);
        const f32x4* qp = (const f32x4*)(qL + tt * N + nq * 16);
        float part = 0.f;
#pragma unroll
        for (int q4 = 0; q4 < 4; ++q4) {
            const f32x4 kv = kp[q4], qv = qp[q4];
            S[q4 * 4 + 0] = dec * S[q4 * 4 + 0] + kv.x * xdt; part += qv.x * S[q4 * 4 + 0];
            S[q4 * 4 + 1] = dec * S[q4 * 4 + 1] + kv.y * xdt; part += qv.y * S[q4 * 4 + 1];
            S[q4 * 4 + 2] = dec * S[q4 * 4 + 2] + kv.z * xdt; part += qv.z * S[q4 * 4 + 2];
            S[q4 * 4 + 3] = dec * S[q4 * 4 + 3] + kv.w * xdt; part += qv.w * S[q4 * 4 + 3];
        }
        part = (NQ == 8) ? red8(part) : red4(part);
        if (nq == 0) yL[tt * PB + pl] = part;
    }
}

__device__ __forceinline__ void scan_tile(int b, int dir, int tau, int& low, int& s0, int& s1, bool& isctx, bool& first) {
    int ti, nt;
    isctx = tau < 8;
    if (isctx) { ti = dir ? 7 - tau : tau; s0 = RL + b * 256; s1 = s0 + 256; nt = 8; }
    else { ti = dir ? 255 - (tau - 8) : tau - 8; s0 = b * 8192; s1 = s0 + 8192; nt = 256; }
    low = s0 + ti * 32;
    first = (dir == 0) == (ti < nt / 2);
}

template <int NK> struct CsL {
    static constexpr int SN = NK + 8, SS = 40;
    static constexpr int O_CN = 0, O_BN = O_CN + 32 * SN * 2, O_BWT = O_BN + 32 * SN * 2, O_XT = O_BWT + NK * SS * 2, O_PM = O_XT + 64 * SS * 2,
                         O_ST = O_PM + 32 * SS * 2, O_F = O_ST + 64 * SN * 2, O_Y = O_F + 544, O_RAW = (NK == 128) ? O_Y : O_Y + 8192;
};
template <int NK>
__device__ __forceinline__ void cs_core(unsigned char* base, f32x4 (&accS)[NK / 16], int dir, int w, int fr, int fq) {
    typedef CsL<NK> L;
    constexpr int SN = L::SN, SS = L::SS, KC = NK / 32, NT = NK / 16;
    bf16_t* Cn = (bf16_t*)(base + L::O_CN); bf16_t* Bn = (bf16_t*)(base + L::O_BN); bf16_t* BwT = (bf16_t*)(base + L::O_BWT);
    bf16_t* XT = (bf16_t*)(base + L::O_XT); bf16_t* Pm = (bf16_t*)(base + L::O_PM); bf16_t* ST = (bf16_t*)(base + L::O_ST);
    float* cumL = (float*)(base + L::O_F); float* dtL = cumL + 32; float* eL = dtL + 32; float* totL = eL + 64;
    float* yL = (float*)(base + ((NK == 128) ? L::O_BN : L::O_Y));
    f32x4 acc4[2];
    {
        const int mt = w >> 1, nt = w & 1;
        f32x4 g = (f32x4){0.f, 0.f, 0.f, 0.f};
#pragma unroll
        for (int kc = 0; kc < KC; ++kc) {
            const bf16x8 A = *(const bf16x8*)(Cn + (mt * 16 + fr) * SN + kc * 32 + fq * 8);
            const bf16x8 Bf = *(const bf16x8*)(Bn + (nt * 16 + fr) * SN + kc * 32 + fq * 8);
            g = __builtin_amdgcn_mfma_f32_16x16x32_bf16(A, Bf, g, 0, 0, 0);
        }
        const int s = nt * 16 + fr; const float cs = cumL[s], ds = dtL[s];
#pragma unroll
        for (int r = 0; r < 4; ++r) {
            const int t = mt * 16 + fq * 4 + r;
            const bool ok = dir ? (s >= t) : (s <= t);
            const float val = ok ? g[r] * __expf(cumL[t] - cs) * ds : 0.f;
            Pm[t * SS + s] = f2bf(val);
        }
#pragma unroll
        for (int mt2 = 0; mt2 < 2; ++mt2) {
            acc4[mt2] = (f32x4){0.f, 0.f, 0.f, 0.f};
#pragma unroll
            for (int kc = 0; kc < KC; ++kc) {
                const bf16x8 A = *(const bf16x8*)(Cn + (mt2 * 16 + fr) * SN + kc * 32 + fq * 8);
                const bf16x8 Bf = *(const bf16x8*)(ST + (w * 16 + fr) * SN + kc * 32 + fq * 8);
                acc4[mt2] = __builtin_amdgcn_mfma_f32_16x16x32_bf16(A, Bf, acc4[mt2], 0, 0, 0);
            }
        }
    }
    __syncthreads();
    {
        const bf16x8 Xf = *(const bf16x8*)(XT + (w * 16 + fr) * SS + fq * 8);
#pragma unroll
        for (int mt2 = 0; mt2 < 2; ++mt2) {
            const bf16x8 A = *(const bf16x8*)(Pm + (mt2 * 16 + fr) * SS + fq * 8);
            f32x4 a3 = (f32x4){0.f, 0.f, 0.f, 0.f};
            a3 = __builtin_amdgcn_mfma_f32_16x16x32_bf16(A, Xf, a3, 0, 0, 0);
#pragma unroll
            for (int r = 0; r < 4; ++r) { const int t = mt2 * 16 + fq * 4 + r; yL[t * 64 + w * 16 + fr] = a3[r] + eL[t] * acc4[mt2][r]; }
        }
        const float dtot = __expf(totL[0]);
#pragma unroll
        for (int n8 = 0; n8 < NT; ++n8) {
            const bf16x8 Bf = *(const bf16x8*)(BwT + (n8 * 16 + fr) * SS + fq * 8);
            accS[n8] = accS[n8] * dtot;
            accS[n8] = __builtin_amdgcn_mfma_f32_16x16x32_bf16(Xf, Bf, accS[n8], 0, 0, 0);
#pragma unroll
            for (int r = 0; r < 4; ++r) ST[(w * 16 + fq * 4 + r) * SN + n8 * 16 + fr] = f2bf(accS[n8][r]);
        }
    }
    __syncthreads();
}

template <int NK, bool DX>
__device__ __forceinline__ void cs_writeout(unsigned char* base, bf16_t* pp, u32x4 pv, int tl, float Dh) {
    typedef CsL<NK> L;
    const float* yL = (const float*)(base + ((NK == 128) ? L::O_BN : L::O_Y));
    const bf16_t* XT = (const bf16_t*)(base + L::O_XT);
    const int t = tl >> 3, pg = tl & 7;
    const f32x4 ya = *(const f32x4*)(yL + t * 64 + pg * 8), yb = *(const f32x4*)(yL + t * 64 + pg * 8 + 4);
    float y[8] = {ya.x, ya.y, ya.z, ya.w, yb.x, yb.y, yb.z, yb.w};
    const unsigned pa[4] = {pv.x, pv.y, pv.z, pv.w};
#pragma unroll
    for (int j = 0; j < 4; ++j) { y[2 * j] += bflo(pa[j]); y[2 * j + 1] += bfhi(pa[j]); }
    if (DX) {
#pragma unroll
        for (int j = 0; j < 8; ++j) y[j] += Dh * bf2f(XT[(pg * 8 + j) * L::SS + t]);
    }
    u32x4 o; o.x = pk2(y[0], y[1]); o.y = pk2(y[2], y[3]); o.z = pk2(y[4], y[5]); o.w = pk2(y[6], y[7]);
    *(u32x4*)pp = o;
}

__device__ __forceinline__ void ssd_scan_item(CParams& p_in, int l_in, int item, unsigned char* smem) {
    CParams* pq_ = &p_in; asm volatile("" : "+s"(pq_)); CParams& p = *pq_;
    int l = l_in; asm volatile("" : "+s"(l));
    const int tidx = opaque_tid();
    typedef CsL<128> L;
    constexpr int SN = L::SN, SS = L::SS;
    const int b = item >> 4, h = item & 15, g = h >> 3;
    const int tid = tidx, dir = tid >> 8, tl = tid & 255, lane = tid & 63, w = tl >> 6, fr = lane & 15, fq = lane >> 4;
    unsigned char* base = smem + dir * 76800;
    bf16_t* Cn = (bf16_t*)(base + L::O_CN); bf16_t* Bn = (bf16_t*)(base + L::O_BN); bf16_t* BwT = (bf16_t*)(base + L::O_BWT);
    bf16_t* XT = (bf16_t*)(base + L::O_XT); bf16_t* ST = (bf16_t*)(base + L::O_ST);
    float* cumL = (float*)(base + L::O_F); float* dtL = cumL + 32; float* eL = dtL + 32; float* wL = eL + 32; float* totL = eL + 64;
    bf16_t* rawL = (bf16_t*)(base + L::O_RAW);
    const bf16_t* XBC = (const bf16_t*)(p.ws + OFF_XBC);
    const float* DT = (const float*)(p.ws + OFF_DT);
    bf16_t* P = (bf16_t*)(p.ws + OFF_H);
    const float* cw = p.in[8] + (size_t)l * 5 * 1536; const float* cbias = p.in[9] + (size_t)l * 1536;
    const float dtb = p.in[10][l * 32 + dir * 16 + h];
    const float aneg = -__expf(p.in[11][l * 32 + dir * 16 + h]);
    const float Dh = p.in[12][l * 16 + h];
    const int xc1 = 1024 + g * 128 + (tl & 127) * 2;
    const int xc1c = ((tl & 127) < 64) ? xc1 : 1280 + g * 128 + ((tl & 127) - 64) * 2;
    const f32x2_t cw0 = {cw[xc1c], cw[xc1c + 1]}, cw1 = {cw[1536 + xc1c], cw[1536 + xc1c + 1]}, cw2 = {cw[2 * 1536 + xc1c], cw[2 * 1536 + xc1c + 1]},
                  cw3 = {cw[3 * 1536 + xc1c], cw[3 * 1536 + xc1c + 1]}, cw4 = {cw[4 * 1536 + xc1c], cw[4 * 1536 + xc1c + 1]}, cwb = {cbias[xc1c], cbias[xc1c + 1]};
    const int xc2 = h * 64 + (tl & 63);
    const float c20 = cw[xc2], c21 = cw[1536 + xc2], c22 = cw[2 * 1536 + xc2], c23 = cw[3 * 1536 + xc2], c24 = cw[4 * 1536 + xc2], c2b = cbias[xc2];
    for (int i = tl; i < 64 * SN; i += 256) ST[i] = 0;
    f32x4 accS[8];
#pragma unroll
    for (int i = 0; i < 8; ++i) accS[i] = (f32x4){0.f, 0.f, 0.f, 0.f};
    u32x4 rv[6]; float dtr = 0.f;
    int pf_rr[6], pf_off[6], pf_lds[6];
#pragma unroll
    for (int i = 0; i < 6; ++i) {
        const int e = tl + 256 * i; const int rr = e / 40, ch = e - rr * 40;
        const int xc = ch < 16 ? 1024 + g * 128 + ch * 8 : (ch < 32 ? 1280 + g * 128 + (ch - 16) * 8 : h * 64 + (ch - 32) * 8);
        pf_rr[i] = rr; pf_off[i] = rr * 1536 + xc; pf_lds[i] = (e < 36 * 40) ? rr * 320 + ch * 8 : -1;
    }
#define SSD_PREFETCH(tau_) do { int low_, s0_, s1_; bool ic_, fi_; scan_tile(b, dir, (tau_), low_, s0_, s1_, ic_, fi_); \
        const bf16_t* rb_ = XBC + (size_t)(low_ - 2) * 1536; \
        _Pragma("unroll") for (int i = 0; i < 6; ++i) { \
            const int row = low_ - 2 + pf_rr[i]; \
            rv[i] = (u32x4){0u, 0u, 0u, 0u}; \
            if (pf_lds[i] >= 0 && row >= s0_ && row < s1_) rv[i] = *(const u32x4*)(rb_ + pf_off[i]); } \
        if (tl < 32) dtr = DT[(size_t)(low_ + tl) * 32 + dir * 16 + h]; } while (0)
    SSD_PREFETCH(0);
    for (int tau = 0; tau < 264; ++tau) {
        int low, s0, s1; bool isctx, first;
        scan_tile(b, dir, tau, low, s0, s1, isctx, first);
#pragma unroll
        for (int i = 0; i < 6; ++i) { if (pf_lds[i] >= 0) *(u32x4*)(rawL + pf_lds[i]) = rv[i]; }
        if (tl < 64) {
            const float dt = fast_softplus(dtr + dtb);
            const float la = dt * aneg;
            float c = la;
#pragma unroll
            for (int o = 1; o < 32; o <<= 1) { const float v = __shfl_up(c, o); if (lane >= o) c += v; }
            const float total = __shfl(c, 31);
            const float cd = dir ? (total - c + la) : c;
            if (tl < 32) { cumL[tl] = cd; dtL[tl] = dt; eL[tl] = __expf(cd); wL[tl] = __expf(total - cd) * dt; if (tl == 0) totL[0] = total; }
        }
        bf16_t* pp = P + (size_t)(low + (tl >> 3)) * 1024 + h * 64 + (tl & 7) * 8;
        const bool late = (tau == 4) || (tau == 136);
        u32x4 pv = (u32x4){0u, 0u, 0u, 0u};
        if (!first && !late) pv = *(const u32x4*)pp;
        __syncthreads();
        {
            const bf16_t* __restrict__ rawR = rawL;
            {
                const int cp = tl & 127, th = tl >> 7, c0 = cp * 2, tb = th * 16;
                f32x2_t q0, q1, q2, q3;
                { const unsigned a = *(const unsigned*)(rawR + (tb) * 320 + c0), bq = *(const unsigned*)(rawR + (tb + 1) * 320 + c0), cq = *(const unsigned*)(rawR + (tb + 2) * 320 + c0), dq = *(const unsigned*)(rawR + (tb + 3) * 320 + c0);
                  q0 = (f32x2_t){bflo(a), bfhi(a)}; q1 = (f32x2_t){bflo(bq), bfhi(bq)}; q2 = (f32x2_t){bflo(cq), bfhi(cq)}; q3 = (f32x2_t){bflo(dq), bfhi(dq)}; }
#pragma unroll 8
                for (int j = 0; j < 16; ++j) {
                    const int t = tb + j;
                    const unsigned e = *(const unsigned*)(rawR + (t + 4) * 320 + c0);
                    const f32x2_t q4 = {bflo(e), bfhi(e)};
                    f32x2_t o = __builtin_elementwise_fma(cw4, q4, cwb);
                    o = __builtin_elementwise_fma(cw3, q3, o); o = __builtin_elementwise_fma(cw2, q2, o);
                    o = __builtin_elementwise_fma(cw1, q1, o); o = __builtin_elementwise_fma(cw0, q0, o);
                    o.x = siluf_(o.x); o.y = siluf_(o.y);
                    if (cp < 64) {
                        *(unsigned*)(Bn + t * SN + c0) = pk2(o.x, o.y);
                        const float wt = wL[t];
                        const unsigned bw = pk2(o.x * wt, o.y * wt);
                        BwT[c0 * SS + t] = (bf16_t)(bw & 0xffffu); BwT[(c0 + 1) * SS + t] = (bf16_t)(bw >> 16);
                    } else *(unsigned*)(Cn + t * SN + c0 - 128) = pk2(o.x, o.y);
                    q0 = q1; q1 = q2; q2 = q3; q3 = q4;
                }
            }
            const int xcol = 256 + (tl & 63), tq = tl >> 6;
            float q0 = bf2f(rawL[(tq * 8) * 320 + xcol]), q1 = bf2f(rawL[(tq * 8 + 1) * 320 + xcol]), q2 = bf2f(rawL[(tq * 8 + 2) * 320 + xcol]), q3 = bf2f(rawL[(tq * 8 + 3) * 320 + xcol]);
            unsigned xo[4];
#pragma unroll
            for (int j = 0; j < 8; ++j) {
                const float q4 = bf2f(rawL[(tq * 8 + j + 4) * 320 + xcol]);
                const float o = siluf_(c20 * q0 + c21 * q1 + c22 * q2 + c23 * q3 + c24 * q4 + c2b);
                if (j & 1) xo[j >> 1] |= ((unsigned)f2bf(o)) << 16; else xo[j >> 1] = f2bf(o);
                q0 = q1; q1 = q2; q2 = q3; q3 = q4;
            }
            *(u32x4*)(XT + (tl & 63) * SS + tq * 8) = (u32x4){xo[0], xo[1], xo[2], xo[3]};
        }
        __syncthreads();
        if (!first && late) pv = *(const u32x4*)pp;
        if (tau + 1 < 264) SSD_PREFETCH(tau + 1);
        cs_core<128>(base, accS, dir, w, fr, fq);
        cs_writeout<128, true>(base, pp, pv, tl, first ? 0.f : Dh);
    }
#undef SSD_PREFETCH
}

__device__ __forceinline__ void ret_scan_item(CParams& p_in, int l_in, int item, unsigned char* smem) {
    CParams* pq_ = &p_in; asm volatile("" : "+s"(pq_)); CParams& p = *pq_;
    int l = l_in; asm volatile("" : "+s"(l));
    const int tidx = opaque_tid();
    typedef CsL<64> L;
    constexpr int SN = L::SN, SS = L::SS;
    const int b = item >> 3, hd = (item >> 1) & 3, phalf = item & 1;
    const int tid = tidx, dir = tid >> 8, tl = tid & 255, lane = tid & 63, w = tl >> 6, fr = lane & 15, fq = lane >> 4;
    unsigned char* base = smem + dir * 76800;
    bf16_t* Cn = (bf16_t*)(base + L::O_CN); bf16_t* Bn = (bf16_t*)(base + L::O_BN); bf16_t* BwT = (bf16_t*)(base + L::O_BWT);
    bf16_t* XT = (bf16_t*)(base + L::O_XT); bf16_t* ST = (bf16_t*)(base + L::O_ST);
    float* cumL = (float*)(base + L::O_F); float* dtL = cumL + 32; float* eL = dtL + 32; float* wL = eL + 32; float* totL = eL + 64;
    bf16_t* rawL = (bf16_t*)(base + L::O_RAW);
    const bf16_t* QKV = (const bf16_t*)(p.ws + OFF_QKV);
    bf16_t* P = (bf16_t*)(p.ws + OFF_PRET);
    const float lg = -fast_softplus(-p.in[14][l * 8 + dir * 4 + hd]);
    if (tl < 32) {
        const float cd = dir ? (float)(32 - tl) * lg : (float)(tl + 1) * lg;
        const float total = 32.f * lg;
        cumL[tl] = cd; dtL[tl] = 1.f; eL[tl] = __expf(cd); wL[tl] = __expf(total - cd); if (tl == 0) totL[0] = total;
    }
    for (int i = tl; i < 64 * SN; i += 256) ST[i] = 0;
    f32x4 accS[4];
#pragma unroll
    for (int i = 0; i < 4; ++i) accS[i] = (f32x4){0.f, 0.f, 0.f, 0.f};
    const int pairidx = tl & 63, tq = tl >> 6, which = pairidx >> 5, pi = pairidx & 31;
    const float inv = exp2f(-(float)(pi & 15) * (13.287712379549449f / 16.f));
    u32x4 rv[3];
#define RET_PREFETCH(tau_) do { int low_, s0_, s1_; bool ic_, fi_; scan_tile(b, dir, (tau_), low_, s0_, s1_, ic_, fi_); \
        _Pragma("unroll") for (int i = 0; i < 3; ++i) { \
            const int e = tl + 256 * i; const int rr = e / 24, ch = e - rr * 24; \
            const int col = ch < 8 ? hd * 64 + ch * 8 : (ch < 16 ? 256 + hd * 64 + (ch - 8) * 8 : 512 + hd * 128 + phalf * 64 + (ch - 16) * 8); \
            rv[i] = *(const u32x4*)(QKV + (size_t)(low_ + rr) * 1024 + col); } } while (0)
    RET_PREFETCH(0);
    for (int tau = 0; tau < 264; ++tau) {
        int low, s0, s1; bool isctx, first;
        scan_tile(b, dir, tau, low, s0, s1, isctx, first);
#pragma unroll
        for (int i = 0; i < 3; ++i) { const int e = tl + 256 * i; const int rr = e / 24, ch = e - rr * 24; *(u32x4*)(rawL + rr * 192 + ch * 8) = rv[i]; }
        bf16_t* pp = P + (size_t)(low + (tl >> 3)) * 512 + hd * 128 + phalf * 64 + (tl & 7) * 8;
        const bool late = (tau == 4) || (tau == 136);
        u32x4 pv = (u32x4){0u, 0u, 0u, 0u};
        if (!first && !late) pv = *(const u32x4*)pp;
        __syncthreads();
        {
#pragma unroll
            for (int j = 0; j < 8; ++j) {
                const int t = tq * 8 + j;
                const unsigned raw = *(const unsigned*)(rawL + t * 192 + which * 64 + 2 * pi);
                const float x1 = bflo(raw), x2 = bfhi(raw);
                float c = 1.f, s = 0.f;
                if (!isctx) { const int pos = low + t - s0; const float ppos = (pi < 16) ? (float)(pos >> 6) : (float)(pos & 63); const float ang = ppos * inv; c = __cosf(ang); s = __sinf(ang); }
                const float o1 = x1 * c - x2 * s, o2 = x1 * s + x2 * c;
                if (which == 0) *(unsigned*)(Cn + t * SN + 2 * pi) = pk2(o1, o2);
                else {
                    const float k1 = o1 * 0.125f, k2 = o2 * 0.125f, wt = wL[t];
                    *(unsigned*)(Bn + t * SN + 2 * pi) = pk2(k1, k2);
                    BwT[(2 * pi) * SS + t] = f2bf(k1 * wt); BwT[(2 * pi + 1) * SS + t] = f2bf(k2 * wt);
                }
            }
            unsigned xo[4];
#pragma unroll
            for (int j = 0; j < 8; ++j) { const unsigned v = rawL[(tq * 8 + j) * 192 + 128 + pairidx]; if (j & 1) xo[j >> 1] |= v << 16; else xo[j >> 1] = v; }
            *(u32x4*)(XT + pairidx * SS + tq * 8) = (u32x4){xo[0], xo[1], xo[2], xo[3]};
        }
        __syncthreads();
        if (!first && late) pv = *(const u32x4*)pp;
        if (tau + 1 < 264) RET_PREFETCH(tau + 1);
        cs_core<64>(base, accS, dir, w, fr, fq);
        cs_writeout<64, false>(base, pp, pv, tl, 0.f);
    }
#undef RET_PREFETCH
}

__device__ __forceinline__ void shift_phase(CParams& p_in, int l_in, int part, unsigned char* smem) {
    CParams* pq_ = &p_in; asm volatile("" : "+s"(pq_)); CParams& p = *pq_;
    int l = l_in; asm volatile("" : "+s"(l));
    const int tidx = opaque_tid();
    bf16_t* RW = (bf16_t*)(p.ws + OFF_RW);
    u32x2* halo = (u32x2*)smem;
    const int c0 = tidx * 4;
    if (tidx >= 448) return;
    if (part == 0) {
        for (int k = 0; k < 5; ++k) {
            const int chunk = blockIdx.x + k * gridDim.x; if (chunk >= R / 32) break;
            const int lo = chunk * 32; int s0, s1;
            if (lo < RL) { s0 = lo & ~8191; s1 = s0 + 8192; } else { s0 = RL + ((lo - RL) & ~255); s1 = s0 + 256; }
            u32x2 a = (u32x2){0u, 0u}, b = (u32x2){0u, 0u};
            if (lo - 1 >= s0) a = *(const u32x2*)(RW + (size_t)(lo - 1) * 1792 + c0);
            if (lo + 32 < s1) b = *(const u32x2*)(RW + (size_t)(lo + 32) * 1792 + c0);
            halo[(k * 2 + 0) * 448 + tidx] = a; halo[(k * 2 + 1) * 448 + tidx] = b;
        }
        return;
    }
    const f32x4 mx = *(const f32x4*)(p.in[15] + (size_t)l * 1792 + c0);
    const int kind = (c0 >= 1536 && c0 < 1600) ? 1 : (c0 >= 1664 ? 2 : 0);
    for (int k = 0; k < 5; ++k) {
        const int chunk = blockIdx.x + k * gridDim.x; if (chunk >= R / 32) break;
        bf16_t* base = RW + (size_t)chunk * 32 * 1792 + c0;
        u32x2 rows[34];
        rows[0] = halo[(k * 2 + 0) * 448 + tidx]; rows[33] = halo[(k * 2 + 1) * 448 + tidx];
#pragma unroll
        for (int t = 0; t < 32; ++t) rows[t + 1] = *(const u32x2*)(base + (size_t)t * 1792);
#pragma unroll
        for (int t = 0; t < 32; ++t) {
            const u32x2 a = rows[t], b = rows[t + 1], c = rows[t + 2];
            f32x4 u0 = (f32x4){bflo(a.x), bfhi(a.x), bflo(a.y), bfhi(a.y)}, u1 = (f32x4){bflo(b.x), bfhi(b.x), bflo(b.y), bfhi(b.y)}, u2 = (f32x4){bflo(c.x), bfhi(c.x), bflo(c.y), bfhi(c.y)};
            f32x4 v = u1 + mx * ((u0 + u2) * 0.5f - u1);
            if (kind == 1) { v.x = fast_tanh(v.x); v.y = fast_tanh(v.y); v.z = fast_tanh(v.z); v.w = fast_tanh(v.w); }
            else if (kind == 2) { v.x = sigmoidf_(v.x); v.y = sigmoidf_(v.y); v.z = sigmoidf_(v.z); v.w = sigmoidf_(v.w); }
            u32x2 o; o.x = pk2(v.x, v.y); o.y = pk2(v.z, v.w);
            *(u32x2*)(base + (size_t)t * 1792) = o;
        }
    }
}

__device__ __forceinline__ void rwkv_scan_item(CParams& p_in, int l_in, int item, unsigned char* smem) {
    CParams* pq_ = &p_in; asm volatile("" : "+s"(pq_)); CParams& p = *pq_;
    int l = l_in; asm volatile("" : "+s"(l));
    const int tidx = opaque_tid();
    const int b = item >> 5, h = (item >> 2) & 7, rq = item & 3;
    const int tid = tidx, dir = tid >> 8, tl = tid & 255, lane = tid & 63, wv = tl >> 6;
    const int kq = lane & 15, rloc = wv * 4 + (lane >> 4);
    const int fr = lane & 15, fq = lane >> 4;
    unsigned char* base = smem + dir * 67072;
    float* rL = (float*)base;
    float *kL = rL + 2048, *wL = kL + 2048, *bL = wL + 2048, *nkL = bL + 2048, *vL = nkL + 2048, *yL = vL + 1024;
    float* kdL = (float*)(base + 58880);
    bf16_t* twB = (bf16_t*)(yL + 1024);
    bf16_t* aloB = twB + 2048;
    float* invn = (float*)(aloB + 2048);
    const bf16_t* RW = (const bf16_t*)(p.ws + OFF_RW);
    bf16_t* P = (bf16_t*)(p.ws + OFF_PRW);
    const int cch = h * 64 + wv * 16 + fr;
    bf16x8 Bw[2], Ba[2];
    {
        const float* w2g = p.in[17] + ((size_t)(l * 2 + dir) * 64) * 512 + cch;
        const float* a2g = p.in[19] + ((size_t)l * 64) * 512 + cch;
#pragma unroll
        for (int kc = 0; kc < 2; ++kc)
#pragma unroll
            for (int e = 0; e < 8; ++e) {
                const int j = kc * 32 + fq * 8 + e;
                Bw[kc][e] = (short)f2bf(w2g[(size_t)j * 512]); Ba[kc][e] = (short)f2bf(a2g[(size_t)j * 512]);
            }
    }
    const float w0c = p.in[16][(l * 2 + dir) * 512 + cch], a0c = p.in[18][(l * 2 + dir) * 512 + cch];
    const float kkc = p.in[21][l * 512 + cch], kac = p.in[22][l * 512 + cch];
    const int t2 = tl >> 3, part2 = tl & 7;
    f32x4 kk2a = *(const f32x4*)(p.in[21] + l * 512 + h * 64 + part2 * 8), kk2b = *(const f32x4*)(p.in[21] + l * 512 + h * 64 + part2 * 8 + 4);
    float S[4];
#pragma unroll
    for (int i = 0; i < 4; ++i) S[i] = 0.f;
    u32x4 rv[5];
    int pf_off[5], pf_dst[5], pf_mode[5];
#pragma unroll
    for (int i = 0; i < 5; ++i) {
        const int e = tl + 256 * i; const int rr = e / 34, ch = e - rr * 34;
        const int col = ch < 8 ? h * 64 + ch * 8 : (ch < 16 ? 512 + h * 64 + (ch - 8) * 8 : (ch < 32 ? 1536 + (ch - 16) * 8 : 1024 + h * 64 + rq * 16 + (ch - 32) * 8));
        pf_off[i] = rr * 1792 + col;
        int dst, mode;
        if (ch < 8) { dst = (int)((unsigned char*)(rL + rr * 64 + ch * 8) - base); mode = 0; }
        else if (ch < 16) { dst = (int)((unsigned char*)(kL + rr * 64 + (ch - 8) * 8) - base); mode = 0; }
        else if (ch < 24) { dst = (int)((unsigned char*)(twB + rr * 64 + (ch - 16) * 8) - base); mode = 1; }
        else if (ch < 32) { dst = (int)((unsigned char*)(aloB + rr * 64 + (ch - 24) * 8) - base); mode = 1; }
        else { dst = (int)((unsigned char*)(vL + rr * 16 + (ch - 32) * 8) - base); mode = 0; }
        pf_dst[i] = dst; pf_mode[i] = (e < 32 * 34) ? mode : -1;
    }
#define RW_PREFETCH(tau_) do { int low_, s0_, s1_; bool ic_, fi_; scan_tile(b, dir, (tau_), low_, s0_, s1_, ic_, fi_); \
        const bf16_t* rb_ = RW + (size_t)low_ * 1792; \
        _Pragma("unroll") for (int i = 0; i < 5; ++i) { \
            rv[i] = (u32x4){0u, 0u, 0u, 0u}; \
            if (pf_mode[i] >= 0) rv[i] = *(const u32x4*)(rb_ + pf_off[i]); } } while (0)
    RW_PREFETCH(0);
    for (int tau = 0; tau < 264; ++tau) {
        int low, s0, s1; bool isctx, first;
        scan_tile(b, dir, tau, low, s0, s1, isctx, first);
#pragma unroll
        for (int i = 0; i < 5; ++i) {
            if (pf_mode[i] == 1) *(u32x4*)(base + pf_dst[i]) = rv[i];
            else if (pf_mode[i] == 0) {
                *(f32x4*)(base + pf_dst[i]) = (f32x4){bflo(rv[i].x), bfhi(rv[i].x), bflo(rv[i].y), bfhi(rv[i].y)};
                *(f32x4*)(base + pf_dst[i] + 16) = (f32x4){bflo(rv[i].z), bfhi(rv[i].z), bflo(rv[i].w), bfhi(rv[i].w)};
            }
        }
        bf16_t* pp = P + (size_t)(low + t2) * 512 + h * 64 + rq * 16 + part2 * 2;
        const bool late = (tau == 4) || (tau == 136);
        unsigned pv = 0u;
        if (!first && !late) pv = *(const unsigned*)pp;
        __syncthreads();
        {
            const f32x4 ka = *(const f32x4*)(kL + t2 * 64 + part2 * 8), kb = *(const f32x4*)(kL + t2 * 64 + part2 * 8 + 4);
            const f32x4 pa = ka * kk2a, pb = kb * kk2b;
            float ss = pa.x * pa.x + pa.y * pa.y + pa.z * pa.z + pa.w * pa.w + pb.x * pb.x + pb.y * pb.y + pb.z * pb.z + pb.w * pb.w;
            ss = red8(ss);
            if (part2 == 0) { const float iv = __builtin_amdgcn_rcpf(fmaxf(sqrtf(ss), 1e-12f)); invn[t2] = iv * iv; }
        }
        f32x4 accw[2], acca[2];
#pragma unroll
        for (int mt = 0; mt < 2; ++mt) {
            accw[mt] = (f32x4){0.f, 0.f, 0.f, 0.f}; acca[mt] = (f32x4){0.f, 0.f, 0.f, 0.f};
#pragma unroll
            for (int kc = 0; kc < 2; ++kc) {
                const bf16x8 Aw = *(const bf16x8*)(twB + (mt * 16 + fr) * 64 + kc * 32 + fq * 8);
                const bf16x8 Aa = *(const bf16x8*)(aloB + (mt * 16 + fr) * 64 + kc * 32 + fq * 8);
                accw[mt] = __builtin_amdgcn_mfma_f32_16x16x32_bf16(Aw, Bw[kc], accw[mt], 0, 0, 0);
                acca[mt] = __builtin_amdgcn_mfma_f32_16x16x32_bf16(Aa, Ba[kc], acca[mt], 0, 0, 0);
            }
        }
#pragma unroll
        for (int mt = 0; mt < 2; ++mt)
#pragma unroll
            for (int r = 0; r < 4; ++r) {
                const int t = mt * 16 + fq * 4 + r, c = wv * 16 + fr;
                const float wl = w0c + accw[mt][r];
                const float decay = __expf(-0.6065306597f * sigmoidf_(wl));
                const float a = sigmoidf_(a0c + acca[mt][r]);
                const float kraw = kL[t * 64 + c];
                const float kk = kraw * kkc;
                wL[t * 64 + c] = decay;
                kdL[t * 64 + c] = kraw * (1.f + (a - 1.f) * kac);
                bL[t * 64 + c] = kk * a;
                nkL[t * 64 + c] = -kk;
            }
        __syncthreads();
        if (!first && late) pv = *(const unsigned*)pp;
        if (tau + 1 < 264) RW_PREFETCH(tau + 1);
        {
            const float* __restrict__ nkR = nkL + kq * 4; const float* __restrict__ wR = wL + kq * 4; const float* __restrict__ bR = bL + kq * 4;
            const float* __restrict__ kR = kdL + kq * 4; const float* __restrict__ rR = rL + kq * 4; const float* __restrict__ vR = vL + rloc;
            float* __restrict__ yW = yL + rloc;
            const int t0 = dir ? 31 : 0, dt = dir ? -1 : 1;
            f32x4 n0 = *(const f32x4*)(nkR + t0 * 64), wa = *(const f32x4*)(wR + t0 * 64), ba = *(const f32x4*)(bR + t0 * 64);
            f32x4 ka = *(const f32x4*)(kR + t0 * 64), ra = *(const f32x4*)(rR + t0 * 64);
            float vv = vR[t0 * 16], iv2 = invn[t0];
            f32x2_t S01 = {S[0], S[1]}, S23 = {S[2], S[3]};
            float yprev = 0.f; int tprev = t0;
#pragma unroll 2
            for (int j = 0; j < 32; ++j) {
                const int tt = t0 + dt * j;
                const int tn = (j < 31) ? tt + dt : tt;
                const f32x4 n0n = *(const f32x4*)(nkR + tn * 64), wan = *(const f32x4*)(wR + tn * 64), ban = *(const f32x4*)(bR + tn * 64);
                const f32x4 kan = *(const f32x4*)(kR + tn * 64), ran = *(const f32x4*)(rR + tn * 64);
                const float vvn = vR[tn * 16], iv2n = invn[tn];
                f32x2_t pp2 = S01 * (f32x2_t){n0.x, n0.y};
                pp2 = __builtin_elementwise_fma(S23, (f32x2_t){n0.z, n0.w}, pp2);
                float ra_ = pp2.x + pp2.y, rb_ = yprev;
                ra_ += dppf<0xB1>(ra_); rb_ += dppf<0xB1>(rb_);
                ra_ += dppf<0x4E>(ra_); rb_ += dppf<0x4E>(rb_);
                ra_ += dppf<0x141>(ra_); rb_ += dppf<0x141>(rb_);
                ra_ += dppf<0x140>(ra_); rb_ += dppf<0x140>(rb_);
                if (kq == 0 && j > 0) yW[tprev * 16] = rb_;
                const float sa = ra_ * iv2;
                const f32x2_t sav = {sa, sa}, vvv = {vv, vv};
                f32x2_t t01 = vvv * (f32x2_t){ka.x, ka.y}, t23 = vvv * (f32x2_t){ka.z, ka.w};
                t01 = __builtin_elementwise_fma(sav, (f32x2_t){ba.x, ba.y}, t01);
                t23 = __builtin_elementwise_fma(sav, (f32x2_t){ba.z, ba.w}, t23);
                S01 = __builtin_elementwise_fma(S01, (f32x2_t){wa.x, wa.y}, t01);
                S23 = __builtin_elementwise_fma(S23, (f32x2_t){wa.z, wa.w}, t23);
                f32x2_t qq = S01 * (f32x2_t){ra.x, ra.y};
                qq = __builtin_elementwise_fma(S23, (f32x2_t){ra.z, ra.w}, qq);
                yprev = qq.x + qq.y; tprev = tt;
                n0 = n0n; wa = wan; ba = ban; ka = kan; ra = ran; vv = vvn; iv2 = iv2n;
            }
            { const float y = red16(yprev); if (kq == 0) yW[tprev * 16] = y; }
            S[0] = S01.x; S[1] = S01.y; S[2] = S23.x; S[3] = S23.y;
        }
        __syncthreads();
        {
            const float y0 = yL[t2 * 16 + part2 * 2], y1 = yL[t2 * 16 + part2 * 2 + 1];
            *(unsigned*)pp = pk2(bflo(pv) + y0, bfhi(pv) + y1);
        }
    }
#undef RW_PREFETCH
}

__device__ __forceinline__ void scan_phase(CParams& p, int l, unsigned char* smem) {
    for (int it = blockIdx.x; it < 224; it += gridDim.x) {
        if (it < 128) rwkv_scan_item(p, l, it, smem);
        else if (it < 192) ssd_scan_item(p, l, it - 128, smem);
        else ret_scan_item(p, l, it - 192, smem);
        __syncthreads();
    }
    int cb = (int)blockIdx.x - 224, cn = (int)gridDim.x - 224;
    if (cn <= 0) { cb = blockIdx.x; cn = gridDim.x; }
    if (cb >= 0) cvt_mix(p, l, smem, cb, cn);
}

__device__ __forceinline__ void post_phase(CParams& p_in, int l_in, int nrows, unsigned char* smem) {
    CParams* pq_ = &p_in; asm volatile("" : "+s"(pq_)); CParams& p = *pq_;
    int l = l_in; asm volatile("" : "+s"(l));
    const int tidx = opaque_tid();
    const int lane = tidx & 63, gw = blockIdx.x * 8 + (tidx >> 6), ngw = gridDim.x * 8;
    unsigned char* ws = p.ws;
    const float* MOD = (const float*)(ws + OFF_MOD);
    for (int row = gw; row < nrows; row += ngw) {
        {
            const bf16_t* yp = (const bf16_t*)(ws + OFF_H) + (size_t)row * 1024 + lane * 16;
            bf16_t* zp = (bf16_t*)(ws + OFF_Z) + (size_t)row * 1024 + lane * 16;
            const float* nw = p.in[13] + (size_t)l * 1024 + lane * 16;
            float v[16]; float ss = 0.f;
#pragma unroll
            for (int q = 0; q < 2; ++q) {
                const u32x4 yr = *(const u32x4*)(yp + q * 8), zr = *(const u32x4*)(zp + q * 8);
                const unsigned ya[4] = {yr.x, yr.y, yr.z, yr.w}, za[4] = {zr.x, zr.y, zr.z, zr.w};
#pragma unroll
                for (int e = 0; e < 4; ++e) {
                    const float y0 = bflo(ya[e]), y1 = bfhi(ya[e]), z0 = bflo(za[e]), z1 = bfhi(za[e]);
                    const float a = y0 * siluf_(z0), c = y1 * siluf_(z1);
                    v[q * 8 + e * 2] = a; v[q * 8 + e * 2 + 1] = c; ss += a * a + c * c;
                }
            }
            ss = red16(ss); ss += __shfl_xor(ss, 16);
            const float rs = rsqrtf(ss * (1.f / 512.f) + 1e-6f);
#pragma unroll
            for (int q = 0; q < 2; ++q) {
                const f32x4 wa = *(const f32x4*)(nw + q * 8), wb = *(const f32x4*)(nw + q * 8 + 4);
                u32x4 o;
                o.x = pk2(v[q * 8 + 0] * rs * wa.x, v[q * 8 + 1] * rs * wa.y); o.y = pk2(v[q * 8 + 2] * rs * wa.z, v[q * 8 + 3] * rs * wa.w);
                o.z = pk2(v[q * 8 + 4] * rs * wb.x, v[q * 8 + 5] * rs * wb.y); o.w = pk2(v[q * 8 + 6] * rs * wb.z, v[q * 8 + 7] * rs * wb.w);
                *(u32x4*)(zp + q * 8) = o;
            }
        }
        {
            const bf16_t* yp = (const bf16_t*)(ws + OFF_PRET) + (size_t)row * 512 + lane * 8;
            bf16_t* gp = (bf16_t*)(ws + OFF_G) + (size_t)row * 512 + lane * 8;
            const u32x4 yr = *(const u32x4*)yp, gr = *(const u32x4*)gp;
            const unsigned ya[4] = {yr.x, yr.y, yr.z, yr.w}, ga[4] = {gr.x, gr.y, gr.z, gr.w};
            float v[8], gg[8]; float s = 0.f;
#pragma unroll
            for (int e = 0; e < 4; ++e) { v[2 * e] = bflo(ya[e]); v[2 * e + 1] = bfhi(ya[e]); gg[2 * e] = bflo(ga[e]); gg[2 * e + 1] = bfhi(ga[e]); s += v[2 * e] + v[2 * e + 1]; }
            s = red16(s);
            const float mean = s * (1.f / 128.f); float q2 = 0.f;
#pragma unroll
            for (int e = 0; e < 8; ++e) { v[e] -= mean; q2 += v[e] * v[e]; }
            q2 = red16(q2);
            const float rs = rsqrtf(q2 * (1.f / 128.f) + 1e-6f);
            u32x4 o;
            o.x = pk2(v[0] * rs * siluf_(gg[0]), v[1] * rs * siluf_(gg[1])); o.y = pk2(v[2] * rs * siluf_(gg[2]), v[3] * rs * siluf_(gg[3]));
            o.z = pk2(v[4] * rs * siluf_(gg[4]), v[5] * rs * siluf_(gg[5])); o.w = pk2(v[6] * rs * siluf_(gg[6]), v[7] * rs * siluf_(gg[7]));
            *(u32x4*)gp = o;
        }
        {
            const bool lat = row < RL; const int mi = lat ? (row >> 13) : 4;
            const float* xin;
            if (lat) xin = (l == 0) ? p.in[0] + (size_t)row * 1024 : p.out + (size_t)row * 1024;
            else xin = (l == 0) ? p.in[2] + (size_t)(row - RL) * 1024 : (const float*)(ws + OFF_CTXS) + (size_t)(row - RL) * 1024;
            const float* modl = MOD + (size_t)(l * 5 + mi) * 6144;
            row_pass(xin, nullptr, nullptr, nullptr, nullptr, true, p.in[4] + (l * 4 + 0) * 1024, modl, modl + 1024, (bf16_t*)(ws + OFF_XBC) + (size_t)row * 1024, lane);
        }
    }
    bf16_t* aB = (bf16_t*)smem;
    bf16_t* gB = aB + 32 * 72;
    float* asL = (float*)(smem + 13312);
    float* gsL = asL + 32 * 512;
    const bf16_t* RW = (const bf16_t*)(ws + OFF_RW);
    bf16_t* P = (bf16_t*)(ws + OFF_PRW);
    const float* mix = p.in[15] + (size_t)l * 1792;
    const int c = tidx;
    const float a0f = p.in[18][(l * 2 + 0) * 512 + c], a0b = p.in[18][(l * 2 + 1) * 512 + c];
    const float kac = p.in[22][l * 512 + c], rkc = p.in[23][l * 512 + c], lw = p.in[24][l * 512 + c], lb = p.in[25][l * 512 + c];
    const float mxr = mix[c], mxk = mix[512 + c], mxv = mix[1024 + c];
    const int wvB = tidx >> 6, frB = lane & 15, fqB = lane >> 4;
    const float* a2 = p.in[19] + (size_t)l * 64 * 512 + wvB * 64 + frB;
    const float* g2 = p.in[20] + (size_t)l * 128 * 512 + wvB * 64 + frB;
    for (int tile = blockIdx.x; tile < nrows / 32; tile += gridDim.x) {
        const int low = tile * 32;
        int s0, s1;
        if (low < RL) { s0 = low & ~8191; s1 = s0 + 8192; } else { s0 = RL + ((low - RL) & ~255); s1 = s0 + 256; }
        {
            for (int e = tidx; e < 32 * 24; e += 512) {
                const int t = e / 24, ch = e - t * 24;
                const u32x4 v = *(const u32x4*)(RW + (size_t)(low + t) * 1792 + 1600 + ch * 8);
                if (ch < 8) *(u32x4*)(aB + t * 72 + ch * 8) = v; else *(u32x4*)(gB + t * 136 + (ch - 8) * 8) = v;
            }
        }
        __syncthreads();
        {
            bf16x8 Aa[2][2], Ag[2][4];
#pragma unroll
            for (int mt = 0; mt < 2; ++mt) {
#pragma unroll
                for (int kc = 0; kc < 2; ++kc) Aa[mt][kc] = *(const bf16x8*)(aB + (mt * 16 + frB) * 72 + kc * 32 + fqB * 8);
#pragma unroll
                for (int kc = 0; kc < 4; ++kc) Ag[mt][kc] = *(const bf16x8*)(gB + (mt * 16 + frB) * 136 + kc * 32 + fqB * 8);
            }
#pragma unroll 1
            for (int nt = 0; nt < 4; ++nt) {
                bf16x8 ba[2], bg[4];
#pragma unroll
                for (int kc = 0; kc < 2; ++kc)
#pragma unroll
                    for (int e = 0; e < 8; ++e) ba[kc][e] = (short)f2bf(a2[(size_t)(kc * 32 + fqB * 8 + e) * 512 + nt * 16]);
#pragma unroll
                for (int kc = 0; kc < 4; ++kc)
#pragma unroll
                    for (int e = 0; e < 8; ++e) bg[kc][e] = (short)f2bf(g2[(size_t)(kc * 32 + fqB * 8 + e) * 512 + nt * 16]);
#pragma unroll
                for (int mt = 0; mt < 2; ++mt) {
                    f32x4 ca = (f32x4){0.f, 0.f, 0.f, 0.f}, cg = (f32x4){0.f, 0.f, 0.f, 0.f};
#pragma unroll
                    for (int kc = 0; kc < 2; ++kc) ca = __builtin_amdgcn_mfma_f32_16x16x32_bf16(Aa[mt][kc], ba[kc], ca, 0, 0, 0);
#pragma unroll
                    for (int kc = 0; kc < 4; ++kc) cg = __builtin_amdgcn_mfma_f32_16x16x32_bf16(Ag[mt][kc], bg[kc], cg, 0, 0, 0);
#pragma unroll
                    for (int r = 0; r < 4; ++r) {
                        const int idx = (mt * 16 + fqB * 4 + r) * 512 + wvB * 64 + nt * 16 + frB;
                        asL[idx] = ca[r]; gsL[idx] = cg[r];
                    }
                }
            }
        }
        __syncthreads();
        const bf16_t* u = RW + (size_t)low * 1792;
#pragma unroll 1
        for (int tb = 0; tb < 32; tb += 8) {
            bf16_t rr[8], kk8[8], vv8[8], yy[8];
#pragma unroll
            for (int i = 0; i < 8; ++i) {
                const bf16_t* un = u + (size_t)(tb + i) * 1792;
                rr[i] = un[c]; kk8[i] = un[512 + c]; vv8[i] = un[1024 + c]; yy[i] = P[(size_t)(low + tb + i) * 512 + c];
            }
#pragma unroll
            for (int i = 0; i < 8; ++i) {
                const int row = low + tb + i;
                const float r = bf2f(rr[i]), k = bf2f(kk8[i]), v = bf2f(vv8[i]), y = bf2f(yy[i]);
                const float ash = asL[(tb + i) * 512 + c];
                const float af = sigmoidf_(a0f + ash), ab = sigmoidf_(a0b + ash);
                const float ks = k * (2.f + (af + ab - 2.f) * kac);
                const float bsum = wave_sum(r * ks * rkc);
                const float mean = wave_sum(y) * (1.f / 64.f);
                const float d = y - mean;
                const float var = wave_sum(d * d) * (1.f / 64.f);
                const float yn = d * rsqrtf(var + 64e-5f) * lw + lb;
                P[(size_t)row * 512 + c] = f2bf((yn + bsum * v) * gsL[(tb + i) * 512 + c]);
            }
        }
        __syncthreads();
    }
}

__device__ __forceinline__ void flat_barrier(unsigned* cnt, unsigned target) {
    asm volatile("s_waitcnt vmcnt(0)" ::: "memory");
    __syncthreads();
    if (threadIdx.x == 0) {
        __builtin_amdgcn_fence(__ATOMIC_RELEASE, "agent");
        asm volatile("s_waitcnt vmcnt(0)" ::: "memory");
        __hip_atomic_fetch_add(cnt, 1u, __ATOMIC_RELAXED, __HIP_MEMORY_SCOPE_AGENT);
        while (__hip_atomic_load(cnt, __ATOMIC_RELAXED, __HIP_MEMORY_SCOPE_AGENT) < target) __builtin_amdgcn_s_sleep(1);
        __builtin_amdgcn_fence(__ATOMIC_ACQUIRE, "agent");
        asm volatile("s_waitcnt vmcnt(0)" ::: "memory");
    }
    __syncthreads();
}

__global__ void __launch_bounds__(512) mega(Params p_arg) {
    extern __shared__ __attribute__((aligned(16))) unsigned char smem[];
    CParams* pbase = (CParams*)__builtin_amdgcn_kernarg_segment_ptr();
    const int ph_lo = p_arg.ph_lo, ph_hi = p_arg.ph_hi;
    for (int ph = ph_lo; ph < ph_hi; ++ph) {
        CParams* pq = pbase;
        asm volatile("" : "+s"(pq));
        CParams& p = *pq;
        int gm = -1, l = 0, sub = -1;
        if (ph >= 2) { l = (ph - 2) / 11; sub = (ph - 2) % 11; }
        const int nrows = (l == 3) ? RL : R;
        if (sub == 0) gm = GM_IN; else if (sub == 5) gm = GM_MERGE; else if (sub == 6) gm = GM_OUT; else if (sub == 8) gm = GM_MLP1; else if (sub == 9) gm = GM_MLP2;
        if (gm >= 0) {
            gemm_phase(p, gm, gm == GM_IN ? 132 : nrows / 256, (LAS unsigned char*)smem);
            __syncthreads();
        } else if (ph == 0) {
            phase_mod(p, smem);
            cvt_win(p, 0, smem, blockIdx.x, gridDim.x);
        } else if (ph == 1) {
            token_phase(p, 0, 0, R);
        } else if (sub == 1) {
            shift_phase(p, l, 0, smem);
        } else if (sub == 2) {
            shift_phase(p, l, 1, smem);
        } else if (sub == 3) {
            scan_phase(p, l, smem);
        } else if (sub == 4) {
            post_phase(p, l, nrows, smem);
        } else if (sub == 7) {
            token_phase(p, l, 1, nrows);
            cvt_mlp(p, l, smem, blockIdx.x, gridDim.x);
        } else if (sub == 10) {
            token_phase(p, l, 2, nrows);
            if (l < 3) cvt_win(p, l + 1, smem, blockIdx.x, gridDim.x);
        }
        if (ph + 1 < ph_hi) {
            if (ph == ph_lo) { __threadfence(); cg::this_grid().sync(); }
            else flat_barrier((unsigned*)(p_arg.ws + OFF_BAR), (unsigned)(ph - ph_lo) * gridDim.x);
        }
    }
}

extern "C" void kernel_launch(void* const* d_in, const int* in_sizes, int n_in, void* d_out, int out_size, void* d_ws, size_t ws_size, hipStream_t stream) {
    static int grid = 0;
    if (grid == 0) {
        if (n_in != 32 || ws_size < WS_END) { fprintf(stderr, "kernel_launch: bad n_in %d or ws %zu < %zu\n", n_in, ws_size, (size_t)WS_END); grid = -1; return; }
        if (hipFuncSetAttribute((const void*)mega, hipFuncAttributeMaxDynamicSharedMemorySize, LDS_BYTES) != hipSuccess) { grid = -1; return; }
        int dev = 0, cus = 0, per_cu = 0;
        hipGetDevice(&dev);
        hipDeviceGetAttribute(&cus, hipDeviceAttributeMultiprocessorCount, dev);
        hipOccupancyMaxActiveBlocksPerMultiprocessor(&per_cu, (const void*)mega, 512, LDS_BYTES);
        (void)hipGetLastError();
        if (per_cu < 1) per_cu = 1;
        grid = cus * per_cu; if (grid > 256) grid = 256;
    }
    if (grid < 0) return;
    Params p{};
    for (int i = 0; i < 32; ++i) p.in[i] = (const float*)d_in[i];
    p.out = (float*)d_out; p.ws = (unsigned char*)d_ws;
    p.ph_lo = 0; p.ph_hi = NPH; p.coop = 1; p.pad = 0;
    if (hipMemsetAsync((char*)d_ws + OFF_BAR, 0, 64, stream) != hipSuccess) return;
    void* args[] = {&p};
    hipError_t e = hipLaunchCooperativeKernel((const void*)mega, dim3(grid), dim3(512), args, LDS_BYTES, stream);
    if (e != hipSuccess) fprintf(stderr, "cooperative launch failed: %s (grid %d)\n", hipGetErrorString(e), grid);
}
```

```cpp
#include <hip/hip_runtime.h>
#include <hip/hip_cooperative_groups.h>
#include <cstdint>
#include <cstdio>
namespace cg = cooperative_groups;

typedef unsigned short bf16_t;
typedef short bf16x8 __attribute__((ext_vector_type(8)));
typedef float f32x4 __attribute__((ext_vector_type(4)));
typedef unsigned u32x2 __attribute__((ext_vector_type(2)));
typedef unsigned u32x4 __attribute__((ext_vector_type(4)));

constexpr int RL = 32768;
constexpr int RC = 1024;
constexpr int R = RL + RC;
constexpr int LDS_BYTES = 153600;
constexpr int NPH = 2 + 11 * 4;
#ifndef PROBE_SCAN
#define PROBE_SCAN 0
#endif
#ifndef PROBE_GEMM
#define PROBE_GEMM 0
#endif

constexpr size_t OFF_MOD = 0;
constexpr size_t OFF_BAR = 491776;
constexpr size_t OFF_CTXS = 524288;
constexpr size_t OFF_DT = OFF_CTXS + 4194304;
constexpr size_t OFF_W = OFF_DT + (size_t)R * 32 * 4;
constexpr size_t OFF_H = OFF_W + 16777216;
constexpr size_t SZ1024 = (size_t)R * 1024 * 2;
constexpr size_t OFF_Z = OFF_H + SZ1024;
constexpr size_t OFF_XBC = OFF_Z + SZ1024;
constexpr size_t OFF_QKV = OFF_XBC + (size_t)R * 1536 * 2;
constexpr size_t OFF_G = OFF_QKV + SZ1024;
constexpr size_t OFF_RW = OFF_G + (size_t)R * 512 * 2;
constexpr size_t OFF_PRET = OFF_RW + (size_t)R * 1792 * 2;
constexpr size_t OFF_PRW = OFF_PRET + (size_t)R * 512 * 2;
constexpr size_t WS_END = OFF_PRW + (size_t)R * 512 * 2;
constexpr size_t W_G = 0, W_SO = 6291456, W_RO = 8388608, W_WO = 9437184, W_O = 10485760;
constexpr size_t W_1 = 0, W_2 = 8388608;
constexpr size_t MSCR_S = 0, MSCR_M = (size_t)256 * 131072;

struct Params {
    const float* in[32];
    float* out;
    unsigned char* ws;
    int ph_lo, ph_hi, coop, pad;
};

typedef const __attribute__((address_space(4))) Params CParams;

__device__ __forceinline__ float bf2f(bf16_t h) { return __uint_as_float(((unsigned)h) << 16); }
__device__ __forceinline__ float bflo(unsigned u) { return __uint_as_float(u << 16); }
__device__ __forceinline__ float bfhi(unsigned u) { return __uint_as_float(u & 0xffff0000u); }
typedef float f32x2_t __attribute__((ext_vector_type(2)));
typedef __bf16 bf16x2_t __attribute__((ext_vector_type(2)));
__device__ __forceinline__ unsigned pk2(float a, float b) { const f32x2_t v = {a, b}; const bf16x2_t r = __builtin_convertvector(v, bf16x2_t); return __builtin_bit_cast(unsigned, r); }
__device__ __forceinline__ bf16_t f2bf(float f) { const __bf16 r = (__bf16)f; return __builtin_bit_cast(unsigned short, r); }
template <int CTRL> __device__ __forceinline__ float dppf(float v) {
    return __builtin_bit_cast(float, __builtin_amdgcn_update_dpp(0, __builtin_bit_cast(int, v), CTRL, 0xf, 0xf, true));
}
__device__ __forceinline__ float red4(float v) { v += dppf<0xB1>(v); v += dppf<0x4E>(v); return v; }
__device__ __forceinline__ float red8(float v) { v = red4(v); v += dppf<0x141>(v); return v; }
__device__ __forceinline__ float red16(float v) { v = red8(v); v += dppf<0x140>(v); return v; }
__device__ __forceinline__ float wave_sum(float v) { v = red16(v); v += __shfl_xor(v, 16); v += __shfl_xor(v, 32); return v; }
__device__ __forceinline__ int opaque_tid() { int t = threadIdx.x; asm volatile("" : "+v"(t)); return t; }
__device__ __forceinline__ float sigmoidf_(float x) { return __builtin_amdgcn_rcpf(1.f + __expf(-x)); }
__device__ __forceinline__ float siluf_(float x) { return x * __builtin_amdgcn_rcpf(1.f + __expf(-x)); }
__device__ __forceinline__ float fast_tanh(float x) { return 1.f - 2.f * __builtin_amdgcn_rcpf(1.f + __expf(2.f * x)); }
__device__ __forceinline__ float fast_softplus(float x) { return x > 20.f ? x : __logf(1.f + __expf(x)); }
__device__ __forceinline__ float softplusf_(float x) { return x > 20.f ? x : log1pf(__expf(x)); }

constexpr int BK = 64, HALF = 128, HT = HALF * BK;
__device__ __forceinline__ int lds_byte(int r, int c) {
    int st = (r >> 4) * 2 + (c >> 5), rr = r & 15, cc = c & 31, ob = rr * 64 + cc * 2;
    return st * 1024 + (ob ^ (((ob >> 9) & 1) << 5));
}
__device__ __forceinline__ void stage_rc(int b, int& Rr, int& Cc) {
    int st = b / 1024, sb = b % 1024, swz = sb ^ (((sb >> 9) & 1) << 5);
    Rr = (st >> 1) * 16 + swz / 64; Cc = (st & 1) * 32 + (swz % 64) / 2;
}

#define LAS __attribute__((address_space(3)))
constexpr int HTB = HALF * BK * 2;

__device__ __forceinline__ bool tile_next(int i, int G, int c, int nM, int nN, int& pm, int& pn) {
    const int nwg = nM * nN;
    const long L = (long)i * G + c; if (L >= nwg) return false;
    int wgid = (int)L; { const int q = nwg / 8, r = nwg % 8, xcd = wgid % 8, off = wgid / 8; wgid = (xcd < r ? xcd * (q + 1) : r * (q + 1) + (xcd - r) * q) + off; }
    const int nig = 8 * nN, gid = wgid / nig, fm = gid * 8, gsz = (nM - fm) < 8 ? (nM - fm) : 8;
    pm = fm + ((wgid % nig) % gsz); pn = (wgid % nig) / gsz; return true;
}

enum { GM_IN = 0, GM_MERGE = 1, GM_OUT = 2, GM_MLP1 = 3, GM_MLP2 = 4 };
struct UnitInfo { const char* A; const char* B; int K, wt, mt, step; };

__device__ __forceinline__ bool get_unit(unsigned char* ws, int mode, int n_mt, int n_wt, int nsteps, int ui, UnitInfo& u) {
    const int it = ui / nsteps, step = ui - it * nsteps;
    int mt, wt;
    if (!tile_next(it, gridDim.x, blockIdx.x, n_mt, n_wt, mt, wt)) return false;
    const size_t tok0 = (size_t)mt * 256;
    const bf16_t* Aw; const bf16_t* Bact; int K = 1024;
    if (mode == GM_IN) { Aw = (const bf16_t*)(ws + OFF_W) + (size_t)wt * 256 * 1024; Bact = (const bf16_t*)(ws + OFF_H) + tok0 * 1024; }
    else if (mode == GM_OUT) { Aw = (const bf16_t*)(ws + OFF_W + W_O) + (size_t)wt * 256 * 1024; Bact = (const bf16_t*)(ws + OFF_QKV) + tok0 * 1024; }
    else if (mode == GM_MLP1) { Aw = (const bf16_t*)(ws + OFF_W + W_1) + (size_t)wt * 256 * 1024; Bact = (const bf16_t*)(ws + OFF_H) + tok0 * 1024; }
    else if (mode == GM_MLP2) { K = 4096; Aw = (const bf16_t*)(ws + OFF_W + W_2) + (size_t)wt * 256 * 4096; Bact = (const bf16_t*)(ws + OFF_Z) + tok0 * 4096; }
    else {
        const int k = step >> 1;
        if ((step & 1) == 0) { Aw = (const bf16_t*)(ws + OFF_W + W_G) + ((size_t)k * 1024 + (size_t)wt * 256) * 1024; Bact = (const bf16_t*)(ws + OFF_XBC) + tok0 * 1024; }
        else if (k == 0) { Aw = (const bf16_t*)(ws + OFF_W + W_SO) + (size_t)wt * 256 * 1024; Bact = (const bf16_t*)(ws + OFF_Z) + tok0 * 1024; }
        else if (k == 1) { K = 512; Aw = (const bf16_t*)(ws + OFF_W + W_RO) + (size_t)wt * 256 * 512; Bact = (const bf16_t*)(ws + OFF_G) + tok0 * 512; }
        else { K = 512; Aw = (const bf16_t*)(ws + OFF_W + W_WO) + (size_t)wt * 256 * 512; Bact = (const bf16_t*)(ws + OFF_PRW) + tok0 * 512; }
    }
    u.A = (const char*)Bact; u.B = (const char*)Aw; u.K = K; u.wt = wt; u.mt = mt; u.step = step;
    return true;
}

__device__ __forceinline__ void gemm_epilogue(unsigned char* ws, int mode, const UnitInfo& u, const f32x4 (&acc)[2][2][4][2], int wr, int wc, int fr, int fq, int tidx) {
    const size_t tok0 = (size_t)u.mt * 256; const int wt = u.wt, step = u.step;
    if (mode == GM_MERGE) {
        u32x4* sp = (u32x4*)(ws + OFF_RW + MSCR_S) + ((size_t)blockIdx.x * 8 * 512 + tidx) * 2;
        f32x4* mp = (f32x4*)(ws + OFF_RW + MSCR_M) + ((size_t)blockIdx.x * 8 * 512 + tidx) * 4;
        bf16_t* MG = (bf16_t*)(ws + OFF_QKV);
#pragma unroll
        for (int ai = 0; ai < 2; ++ai)
#pragma unroll
            for (int bj = 0; bj < 2; ++bj)
#pragma unroll
                for (int mh = 0; mh < 2; ++mh) {
                    if ((step & 1) == 0) {
                        unsigned o[8];
#pragma unroll
                        for (int k = 0; k < 4; ++k) {
                            const f32x4 v = acc[ai][bj][mh * 2 + (k >> 1)][k & 1];
                            o[2 * k] = pk2(sigmoidf_(v.x), sigmoidf_(v.y)); o[2 * k + 1] = pk2(sigmoidf_(v.z), sigmoidf_(v.w));
                        }
                        sp[0] = (u32x4){o[0], o[1], o[2], o[3]}; sp[1] = (u32x4){o[4], o[5], o[6], o[7]};
                    } else {
                        const u32x4 sa_ = sp[0], sb_ = sp[1];
                        const unsigned s8[8] = {sa_.x, sa_.y, sa_.z, sa_.w, sb_.x, sb_.y, sb_.z, sb_.w};
                        f32x4 m4[4];
                        if (step > 1) {
#pragma unroll
                            for (int k = 0; k < 4; ++k) m4[k] = mp[k];
                        }
#pragma unroll
                        for (int k = 0; k < 4; ++k) {
                            const int m = mh * 2 + (k >> 1), n = k & 1;
                            const f32x4 v = acc[ai][bj][m][n];
                            f32x4 mm = (f32x4){bflo(s8[2 * k]) * v.x, bfhi(s8[2 * k]) * v.y, bflo(s8[2 * k + 1]) * v.z, bfhi(s8[2 * k + 1]) * v.w};
                            if (step > 1) mm += m4[k];
                            if (step < 5) mp[k] = mm;
                            else {
                                const size_t tok = tok0 + ai * 128 + wr * 64 + m * 16 + fr;
                                const int feat = wt * 256 + bj * 128 + wc * 32 + fq * 8 + n * 4;
                                u32x2 o; o.x = pk2(mm.x, mm.y); o.y = pk2(mm.z, mm.w);
                                *(u32x2*)(MG + tok * 1024 + feat) = o;
                            }
                        }
                    }
                    sp += 512 * 2; mp += 512 * 4;
                    asm volatile("" : "+v"(sp), "+v"(mp) :: "memory");
                }
    } else if (mode == GM_IN && wt == 23) {
        float* DT = (float*)(ws + OFF_DT);
        if (wc == 0) {
#pragma unroll
            for (int ai = 0; ai < 2; ++ai)
#pragma unroll
                for (int m = 0; m < 4; ++m)
#pragma unroll
                    for (int n = 0; n < 2; ++n) {
                        const size_t tok = tok0 + ai * 128 + wr * 64 + m * 16 + fr;
                        *(f32x4*)(DT + tok * 32 + fq * 8 + n * 4) = acc[ai][0][m][n];
                    }
        }
    } else {
        bf16_t* base; int ld, col0;
        if (mode == GM_IN) {
            if (wt < 4) { base = (bf16_t*)(ws + OFF_Z); ld = 1024; col0 = wt * 256; }
            else if (wt < 10) { base = (bf16_t*)(ws + OFF_XBC); ld = 1536; col0 = (wt - 4) * 256; }
            else if (wt < 14) { base = (bf16_t*)(ws + OFF_QKV); ld = 1024; col0 = (wt - 10) * 256; }
            else if (wt < 16) { base = (bf16_t*)(ws + OFF_G); ld = 512; col0 = (wt - 14) * 256; }
            else { base = (bf16_t*)(ws + OFF_RW); ld = 1792; col0 = (wt - 16) * 256; }
        } else if (mode == GM_MLP1) { base = (bf16_t*)(ws + OFF_Z); ld = 4096; col0 = wt * 256; }
        else { base = (bf16_t*)(ws + OFF_H); ld = 1024; col0 = wt * 256; }
        const bool relu2 = (mode == GM_MLP1);
#pragma unroll
        for (int ai = 0; ai < 2; ++ai)
#pragma unroll
            for (int m = 0; m < 4; ++m) {
                const size_t tok = tok0 + ai * 128 + wr * 64 + m * 16 + fr;
                bf16_t* rowp = base + tok * ld + col0 + wc * 32 + fq * 8;
#pragma unroll
                for (int bj = 0; bj < 2; ++bj) {
                    f32x4 v = acc[ai][bj][m][0], w = acc[ai][bj][m][1];
                    if (relu2) { v.x = v.x > 0.f ? v.x * v.x : 0.f; v.y = v.y > 0.f ? v.y * v.y : 0.f; v.z = v.z > 0.f ? v.z * v.z : 0.f; v.w = v.w > 0.f ? v.w * v.w : 0.f;
                                 w.x = w.x > 0.f ? w.x * w.x : 0.f; w.y = w.y > 0.f ? w.y * w.y : 0.f; w.z = w.z > 0.f ? w.z * w.z : 0.f; w.w = w.w > 0.f ? w.w * w.w : 0.f; }
                    u32x4 o; o.x = pk2(v.x, v.y); o.y = pk2(v.z, v.w); o.z = pk2(w.x, w.y); o.w = pk2(w.z, w.w);
                    *(u32x4*)(rowp + bj * 128) = o;
                }
            }
    }
}

__device__ __forceinline__ void gemm_phase(CParams& p_in, const int mode, const int n_mt, LAS unsigned char* lds) {
    CParams* pq_ = &p_in; asm volatile("" : "+s"(pq_)); CParams& p = *pq_;
    const int tid = opaque_tid(), wid = __builtin_amdgcn_readfirstlane(tid >> 6), lane = tid & 63, wr = wid >> 2, wc = wid & 3, fr = lane & 15, fq = lane >> 4;
    unsigned char* ws = p.ws;
    int n_wt, nsteps = 1;
    if (mode == GM_IN) n_wt = 24; else if (mode == GM_MLP1) n_wt = 16; else n_wt = 4;
    if (mode == GM_MERGE) nsteps = 6;
    unsigned vR[2], vC[2];
#pragma unroll
    for (int i = 0; i < 2; ++i) { int Rr, Cc; stage_rc(tid * 16 + i * 8192, Rr, Cc); vR[i] = (unsigned)Rr * 2u; vC[i] = (unsigned)Cc * 2u; }
    const size_t kstep = (size_t)(BK * 2);
    const unsigned ldsw = (unsigned)wid * 1024u;
    const int aoff = lds_byte(wr * 64 + fr, fq * 8), boff = lds_byte(wc * 32 + fr, fq * 8);
#define PG8_SA(b, h) (((b) * 2 + (h)) * HTB)
#define PG8_SB(b, h) ((4 + (b) * 2 + (h)) * HTB)
#define PG8_STAGE(bufoff, gbase, v0, v1) do { \
        __builtin_amdgcn_global_load_lds((const unsigned*)((const char*)(gbase) + (v0)), (LAS unsigned*)(lds + (bufoff) + ldsw), 16, 0, 0); \
        __builtin_amdgcn_global_load_lds((const unsigned*)((const char*)(gbase) + (v1)), (LAS unsigned*)(lds + (bufoff) + ldsw + 8192), 16, 0, 0); } while (0)
#define PG8_LDA(dst, b, h) do { _Pragma("unroll") for (int m = 0; m < 4; ++m) _Pragma("unroll") for (int k = 0; k < 2; ++k) dst[m][k] = *(const LAS bf16x8*)(lds + PG8_SA(b, h) + aoff + m * 2048 + k * 1024); } while (0)
#define PG8_LDB(dst, b, h) do { _Pragma("unroll") for (int n = 0; n < 2; ++n) _Pragma("unroll") for (int k = 0; k < 2; ++k) dst[n][k] = *(const LAS bf16x8*)(lds + PG8_SB(b, h) + boff + n * 2048 + k * 1024); } while (0)
#define PG8_MMA(ai, bj, At, Bt) do { __builtin_amdgcn_s_setprio(1); _Pragma("unroll") for (int m = 0; m < 4; ++m) _Pragma("unroll") for (int n = 0; n < 2; ++n) _Pragma("unroll") for (int k = 0; k < 2; ++k) \
        acc[ai][bj][m][n] = __builtin_amdgcn_mfma_f32_16x16x32_bf16(Bt[n][k], At[m][k], acc[ai][bj][m][n], 0, 0, 0); __builtin_amdgcn_s_setprio(0); } while (0)
#define PG8_WAIT_V(n) asm volatile("s_waitcnt vmcnt(" #n ")" ::: "memory")
#define PG8_WAIT_L(n) asm volatile("s_waitcnt lgkmcnt(" #n ")" ::: "memory")
#define PG8_BAR __builtin_amdgcn_s_barrier()
#define PG8_SCHED __builtin_amdgcn_sched_barrier(0)
    UnitInfo cur, nxt; int ui = 0;
    if (!get_unit(ws, mode, n_mt, n_wt, nsteps, 0, cur)) return;
    f32x4 acc[2][2][4][2];
#pragma unroll
    for (int a = 0; a < 2; ++a)
#pragma unroll
        for (int b = 0; b < 2; ++b)
#pragma unroll
            for (int m = 0; m < 4; ++m)
#pragma unroll
                for (int n = 0; n < 2; ++n) acc[a][b][m][n] = (f32x4){0.f, 0.f, 0.f, 0.f};
    bf16x8 At[4][2], B0[2][2], B1[2][2];
    const char* cA = cur.A; const char* cB = cur.B;
    unsigned vc0 = vR[0] * (unsigned)cur.K + vC[0], vc1 = vR[1] * (unsigned)cur.K + vC[1];
    size_t hstep = (size_t)HALF * cur.K * 2;
    PG8_STAGE(PG8_SB(0, 0), cB, vc0, vc1); PG8_STAGE(PG8_SA(0, 0), cA, vc0, vc1); PG8_STAGE(PG8_SB(0, 1), cB + hstep, vc0, vc1); PG8_STAGE(PG8_SA(0, 1), cA + hstep, vc0, vc1);
    if (wr == 1) PG8_BAR;
    PG8_WAIT_V(4); PG8_BAR;
    PG8_STAGE(PG8_SB(1, 0), cB + kstep, vc0, vc1); PG8_STAGE(PG8_SA(1, 0), cA + kstep, vc0, vc1); PG8_STAGE(PG8_SB(1, 1), cB + hstep + kstep, vc0, vc1);
    PG8_WAIT_V(6); PG8_BAR;
    for (;;) {
        const bool has_next = get_unit(ws, mode, n_mt, n_wt, nsteps, ui + 1, nxt);
        const char* nA = has_next ? nxt.A : cA; const char* nB = has_next ? nxt.B : cB;
        const int Kn = has_next ? nxt.K : cur.K;
        const unsigned vn0 = vR[0] * (unsigned)Kn + vC[0], vn1 = vR[1] * (unsigned)Kn + vC[1];
        const size_t hstepn = (size_t)HALF * Kn * 2;
        const int nt = cur.K / BK;
        for (int t = 0; t < nt; t += 2) {
            const bool last = (t == nt - 2);
            const char* a1 = cA + (size_t)(t + 1) * kstep;
            const char* a2 = last ? nA : cA + (size_t)(t + 2) * kstep; const char* b2 = last ? nB : cB + (size_t)(t + 2) * kstep;
            const char* a3 = a2 + kstep; const char* b3 = b2 + kstep;
            const unsigned w0 = last ? vn0 : vc0, w1 = last ? vn1 : vc1;
            const size_t hs2 = last ? hstepn : hstep;
            PG8_LDB(B0, 0, 0); PG8_SCHED; PG8_LDA(At, 0, 0); PG8_STAGE(PG8_SA(1, 1), a1 + hstep, vc0, vc1);
            PG8_WAIT_L(8); PG8_BAR; PG8_WAIT_L(0); PG8_MMA(0, 0, At, B0); PG8_BAR; PG8_SCHED;
            PG8_LDB(B1, 0, 1); PG8_STAGE(PG8_SB(0, 0), b2, w0, w1);
            PG8_BAR; PG8_WAIT_L(0); PG8_MMA(0, 1, At, B1); PG8_BAR;
            PG8_LDA(At, 0, 1); PG8_STAGE(PG8_SA(0, 0), a2, w0, w1);
            PG8_BAR; PG8_WAIT_L(0); PG8_MMA(1, 0, At, B0); PG8_BAR; PG8_SCHED;
            PG8_STAGE(PG8_SB(0, 1), b2 + hs2, w0, w1);
            PG8_WAIT_V(6); PG8_BAR; PG8_MMA(1, 1, At, B1); PG8_BAR;
            PG8_LDB(B0, 1, 0); PG8_SCHED; PG8_LDA(At, 1, 0); PG8_STAGE(PG8_SA(0, 1), a2 + hs2, w0, w1);
            PG8_WAIT_L(8); PG8_BAR; PG8_WAIT_L(0); PG8_MMA(0, 0, At, B0); PG8_BAR; PG8_SCHED;
            PG8_LDB(B1, 1, 1); PG8_STAGE(PG8_SB(1, 0), b3, w0, w1);
            PG8_BAR; PG8_WAIT_L(0); PG8_MMA(0, 1, At, B1); PG8_BAR;
            PG8_LDA(At, 1, 1); PG8_STAGE(PG8_SA(1, 0), a3, w0, w1);
            PG8_BAR; PG8_WAIT_L(0); PG8_MMA(1, 0, At, B0); PG8_BAR; PG8_SCHED;
            PG8_STAGE(PG8_SB(1, 1), b3 + hs2, w0, w1);
            PG8_WAIT_V(6); PG8_BAR; PG8_MMA(1, 1, At, B1); PG8_BAR;
        }
        gemm_epilogue(ws, mode, cur, acc, wr, wc, fr, fq, tid);
        if (!has_next) break;
#pragma unroll
        for (int a = 0; a < 2; ++a)
#pragma unroll
            for (int b = 0; b < 2; ++b)
#pragma unroll
                for (int m = 0; m < 4; ++m)
#pragma unroll
                    for (int n = 0; n < 2; ++n) acc[a][b][m][n] = (f32x4){0.f, 0.f, 0.f, 0.f};
        cur = nxt; cA = nA; cB = nB; vc0 = vn0; vc1 = vn1; hstep = hstepn; ++ui;
    }
    PG8_WAIT_V(0);
    if (wr == 0) PG8_BAR;
    PG8_BAR;
}

__device__ __forceinline__ void phase_mod(CParams& p_in, unsigned char* smem) {
    CParams* pq_ = &p_in; asm volatile("" : "+s"(pq_)); CParams& p = *pq_;
    const int tidx = opaque_tid();
    float* sc = (float*)smem;
    float* red = sc + 5 * 1024;
    for (int i = tidx; i < 5 * 1024; i += 512) { int r = i >> 10, k = i & 1023; float v = r < 4 ? p.in[1][r * 1024 + k] : p.in[3][k]; sc[i] = siluf_(v); }
    __syncthreads();
    float* MOD = (float*)(p.ws + OFF_MOD);
    const int col = tidx & 63, kp = tidx >> 6;
    for (int item = blockIdx.x; item < 4 * 96; item += gridDim.x) {
        const int l = item / 96, n0 = (item % 96) * 64;
        const float* W = p.in[5] + (size_t)l * 1024 * 6144 + n0 + col;
        float a0 = 0.f, a1 = 0.f, a2 = 0.f, a3 = 0.f, a4 = 0.f;
        for (int k0 = kp * 128; k0 < kp * 128 + 128; k0 += 16) {
            float w[16];
#pragma unroll
            for (int j = 0; j < 16; ++j) w[j] = W[(size_t)(k0 + j) * 6144];
#pragma unroll
            for (int j = 0; j < 16; ++j) { const int k = k0 + j; a0 += sc[k] * w[j]; a1 += sc[1024 + k] * w[j]; a2 += sc[2048 + k] * w[j]; a3 += sc[3072 + k] * w[j]; a4 += sc[4096 + k] * w[j]; }
        }
        red[(kp * 5 + 0) * 64 + col] = a0; red[(kp * 5 + 1) * 64 + col] = a1; red[(kp * 5 + 2) * 64 + col] = a2;
        red[(kp * 5 + 3) * 64 + col] = a3; red[(kp * 5 + 4) * 64 + col] = a4;
        __syncthreads();
        if (tidx < 320) {
            const int r = tidx >> 6; float s = 0.f;
            for (int q = 0; q < 8; ++q) s += red[(q * 5 + r) * 64 + col];
            MOD[(size_t)(l * 5 + r) * 6144 + n0 + col] = s + p.in[6][l * 6144 + n0 + col];
        }
        __syncthreads();
    }
}

__device__ __forceinline__ void cvt_job(const float* W, int ldw, int col0, int ncols, int K, bf16_t* WT, int row0, unsigned char* smem, int cb, int cn) {
    const int tidx = opaque_tid();
    const int wave = tidx >> 6, lane = tidx & 63;
    float* scr = (float*)smem + wave * (64 * 33);
    const int nblk = ncols / 32, nitems = (K / 64) * nblk;
    for (int base = cb * 8; base < nitems; base += cn * 8) {
        const int it = base + wave; const bool valid = it < nitems;
        const int kb = valid ? it / nblk : 0, nb = valid ? it % nblk : 0, k0 = kb * 64, n0 = nb * 32;
        if (valid) {
#pragma unroll 8
            for (int i = 0; i < 32; ++i) { const int kk = 2 * i + (lane >> 5); scr[kk * 33 + (lane & 31)] = W[(size_t)(k0 + kk) * ldw + col0 + n0 + (lane & 31)]; }
        }
        __syncthreads();
        if (valid) {
            const int c = lane & 7;
#pragma unroll
            for (int j = 0; j < 4; ++j) {
                const int n = (lane >> 3) + 8 * j; const float* s = scr + (8 * c) * 33 + n;
                u32x4 o; o.x = pk2(s[0], s[33]); o.y = pk2(s[66], s[99]); o.z = pk2(s[132], s[165]); o.w = pk2(s[198], s[231]);
                const int rho = ((n >> 2) & 1) * 16 + (n >> 3) * 4 + (n & 3);
                *(u32x4*)(WT + (size_t)(row0 + n0 + rho) * K + k0 + 8 * c) = o;
            }
        }
        __syncthreads();
    }
}
__device__ __forceinline__ void cvt_win(CParams& p_in, int l_in, unsigned char* smem, int cb, int cn) {
    CParams* pq_ = &p_in; asm volatile("" : "+s"(pq_)); CParams& p = *pq_;
    int l = l_in; asm volatile("" : "+s"(l));
    const float* W = p.in[7] + (size_t)l * 1024 * 8992; bf16_t* WB = (bf16_t*)(p.ws + OFF_W);
    cvt_job(W, 8992, 3072, 2560, 1024, WB, 0, smem, cb, cn);
    cvt_job(W, 8992, 5664, 3328, 1024, WB, 2560, smem, cb, cn);
    cvt_job(W, 8992, 5632, 256, 1024, WB, 5888, smem, cb, cn);
}
__device__ __forceinline__ void cvt_mix(CParams& p_in, int l_in, unsigned char* smem, int cb, int cn) {
    CParams* pq_ = &p_in; asm volatile("" : "+s"(pq_)); CParams& p = *pq_;
    int l = l_in; asm volatile("" : "+s"(l));
    cvt_job(p.in[7] + (size_t)l * 1024 * 8992, 8992, 0, 3072, 1024, (bf16_t*)(p.ws + OFF_W + W_G), 0, smem, cb, cn);
    cvt_job(p.in[26] + (size_t)l * 1024 * 1024, 1024, 0, 1024, 1024, (bf16_t*)(p.ws + OFF_W + W_SO), 0, smem, cb, cn);
    cvt_job(p.in[27] + (size_t)l * 512 * 1024, 1024, 0, 1024, 512, (bf16_t*)(p.ws + OFF_W + W_RO), 0, smem, cb, cn);
    cvt_job(p.in[28] + (size_t)l * 512 * 1024, 1024, 0, 1024, 512, (bf16_t*)(p.ws + OFF_W + W_WO), 0, smem, cb, cn);
    cvt_job(p.in[29] + (size_t)l * 1024 * 1024, 1024, 0, 1024, 1024, (bf16_t*)(p.ws + OFF_W + W_O), 0, smem, cb, cn);
}
__device__ __forceinline__ void cvt_mlp(CParams& p_in, int l_in, unsigned char* smem, int cb, int cn) {
    CParams* pq_ = &p_in; asm volatile("" : "+s"(pq_)); CParams& p = *pq_;
    int l = l_in; asm volatile("" : "+s"(l));
    cvt_job(p.in[30] + (size_t)l * 1024 * 4096, 4096, 0, 4096, 1024, (bf16_t*)(p.ws + OFF_W + W_1), 0, smem, cb, cn);
    cvt_job(p.in[31] + (size_t)l * 4096 * 1024, 1024, 0, 1024, 4096, (bf16_t*)(p.ws + OFF_W + W_2), 0, smem, cb, cn);
}

__device__ __forceinline__ void row_pass(const float* xrow, const bf16_t* yrow, const float* gate, const float* nwA, float* xout,
                                         bool do_h, const float* nwB, const float* sh, const float* sc, bf16_t* hrow, int lane) {
    f32x4 x[4];
#pragma unroll
    for (int j = 0; j < 4; ++j) x[j] = *(const f32x4*)(xrow + j * 256 + lane * 4);
    u32x2 yraw[4]; f32x4 gw[4];
    if (yrow) {
#pragma unroll
        for (int j = 0; j < 4; ++j) yraw[j] = *(const u32x2*)(yrow + j * 256 + lane * 4);
#pragma unroll
        for (int j = 0; j < 4; ++j) gw[j] = *(const f32x4*)(gate + j * 256 + lane * 4) * *(const f32x4*)(nwA + j * 256 + lane * 4);
    }
    f32x4 hm[4], hs[4];
    if (do_h) {
#pragma unroll
        for (int j = 0; j < 4; ++j) {
            hm[j] = *(const f32x4*)(nwB + j * 256 + lane * 4) * (*(const f32x4*)(sc + j * 256 + lane * 4) + 1.f);
            hs[j] = *(const f32x4*)(sh + j * 256 + lane * 4);
        }
    }
    if (yrow) {
        f32x4 y[4]; float ss = 0.f;
#pragma unroll
        for (int j = 0; j < 4; ++j) {
            y[j] = (f32x4){bflo(yraw[j].x), bfhi(yraw[j].x), bflo(yraw[j].y), bfhi(yraw[j].y)};
            ss += y[j].x * y[j].x + y[j].y * y[j].y + y[j].z * y[j].z + y[j].w * y[j].w;
        }
        ss = wave_sum(ss);
        const float rs = rsqrtf(ss * (1.f / 1024.f) + 1e-6f);
#pragma unroll
        for (int j = 0; j < 4; ++j) x[j] += gw[j] * (y[j] * rs);
    }
    if (xout) {
#pragma unroll
        for (int j = 0; j < 4; ++j) *(f32x4*)(xout + j * 256 + lane * 4) = x[j];
    }
    if (do_h) {
        float ss = 0.f;
#pragma unroll
        for (int j = 0; j < 4; ++j) ss += x[j].x * x[j].x + x[j].y * x[j].y + x[j].z * x[j].z + x[j].w * x[j].w;
        ss = wave_sum(ss);
        const float rs = rsqrtf(ss * (1.f / 1024.f) + 1e-6f);
#pragma unroll
        for (int j = 0; j < 4; ++j) {
            const f32x4 h = (x[j] * rs) * hm[j] + hs[j];
            u32x2 o; o.x = pk2(h.x, h.y); o.y = pk2(h.z, h.w);
            *(u32x2*)(hrow + j * 256 + lane * 4) = o;
        }
    }
}

__device__ __forceinline__ void token_phase(CParams& p_in, int l_in, int kind, int nrows) {
    CParams* pq_ = &p_in; asm volatile("" : "+s"(pq_)); CParams& p = *pq_;
    int l = l_in; asm volatile("" : "+s"(l));
    const int tidx = opaque_tid();
    const int lane = tidx & 63, gw = blockIdx.x * 8 + (tidx >> 6), ngw = gridDim.x * 8;
    const float* MOD = (const float*)(p.ws + OFF_MOD);
    const float* NW = p.in[4];
    bf16_t* H = (bf16_t*)(p.ws + OFF_H);
    float* CTXS = (float*)(p.ws + OFF_CTXS);
    for (int row = gw; row < nrows; row += ngw) {
        const bool lat = row < RL; const int mi = lat ? (row >> 13) : 4;
        const float* xin; float* xout = nullptr;
        const bool from_input = (l == 0 && kind <= 1);
        if (lat) xin = from_input ? p.in[0] + (size_t)row * 1024 : p.out + (size_t)row * 1024;
        else xin = from_input ? p.in[2] + (size_t)(row - RL) * 1024 : CTXS + (size_t)(row - RL) * 1024;
        if (kind > 0) xout = lat ? p.out + (size_t)row * 1024 : CTXS + (size_t)(row - RL) * 1024;
        const float* modl = MOD + (size_t)(l * 5 + mi) * 6144;
        bf16_t* hrow = H + (size_t)row * 1024;
        if (kind == 0) row_pass(xin, nullptr, nullptr, nullptr, nullptr, true, NW + (l * 4 + 0) * 1024, modl, modl + 1024, hrow, lane);
        else if (kind == 1) row_pass(xin, hrow, modl + 2048, NW + (l * 4 + 1) * 1024, xout, true, NW + (l * 4 + 2) * 1024, modl + 3072, modl + 4096, hrow, lane);
        else {
            const bool nxt = l < 3; const float* modn = MOD + (size_t)((l + 1) * 5 + mi) * 6144;
            row_pass(xin, hrow, modl + 5120, NW + (l * 4 + 3) * 1024, xout, nxt, NW + ((l + 1) * 4 + 0) * 1024, modn, modn + 1024, hrow, lane);
        }
    }
}

template <int NQ, int PB>
__device__ __forceinline__ void lin_steps(float (&S)[16], const float* qL, const float* kL, const float* vL, const float* dtL, const float* decL, float* yL, int dir, int nq, int pl) {
    constexpr int N = NQ * 16;
    for (int j = 0; j < 32; ++j) {
        const int tt = dir ? 31 - j : j;
        const float xdt = vL[tt * PB + pl] * dtL[tt];
        const float dec = decL[tt];
        const f32x4* kp = (const f32x4*)(kL + tt * N + nq * 16);
        const f32x4* qp = (const f32x4*)(qL + tt * N + nq * 16);
        float part = 0.f;
#pragma unroll
        for (int q4 = 0; q4 < 4; ++q4) {
            const f32x4 kv = kp[q4], qv = qp[q4];
            S[q4 * 4 + 0] = dec * S[q4 * 4 + 0] + kv.x * xdt; part += qv.x * S[q4 * 4 + 0];
            S[q4 * 4 + 1] = dec * S[q4 * 4 + 1] + kv.y * xdt; part += qv.y * S[q4 * 4 + 1];
            S[q4 * 4 + 2] = dec * S[q4 * 4 + 2] + kv.z * xdt; part += qv.z * S[q4 * 4 + 2];
            S[q4 * 4 + 3] = dec * S[q4 * 4 + 3] + kv.w * xdt; part += qv.w * S[q4 * 4 + 3];
        }
        part = (NQ == 8) ? red8(part) : red4(part);
        if (nq == 0) yL[tt * PB + pl] = part;
    }
}

__device__ __forceinline__ void scan_tile(int b, int dir, int tau, int& low, int& s0, int& s1, bool& isctx, bool& first) {
    int ti, nt;
    isctx = tau < 8;
    if (isctx) { ti = dir ? 7 - tau : tau; s0 = RL + b * 256; s1 = s0 + 256; nt = 8; }
    else { ti = dir ? 255 - (tau - 8) : tau - 8; s0 = b * 8192; s1 = s0 + 8192; nt = 256; }
    low = s0 + ti * 32;
    first = (dir == 0) == (ti < nt / 2);
}

template <int NK> struct CsL {
    static constexpr int SN = NK + 8, SS = 40;
    static constexpr int O_CN = 0, O_BN = O_CN + 32 * SN * 2, O_BWT = O_BN + 32 * SN * 2, O_XT = O_BWT + NK * SS * 2, O_PM = O_XT + 64 * SS * 2,
                         O_ST = O_PM + 32 * SS * 2, O_F = O_ST + 64 * SN * 2, O_Y = O_F + 544, O_RAW = (NK == 128) ? O_Y : O_Y + 8192;
};
template <int NK>
__device__ __forceinline__ void cs_core(unsigned char* base, f32x4 (&accS)[NK / 16], int dir, int w, int fr, int fq) {
    typedef CsL<NK> L;
    constexpr int SN = L::SN, SS = L::SS, KC = NK / 32, NT = NK / 16;
    bf16_t* Cn = (bf16_t*)(base + L::O_CN); bf16_t* Bn = (bf16_t*)(base + L::O_BN); bf16_t* BwT = (bf16_t*)(base + L::O_BWT);
    bf16_t* XT = (bf16_t*)(base + L::O_XT); bf16_t* Pm = (bf16_t*)(base + L::O_PM); bf16_t* ST = (bf16_t*)(base + L::O_ST);
    float* cumL = (float*)(base + L::O_F); float* dtL = cumL + 32; float* eL = dtL + 32; float* totL = eL + 64;
    float* yL = (float*)(base + ((NK == 128) ? L::O_BN : L::O_Y));
    f32x4 acc4[2];
    {
        const int mt = w >> 1, nt = w & 1;
        f32x4 g = (f32x4){0.f, 0.f, 0.f, 0.f};
#pragma unroll
        for (int kc = 0; kc < KC; ++kc) {
            const bf16x8 A = *(const bf16x8*)(Cn + (mt * 16 + fr) * SN + kc * 32 + fq * 8);
            const bf16x8 Bf = *(const bf16x8*)(Bn + (nt * 16 + fr) * SN + kc * 32 + fq * 8);
            g = __builtin_amdgcn_mfma_f32_16x16x32_bf16(A, Bf, g, 0, 0, 0);
        }
        const int s = nt * 16 + fr; const float cs = cumL[s], ds = dtL[s];
#pragma unroll
        for (int r = 0; r < 4; ++r) {
            const int t = mt * 16 + fq * 4 + r;
            const bool ok = dir ? (s >= t) : (s <= t);
            const float val = ok ? g[r] * __expf(cumL[t] - cs) * ds : 0.f;
            Pm[t * SS + s] = f2bf(val);
        }
#pragma unroll
        for (int mt2 = 0; mt2 < 2; ++mt2) {
            acc4[mt2] = (f32x4){0.f, 0.f, 0.f, 0.f};
#pragma unroll
            for (int kc = 0; kc < KC; ++kc) {
                const bf16x8 A = *(const bf16x8*)(Cn + (mt2 * 16 + fr) * SN + kc * 32 + fq * 8);
                const bf16x8 Bf = *(const bf16x8*)(ST + (w * 16 + fr) * SN + kc * 32 + fq * 8);
                acc4[mt2] = __builtin_amdgcn_mfma_f32_16x16x32_bf16(A, Bf, acc4[mt2], 0, 0, 0);
            }
        }
    }
    __syncthreads();
    {
        const bf16x8 Xf = *(const bf16x8*)(XT + (w * 16 + fr) * SS + fq * 8);
#pragma unroll
        for (int mt2 = 0; mt2 < 2; ++mt2) {
            const bf16x8 A = *(const bf16x8*)(Pm + (mt2 * 16 + fr) * SS + fq * 8);
            f32x4 a3 = (f32x4){0.f, 0.f, 0.f, 0.f};
            a3 = __builtin_amdgcn_mfma_f32_16x16x32_bf16(A, Xf, a3, 0, 0, 0);
#pragma unroll
            for (int r = 0; r < 4; ++r) { const int t = mt2 * 16 + fq * 4 + r; yL[t * 64 + w * 16 + fr] = a3[r] + eL[t] * acc4[mt2][r]; }
        }
        const float dtot = __expf(totL[0]);
#pragma unroll
        for (int n8 = 0; n8 < NT; ++n8) {
            const bf16x8 Bf = *(const bf16x8*)(BwT + (n8 * 16 + fr) * SS + fq * 8);
            accS[n8] = accS[n8] * dtot;
            accS[n8] = __builtin_amdgcn_mfma_f32_16x16x32_bf16(Xf, Bf, accS[n8], 0, 0, 0);
#pragma unroll
            for (int r = 0; r < 4; ++r) ST[(w * 16 + fq * 4 + r) * SN + n8 * 16 + fr] = f2bf(accS[n8][r]);
        }
    }
    __syncthreads();
}

template <int NK, bool DX>
__device__ __forceinline__ void cs_writeout(unsigned char* base, bf16_t* pp, u32x4 pv, int tl, float Dh) {
    typedef CsL<NK> L;
    const float* yL = (const float*)(base + ((NK == 128) ? L::O_BN : L::O_Y));
    const bf16_t* XT = (const bf16_t*)(base + L::O_XT);
    const int t = tl >> 3, pg = tl & 7;
    const f32x4 ya = *(const f32x4*)(yL + t * 64 + pg * 8), yb = *(const f32x4*)(yL + t * 64 + pg * 8 + 4);
    float y[8] = {ya.x, ya.y, ya.z, ya.w, yb.x, yb.y, yb.z, yb.w};
    const unsigned pa[4] = {pv.x, pv.y, pv.z, pv.w};
#pragma unroll
    for (int j = 0; j < 4; ++j) { y[2 * j] += bflo(pa[j]); y[2 * j + 1] += bfhi(pa[j]); }
    if (DX) {
#pragma unroll
        for (int j = 0; j < 8; ++j) y[j] += Dh * bf2f(XT[(pg * 8 + j) * L::SS + t]);
    }
    u32x4 o; o.x = pk2(y[0], y[1]); o.y = pk2(y[2], y[3]); o.z = pk2(y[4], y[5]); o.w = pk2(y[6], y[7]);
    *(u32x4*)pp = o;
}

__device__ __forceinline__ void ssd_scan_item(CParams& p_in, int l_in, int item, unsigned char* smem) {
    CParams* pq_ = &p_in; asm volatile("" : "+s"(pq_)); CParams& p = *pq_;
    int l = l_in; asm volatile("" : "+s"(l));
    const int tidx = opaque_tid();
    typedef CsL<128> L;
    constexpr int SN = L::SN, SS = L::SS;
    const int b = item >> 4, h = item & 15, g = h >> 3;
    const int tid = tidx, dir = tid >> 8, tl = tid & 255, lane = tid & 63, w = tl >> 6, fr = lane & 15, fq = lane >> 4;
    unsigned char* base = smem + dir * 76800;
    bf16_t* Cn = (bf16_t*)(base + L::O_CN); bf16_t* Bn = (bf16_t*)(base + L::O_BN); bf16_t* BwT = (bf16_t*)(base + L::O_BWT);
    bf16_t* XT = (bf16_t*)(base + L::O_XT); bf16_t* ST = (bf16_t*)(base + L::O_ST);
    float* cumL = (float*)(base + L::O_F); float* dtL = cumL + 32; float* eL = dtL + 32; float* wL = eL + 32; float* totL = eL + 64;
    bf16_t* rawL = (bf16_t*)(base + L::O_RAW);
    const bf16_t* XBC = (const bf16_t*)(p.ws + OFF_XBC);
    const float* DT = (const float*)(p.ws + OFF_DT);
    bf16_t* P = (bf16_t*)(p.ws + OFF_H);
    const float* cw = p.in[8] + (size_t)l * 5 * 1536; const float* cbias = p.in[9] + (size_t)l * 1536;
    const float dtb = p.in[10][l * 32 + dir * 16 + h];
    const float aneg = -__expf(p.in[11][l * 32 + dir * 16 + h]);
    const float Dh = p.in[12][l * 16 + h];
    const int xc1 = 1024 + g * 128 + (tl & 127) * 2;
    const int xc1c = ((tl & 127) < 64) ? xc1 : 1280 + g * 128 + ((tl & 127) - 64) * 2;
    const f32x2_t cw0 = {cw[xc1c], cw[xc1c + 1]}, cw1 = {cw[1536 + xc1c], cw[1536 + xc1c + 1]}, cw2 = {cw[2 * 1536 + xc1c], cw[2 * 1536 + xc1c + 1]},
                  cw3 = {cw[3 * 1536 + xc1c], cw[3 * 1536 + xc1c + 1]}, cw4 = {cw[4 * 1536 + xc1c], cw[4 * 1536 + xc1c + 1]}, cwb = {cbias[xc1c], cbias[xc1c + 1]};
    const int xc2 = h * 64 + (tl & 63);
    const float c20 = cw[xc2], c21 = cw[1536 + xc2], c22 = cw[2 * 1536 + xc2], c23 = cw[3 * 1536 + xc2], c24 = cw[4 * 1536 + xc2], c2b = cbias[xc2];
    for (int i = tl; i < 64 * SN; i += 256) ST[i] = 0;
    f32x4 accS[8];
#pragma unroll
    for (int i = 0; i < 8; ++i) accS[i] = (f32x4){0.f, 0.f, 0.f, 0.f};
    u32x4 rv[6]; float dtr = 0.f;
    int pf_rr[6], pf_off[6], pf_lds[6];
#pragma unroll
    for (int i = 0; i < 6; ++i) {
        const int e = tl + 256 * i; const int rr = e / 40, ch = e - rr * 40;
        const int xc = ch < 16 ? 1024 + g * 128 + ch * 8 : (ch < 32 ? 1280 + g * 128 + (ch - 16) * 8 : h * 64 + (ch - 32) * 8);
        pf_rr[i] = rr; pf_off[i] = rr * 1536 + xc; pf_lds[i] = (e < 36 * 40) ? rr * 320 + ch * 8 : -1;
    }
#define SSD_PREFETCH(tau_) do { int low_, s0_, s1_; bool ic_, fi_; scan_tile(b, dir, (tau_), low_, s0_, s1_, ic_, fi_); \
        const bf16_t* rb_ = XBC + (size_t)(low_ - 2) * 1536; \
        _Pragma("unroll") for (int i = 0; i < 6; ++i) { \
            const int row = low_ - 2 + pf_rr[i]; \
            rv[i] = (u32x4){0u, 0u, 0u, 0u}; \
            if (pf_lds[i] >= 0 && row >= s0_ && row < s1_) rv[i] = *(const u32x4*)(rb_ + pf_off[i]); } \
        if (tl < 32) dtr = DT[(size_t)(low_ + tl) * 32 + dir * 16 + h]; } while (0)
    SSD_PREFETCH(0);
    for (int tau = 0; tau < 264; ++tau) {
        int low, s0, s1; bool isctx, first;
        scan_tile(b, dir, tau, low, s0, s1, isctx, first);
#pragma unroll
        for (int i = 0; i < 6; ++i) { if (pf_lds[i] >= 0) *(u32x4*)(rawL + pf_lds[i]) = rv[i]; }
        if (tl < 64) {
            const float dt = fast_softplus(dtr + dtb);
            const float la = dt * aneg;
            float c = la;
#pragma unroll
            for (int o = 1; o < 32; o <<= 1) { const float v = __shfl_up(c, o); if (lane >= o) c += v; }
            const float total = __shfl(c, 31);
            const float cd = dir ? (total - c + la) : c;
            if (tl < 32) { cumL[tl] = cd; dtL[tl] = dt; eL[tl] = __expf(cd); wL[tl] = __expf(total - cd) * dt; if (tl == 0) totL[0] = total; }
        }
        bf16_t* pp = P + (size_t)(low + (tl >> 3)) * 1024 + h * 64 + (tl & 7) * 8;
        const bool late = (tau == 4) || (tau == 136);
        u32x4 pv = (u32x4){0u, 0u, 0u, 0u};
        if (!first && !late) pv = *(const u32x4*)pp;
        __syncthreads();
        {
            const bf16_t* __restrict__ rawR = rawL;
            {
                const int cp = tl & 127, th = tl >> 7, c0 = cp * 2, tb = th * 16;
                f32x2_t q0, q1, q2, q3;
                { const unsigned a = *(const unsigned*)(rawR + (tb) * 320 + c0), bq = *(const unsigned*)(rawR + (tb + 1) * 320 + c0), cq = *(const unsigned*)(rawR + (tb + 2) * 320 + c0), dq = *(const unsigned*)(rawR + (tb + 3) * 320 + c0);
                  q0 = (f32x2_t){bflo(a), bfhi(a)}; q1 = (f32x2_t){bflo(bq), bfhi(bq)}; q2 = (f32x2_t){bflo(cq), bfhi(cq)}; q3 = (f32x2_t){bflo(dq), bfhi(dq)}; }
#pragma unroll 8
                for (int j = 0; j < 16; ++j) {
                    const int t = tb + j;
                    const unsigned e = *(const unsigned*)(rawR + (t + 4) * 320 + c0);
                    const f32x2_t q4 = {bflo(e), bfhi(e)};
                    f32x2_t o = __builtin_elementwise_fma(cw4, q4, cwb);
                    o = __builtin_elementwise_fma(cw3, q3, o); o = __builtin_elementwise_fma(cw2, q2, o);
                    o = __builtin_elementwise_fma(cw1, q1, o); o = __builtin_elementwise_fma(cw0, q0, o);
                    o.x = siluf_(o.x); o.y = siluf_(o.y);
                    if (cp < 64) {
                        *(unsigned*)(Bn + t * SN + c0) = pk2(o.x, o.y);
                        const float wt = wL[t];
                        const unsigned bw = pk2(o.x * wt, o.y * wt);
                        BwT[c0 * SS + t] = (bf16_t)(bw & 0xffffu); BwT[(c0 + 1) * SS + t] = (bf16_t)(bw >> 16);
                    } else *(unsigned*)(Cn + t * SN + c0 - 128) = pk2(o.x, o.y);
                    q0 = q1; q1 = q2; q2 = q3; q3 = q4;
                }
            }
            const int xcol = 256 + (tl & 63), tq = tl >> 6;
            float q0 = bf2f(rawL[(tq * 8) * 320 + xcol]), q1 = bf2f(rawL[(tq * 8 + 1) * 320 + xcol]), q2 = bf2f(rawL[(tq * 8 + 2) * 320 + xcol]), q3 = bf2f(rawL[(tq * 8 + 3) * 320 + xcol]);
            unsigned xo[4];
#pragma unroll
            for (int j = 0; j < 8; ++j) {
                const float q4 = bf2f(rawL[(tq * 8 + j + 4) * 320 + xcol]);
                const float o = siluf_(c20 * q0 + c21 * q1 + c22 * q2 + c23 * q3 + c24 * q4 + c2b);
                if (j & 1) xo[j >> 1] |= ((unsigned)f2bf(o)) << 16; else xo[j >> 1] = f2bf(o);
                q0 = q1; q1 = q2; q2 = q3; q3 = q4;
            }
            *(u32x4*)(XT + (tl & 63) * SS + tq * 8) = (u32x4){xo[0], xo[1], xo[2], xo[3]};
        }
        __syncthreads();
        if (!first && late) pv = *(const u32x4*)pp;
        if (tau + 1 < 264) SSD_PREFETCH(tau + 1);
        cs_core<128>(base, accS, dir, w, fr, fq);
        cs_writeout<128, true>(base, pp, pv, tl, first ? 0.f : Dh);
    }
#undef SSD_PREFETCH
}

__device__ __forceinline__ void ret_scan_item(CParams& p_in, int l_in, int item, unsigned char* smem) {
    CParams* pq_ = &p_in; asm volatile("" : "+s"(pq_)); CParams& p = *pq_;
    int l = l_in; asm volatile("" : "+s"(l));
    const int tidx = opaque_tid();
    typedef CsL<64> L;
    constexpr int SN = L::SN, SS = L::SS;
    const int b = item >> 3, hd = (item >> 1) & 3, phalf = item & 1;
    const int tid = tidx, dir = tid >> 8, tl = tid & 255, lane = tid & 63, w = tl >> 6, fr = lane & 15, fq = lane >> 4;
    unsigned char* base = smem + dir * 76800;
    bf16_t* Cn = (bf16_t*)(base + L::O_CN); bf16_t* Bn = (bf16_t*)(base + L::O_BN); bf16_t* BwT = (bf16_t*)(base + L::O_BWT);
    bf16_t* XT = (bf16_t*)(base + L::O_XT); bf16_t* ST = (bf16_t*)(base + L::O_ST);
    float* cumL = (float*)(base + L::O_F); float* dtL = cumL + 32; float* eL = dtL + 32; float* wL = eL + 32; float* totL = eL + 64;
    bf16_t* rawL = (bf16_t*)(base + L::O_RAW);
    const bf16_t* QKV = (const bf16_t*)(p.ws + OFF_QKV);
    bf16_t* P = (bf16_t*)(p.ws + OFF_PRET);
    const float lg = -fast_softplus(-p.in[14][l * 8 + dir * 4 + hd]);
    if (tl < 32) {
        const float cd = dir ? (float)(32 - tl) * lg : (float)(tl + 1) * lg;
        const float total = 32.f * lg;
        cumL[tl] = cd; dtL[tl] = 1.f; eL[tl] = __expf(cd); wL[tl] = __expf(total - cd); if (tl == 0) totL[0] = total;
    }
    for (int i = tl; i < 64 * SN; i += 256) ST[i] = 0;
    f32x4 accS[4];
#pragma unroll
    for (int i = 0; i < 4; ++i) accS[i] = (f32x4){0.f, 0.f, 0.f, 0.f};
    const int pairidx = tl & 63, tq = tl >> 6, which = pairidx >> 5, pi = pairidx & 31;
    const float inv = exp2f(-(float)(pi & 15) * (13.287712379549449f / 16.f));
    u32x4 rv[3];
#define RET_PREFETCH(tau_) do { int low_, s0_, s1_; bool ic_, fi_; scan_tile(b, dir, (tau_), low_, s0_, s1_, ic_, fi_); \
        _Pragma("unroll") for (int i = 0; i < 3; ++i) { \
            const int e = tl + 256 * i; const int rr = e / 24, ch = e - rr * 24; \
            const int col = ch < 8 ? hd * 64 + ch * 8 : (ch < 16 ? 256 + hd * 64 + (ch - 8) * 8 : 512 + hd * 128 + phalf * 64 + (ch - 16) * 8); \
            rv[i] = *(const u32x4*)(QKV + (size_t)(low_ + rr) * 1024 + col); } } while (0)
    RET_PREFETCH(0);
    for (int tau = 0; tau < 264; ++tau) {
        int low, s0, s1; bool isctx, first;
        scan_tile(b, dir, tau, low, s0, s1, isctx, first);
#pragma unroll
        for (int i = 0; i < 3; ++i) { const int e = tl + 256 * i; const int rr = e / 24, ch = e - rr * 24; *(u32x4*)(rawL + rr * 192 + ch * 8) = rv[i]; }
        bf16_t* pp = P + (size_t)(low + (tl >> 3)) * 512 + hd * 128 + phalf * 64 + (tl & 7) * 8;
        const bool late = (tau == 4) || (tau == 136);
        u32x4 pv = (u32x4){0u, 0u, 0u, 0u};
        if (!first && !late) pv = *(const u32x4*)pp;
        __syncthreads();
        {
#pragma unroll
            for (int j = 0; j < 8; ++j) {
                const int t = tq * 8 + j;
                const unsigned raw = *(const unsigned*)(rawL + t * 192 + which * 64 + 2 * pi);
                const float x1 = bflo(raw), x2 = bfhi(raw);
                float c = 1.f, s = 0.f;
                if (!isctx) { const int pos = low + t - s0; const float ppos = (pi < 16) ? (float)(pos >> 6) : (float)(pos & 63); const float ang = ppos * inv; c = __cosf(ang); s = __sinf(ang); }
                const float o1 = x1 * c - x2 * s, o2 = x1 * s + x2 * c;
                if (which == 0) *(unsigned*)(Cn + t * SN + 2 * pi) = pk2(o1, o2);
                else {
                    const float k1 = o1 * 0.125f, k2 = o2 * 0.125f, wt = wL[t];
                    *(unsigned*)(Bn + t * SN + 2 * pi) = pk2(k1, k2);
                    BwT[(2 * pi) * SS + t] = f2bf(k1 * wt); BwT[(2 * pi + 1) * SS + t] = f2bf(k2 * wt);
                }
            }
            unsigned xo[4];
#pragma unroll
            for (int j = 0; j < 8; ++j) { const unsigned v = rawL[(tq * 8 + j) * 192 + 128 + pairidx]; if (j & 1) xo[j >> 1] |= v << 16; else xo[j >> 1] = v; }
            *(u32x4*)(XT + pairidx * SS + tq * 8) = (u32x4){xo[0], xo[1], xo[2], xo[3]};
        }
        __syncthreads();
        if (!first && late) pv = *(const u32x4*)pp;
        if (tau + 1 < 264) RET_PREFETCH(tau + 1);
        cs_core<64>(base, accS, dir, w, fr, fq);
        cs_writeout<64, false>(base, pp, pv, tl, 0.f);
    }
#undef RET_PREFETCH
}

__device__ __forceinline__ void shift_phase(CParams& p_in, int l_in, int part, unsigned char* smem) {
    CParams* pq_ = &p_in; asm volatile("" : "+s"(pq_)); CParams& p = *pq_;
    int l = l_in; asm volatile("" : "+s"(l));
    const int tidx = opaque_tid();
    bf16_t* RW = (bf16_t*)(p.ws + OFF_RW);
    u32x2* halo = (u32x2*)smem;
    const int c0 = tidx * 4;
    if (tidx >= 448) return;
    if (part == 0) {
        for (int k = 0; k < 5; ++k) {
            const int chunk = blockIdx.x + k * gridDim.x; if (chunk >= R / 32) break;
            const int lo = chunk * 32; int s0, s1;
            if (lo < RL) { s0 = lo & ~8191; s1 = s0 + 8192; } else { s0 = RL + ((lo - RL) & ~255); s1 = s0 + 256; }
            u32x2 a = (u32x2){0u, 0u}, b = (u32x2){0u, 0u};
            if (lo - 1 >= s0) a = *(const u32x2*)(RW + (size_t)(lo - 1) * 1792 + c0);
            if (lo + 32 < s1) b = *(const u32x2*)(RW + (size_t)(lo + 32) * 1792 + c0);
            halo[(k * 2 + 0) * 448 + tidx] = a; halo[(k * 2 + 1) * 448 + tidx] = b;
        }
        return;
    }
    const f32x4 mx = *(const f32x4*)(p.in[15] + (size_t)l * 1792 + c0);
    const int kind = (c0 >= 1536 && c0 < 1600) ? 1 : (c0 >= 1664 ? 2 : 0);
    for (int k = 0; k < 5; ++k) {
        const int chunk = blockIdx.x + k * gridDim.x; if (chunk >= R / 32) break;
        bf16_t* base = RW + (size_t)chunk * 32 * 1792 + c0;
        u32x2 rows[34];
        rows[0] = halo[(k * 2 + 0) * 448 + tidx]; rows[33] = halo[(k * 2 + 1) * 448 + tidx];
#pragma unroll
        for (int t = 0; t < 32; ++t) rows[t + 1] = *(const u32x2*)(base + (size_t)t * 1792);
#pragma unroll
        for (int t = 0; t < 32; ++t) {
            const u32x2 a = rows[t], b = rows[t + 1], c = rows[t + 2];
            f32x4 u0 = (f32x4){bflo(a.x), bfhi(a.x), bflo(a.y), bfhi(a.y)}, u1 = (f32x4){bflo(b.x), bfhi(b.x), bflo(b.y), bfhi(b.y)}, u2 = (f32x4){bflo(c.x), bfhi(c.x), bflo(c.y), bfhi(c.y)};
            f32x4 v = u1 + mx * ((u0 + u2) * 0.5f - u1);
            if (kind == 1) { v.x = fast_tanh(v.x); v.y = fast_tanh(v.y); v.z = fast_tanh(v.z); v.w = fast_tanh(v.w); }
            else if (kind == 2) { v.x = sigmoidf_(v.x); v.y = sigmoidf_(v.y); v.z = sigmoidf_(v.z); v.w = sigmoidf_(v.w); }
            u32x2 o; o.x = pk2(v.x, v.y); o.y = pk2(v.z, v.w);
            *(u32x2*)(base + (size_t)t * 1792) = o;
        }
    }
}

__device__ __forceinline__ void rwkv_scan_item(CParams& p_in, int l_in, int item, unsigned char* smem) {
    CParams* pq_ = &p_in; asm volatile("" : "+s"(pq_)); CParams& p = *pq_;
    int l = l_in; asm volatile("" : "+s"(l));
    const int tidx = opaque_tid();
    const int b = item >> 5, h = (item >> 2) & 7, rq = item & 3;
    const int tid = tidx, dir = tid >> 8, tl = tid & 255, lane = tid & 63, wv = tl >> 6;
    const int kq = lane & 15, rloc = wv * 4 + (lane >> 4);
    const int fr = lane & 15, fq = lane >> 4;
    unsigned char* base = smem + dir * 67072;
    float* rL = (float*)base;
    float *kL = rL + 2048, *wL = kL + 2048, *bL = wL + 2048, *nkL = bL + 2048, *vL = nkL + 2048, *yL = vL + 1024;
    float* kdL = (float*)(base + 58880);
    bf16_t* twB = (bf16_t*)(yL + 1024);
    bf16_t* aloB = twB + 2048;
    float* invn = (float*)(aloB + 2048);
    const bf16_t* RW = (const bf16_t*)(p.ws + OFF_RW);
    bf16_t* P = (bf16_t*)(p.ws + OFF_PRW);
    const int cch = h * 64 + wv * 16 + fr;
    bf16x8 Bw[2], Ba[2];
    {
        const float* w2g = p.in[17] + ((size_t)(l * 2 + dir) * 64) * 512 + cch;
        const float* a2g = p.in[19] + ((size_t)l * 64) * 512 + cch;
#pragma unroll
        for (int kc = 0; kc < 2; ++kc)
#pragma unroll
            for (int e = 0; e < 8; ++e) {
                const int j = kc * 32 + fq * 8 + e;
                Bw[kc][e] = (short)f2bf(w2g[(size_t)j * 512]); Ba[kc][e] = (short)f2bf(a2g[(size_t)j * 512]);
            }
    }
    const float w0c = p.in[16][(l * 2 + dir) * 512 + cch], a0c = p.in[18][(l * 2 + dir) * 512 + cch];
    const float kkc = p.in[21][l * 512 + cch], kac = p.in[22][l * 512 + cch];
    const int t2 = tl >> 3, part2 = tl & 7;
    f32x4 kk2a = *(const f32x4*)(p.in[21] + l * 512 + h * 64 + part2 * 8), kk2b = *(const f32x4*)(p.in[21] + l * 512 + h * 64 + part2 * 8 + 4);
    float S[4];
#pragma unroll
    for (int i = 0; i < 4; ++i) S[i] = 0.f;
    u32x4 rv[5];
    int pf_off[5], pf_dst[5], pf_mode[5];
#pragma unroll
    for (int i = 0; i < 5; ++i) {
        const int e = tl + 256 * i; const int rr = e / 34, ch = e - rr * 34;
        const int col = ch < 8 ? h * 64 + ch * 8 : (ch < 16 ? 512 + h * 64 + (ch - 8) * 8 : (ch < 32 ? 1536 + (ch - 16) * 8 : 1024 + h * 64 + rq * 16 + (ch - 32) * 8));
        pf_off[i] = rr * 1792 + col;
        int dst, mode;
        if (ch < 8) { dst = (int)((unsigned char*)(rL + rr * 64 + ch * 8) - base); mode = 0; }
        else if (ch < 16) { dst = (int)((unsigned char*)(kL + rr * 64 + (ch - 8) * 8) - base); mode = 0; }
        else if (ch < 24) { dst = (int)((unsigned char*)(twB + rr * 64 + (ch - 16) * 8) - base); mode = 1; }
        else if (ch < 32) { dst = (int)((unsigned char*)(aloB + rr * 64 + (ch - 24) * 8) - base); mode = 1; }
        else { dst = (int)((unsigned char*)(vL + rr * 16 + (ch - 32) * 8) - base); mode = 0; }
        pf_dst[i] = dst; pf_mode[i] = (e < 32 * 34) ? mode : -1;
    }
#define RW_PREFETCH(tau_) do { int low_, s0_, s1_; bool ic_, fi_; scan_tile(b, dir, (tau_), low_, s0_, s1_, ic_, fi_); \
        const bf16_t* rb_ = RW + (size_t)low_ * 1792; \
        _Pragma("unroll") for (int i = 0; i < 5; ++i) { \
            rv[i] = (u32x4){0u, 0u, 0u, 0u}; \
            if (pf_mode[i] >= 0) rv[i] = *(const u32x4*)(rb_ + pf_off[i]); } } while (0)
    RW_PREFETCH(0);
    for (int tau = 0; tau < 264; ++tau) {
        int low, s0, s1; bool isctx, first;
        scan_tile(b, dir, tau, low, s0, s1, isctx, first);
#pragma unroll
        for (int i = 0; i < 5; ++i) {
            if (pf_mode[i] == 1) *(u32x4*)(base + pf_dst[i]) = rv[i];
            else if (pf_mode[i] == 0) {
                *(f32x4*)(base + pf_dst[i]) = (f32x4){bflo(rv[i].x), bfhi(rv[i].x), bflo(rv[i].y), bfhi(rv[i].y)};
                *(f32x4*)(base + pf_dst[i] + 16) = (f32x4){bflo(rv[i].z), bfhi(rv[i].z), bflo(rv[i].w), bfhi(rv[i].w)};
            }
        }
        bf16_t* pp = P + (size_t)(low + t2) * 512 + h * 64 + rq * 16 + part2 * 2;
        const bool late = (tau == 4) || (tau == 136);
        unsigned pv = 0u;
        if (!first && !late) pv = *(const unsigned*)pp;
        __syncthreads();
        {
            const f32x4 ka = *(const f32x4*)(kL + t2 * 64 + part2 * 8), kb = *(const f32x4*)(kL + t2 * 64 + part2 * 8 + 4);
            const f32x4 pa = ka * kk2a, pb = kb * kk2b;
            float ss = pa.x * pa.x + pa.y * pa.y + pa.z * pa.z + pa.w * pa.w + pb.x * pb.x + pb.y * pb.y + pb.z * pb.z + pb.w * pb.w;
            ss = red8(ss);
            if (part2 == 0) { const float iv = __builtin_amdgcn_rcpf(fmaxf(sqrtf(ss), 1e-12f)); invn[t2] = iv * iv; }
        }
        f32x4 accw[2], acca[2];
#pragma unroll
        for (int mt = 0; mt < 2; ++mt) {
            accw[mt] = (f32x4){0.f, 0.f, 0.f, 0.f}; acca[mt] = (f32x4){0.f, 0.f, 0.f, 0.f};
#pragma unroll
            for (int kc = 0; kc < 2; ++kc) {
                const bf16x8 Aw = *(const bf16x8*)(twB + (mt * 16 + fr) * 64 + kc * 32 + fq * 8);
                const bf16x8 Aa = *(const bf16x8*)(aloB + (mt * 16 + fr) * 64 + kc * 32 + fq * 8);
                accw[mt] = __builtin_amdgcn_mfma_f32_16x16x32_bf16(Aw, Bw[kc], accw[mt], 0, 0, 0);
                acca[mt] = __builtin_amdgcn_mfma_f32_16x16x32_bf16(Aa, Ba[kc], acca[mt], 0, 0, 0);
            }
        }
#pragma unroll
        for (int mt = 0; mt < 2; ++mt)
#pragma unroll
            for (int r = 0; r < 4; ++r) {
                const int t = mt * 16 + fq * 4 + r, c = wv * 16 + fr;
                const float wl = w0c + accw[mt][r];
                const float decay = __expf(-0.6065306597f * sigmoidf_(wl));
                const float a = sigmoidf_(a0c + acca[mt][r]);
                const float kraw = kL[t * 64 + c];
                const float kk = kraw * kkc;
                wL[t * 64 + c] = decay;
                kdL[t * 64 + c] = kraw * (1.f + (a - 1.f) * kac);
                bL[t * 64 + c] = kk * a;
                nkL[t * 64 + c] = -kk;
            }
        __syncthreads();
        if (!first && late) pv = *(const unsigned*)pp;
        if (tau + 1 < 264) RW_PREFETCH(tau + 1);
        {
            const float* __restrict__ nkR = nkL + kq * 4; const float* __restrict__ wR = wL + kq * 4; const float* __restrict__ bR = bL + kq * 4;
            const float* __restrict__ kR = kdL + kq * 4; const float* __restrict__ rR = rL + kq * 4; const float* __restrict__ vR = vL + rloc;
            float* __restrict__ yW = yL + rloc;
            const int t0 = dir ? 31 : 0, dt = dir ? -1 : 1;
            f32x4 n0 = *(const f32x4*)(nkR + t0 * 64), wa = *(const f32x4*)(wR + t0 * 64), ba = *(const f32x4*)(bR + t0 * 64);
            f32x4 ka = *(const f32x4*)(kR + t0 * 64), ra = *(const f32x4*)(rR + t0 * 64);
            float vv = vR[t0 * 16], iv2 = invn[t0];
            f32x2_t S01 = {S[0], S[1]}, S23 = {S[2], S[3]};
            float yprev = 0.f; int tprev = t0;
#pragma unroll 2
            for (int j = 0; j < 32; ++j) {
                const int tt = t0 + dt * j;
                const int tn = (j < 31) ? tt + dt : tt;
                const f32x4 n0n = *(const f32x4*)(nkR + tn * 64), wan = *(const f32x4*)(wR + tn * 64), ban = *(const f32x4*)(bR + tn * 64);
                const f32x4 kan = *(const f32x4*)(kR + tn * 64), ran = *(const f32x4*)(rR + tn * 64);
                const float vvn = vR[tn * 16], iv2n = invn[tn];
                f32x2_t pp2 = S01 * (f32x2_t){n0.x, n0.y};
                pp2 = __builtin_elementwise_fma(S23, (f32x2_t){n0.z, n0.w}, pp2);
                float ra_ = pp2.x + pp2.y, rb_ = yprev;
                ra_ += dppf<0xB1>(ra_); rb_ += dppf<0xB1>(rb_);
                ra_ += dppf<0x4E>(ra_); rb_ += dppf<0x4E>(rb_);
                ra_ += dppf<0x141>(ra_); rb_ += dppf<0x141>(rb_);
                ra_ += dppf<0x140>(ra_); rb_ += dppf<0x140>(rb_);
                if (kq == 0 && j > 0) yW[tprev * 16] = rb_;
                const float sa = ra_ * iv2;
                const f32x2_t sav = {sa, sa}, vvv = {vv, vv};
                f32x2_t t01 = vvv * (f32x2_t){ka.x, ka.y}, t23 = vvv * (f32x2_t){ka.z, ka.w};
                t01 = __builtin_elementwise_fma(sav, (f32x2_t){ba.x, ba.y}, t01);
                t23 = __builtin_elementwise_fma(sav, (f32x2_t){ba.z, ba.w}, t23);
                S01 = __builtin_elementwise_fma(S01, (f32x2_t){wa.x, wa.y}, t01);
                S23 = __builtin_elementwise_fma(S23, (f32x2_t){wa.z, wa.w}, t23);
                f32x2_t qq = S01 * (f32x2_t){ra.x, ra.y};
                qq = __builtin_elementwise_fma(S23, (f32x2_t){ra.z, ra.w}, qq);
                yprev = qq.x + qq.y; tprev = tt;
                n0 = n0n; wa = wan; ba = ban; ka = kan; ra = ran; vv = vvn; iv2 = iv2n;
            }
            { const float y = red16(yprev); if (kq == 0) yW[tprev * 16] = y; }
            S[0] = S01.x; S[1] = S01.y; S[2] = S23.x; S[3] = S23.y;
        }
        __syncthreads();
        {
            const float y0 = yL[t2 * 16 + part2 * 2], y1 = yL[t2 * 16 + part2 * 2 + 1];
            *(unsigned*)pp = pk2(bflo(pv) + y0, bfhi(pv) + y1);
        }
    }
#undef RW_PREFETCH
}

__device__ __forceinline__ void scan_phase(CParams& p, int l, unsigned char* smem) {
    for (int it = blockIdx.x; it < 224; it += gridDim.x) {
        const int xcd = it & 7;
        if (it < 128) { const int j = it >> 3;
            rwkv_scan_item(p, l, ((xcd * 4 + (j >> 2)) << 2) | (j & 3), smem); }
        else if (it < 192) { const int j = (it - 128) >> 3;
            ssd_scan_item(p, l, ((xcd >> 1) << 4) | ((xcd & 1) << 3) | j, smem); }
        else { const int j = (it - 192) >> 3;
            ret_scan_item(p, l, ((xcd >> 1) << 3) | ((((xcd & 1) << 1) | (j >> 1)) << 1) | (j & 1), smem); }
        __syncthreads();
    }
    int cb = (int)blockIdx.x - 224, cn = (int)gridDim.x - 224;
    if (cn <= 0) { cb = blockIdx.x; cn = gridDim.x; }
    if (cb >= 0) cvt_mix(p, l, smem, cb, cn);
}

__device__ __forceinline__ void post_phase(CParams& p_in, int l_in, int nrows, unsigned char* smem) {
    CParams* pq_ = &p_in; asm volatile("" : "+s"(pq_)); CParams& p = *pq_;
    int l = l_in; asm volatile("" : "+s"(l));
    const int tidx = opaque_tid();
    const int lane = tidx & 63, gw = blockIdx.x * 8 + (tidx >> 6), ngw = gridDim.x * 8;
    unsigned char* ws = p.ws;
    const float* MOD = (const float*)(ws + OFF_MOD);
    for (int row = gw; row < nrows; row += ngw) {
        {
            const bf16_t* yp = (const bf16_t*)(ws + OFF_H) + (size_t)row * 1024 + lane * 16;
            bf16_t* zp = (bf16_t*)(ws + OFF_Z) + (size_t)row * 1024 + lane * 16;
            const float* nw = p.in[13] + (size_t)l * 1024 + lane * 16;
            float v[16]; float ss = 0.f;
#pragma unroll
            for (int q = 0; q < 2; ++q) {
                const u32x4 yr = *(const u32x4*)(yp + q * 8), zr = *(const u32x4*)(zp + q * 8);
                const unsigned ya[4] = {yr.x, yr.y, yr.z, yr.w}, za[4] = {zr.x, zr.y, zr.z, zr.w};
#pragma unroll
                for (int e = 0; e < 4; ++e) {
                    const float y0 = bflo(ya[e]), y1 = bfhi(ya[e]), z0 = bflo(za[e]), z1 = bfhi(za[e]);
                    const float a = y0 * siluf_(z0), c = y1 * siluf_(z1);
                    v[q * 8 + e * 2] = a; v[q * 8 + e * 2 + 1] = c; ss += a * a + c * c;
                }
            }
            ss = red16(ss); ss += __shfl_xor(ss, 16);
            const float rs = rsqrtf(ss * (1.f / 512.f) + 1e-6f);
#pragma unroll
            for (int q = 0; q < 2; ++q) {
                const f32x4 wa = *(const f32x4*)(nw + q * 8), wb = *(const f32x4*)(nw + q * 8 + 4);
                u32x4 o;
                o.x = pk2(v[q * 8 + 0] * rs * wa.x, v[q * 8 + 1] * rs * wa.y); o.y = pk2(v[q * 8 + 2] * rs * wa.z, v[q * 8 + 3] * rs * wa.w);
                o.z = pk2(v[q * 8 + 4] * rs * wb.x, v[q * 8 + 5] * rs * wb.y); o.w = pk2(v[q * 8 + 6] * rs * wb.z, v[q * 8 + 7] * rs * wb.w);
                *(u32x4*)(zp + q * 8) = o;
            }
        }
        {
            const bf16_t* yp = (const bf16_t*)(ws + OFF_PRET) + (size_t)row * 512 + lane * 8;
            bf16_t* gp = (bf16_t*)(ws + OFF_G) + (size_t)row * 512 + lane * 8;
            const u32x4 yr = *(const u32x4*)yp, gr = *(const u32x4*)gp;
            const unsigned ya[4] = {yr.x, yr.y, yr.z, yr.w}, ga[4] = {gr.x, gr.y, gr.z, gr.w};
            float v[8], gg[8]; float s = 0.f;
#pragma unroll
            for (int e = 0; e < 4; ++e) { v[2 * e] = bflo(ya[e]); v[2 * e + 1] = bfhi(ya[e]); gg[2 * e] = bflo(ga[e]); gg[2 * e + 1] = bfhi(ga[e]); s += v[2 * e] + v[2 * e + 1]; }
            s = red16(s);
            const float mean = s * (1.f / 128.f); float q2 = 0.f;
#pragma unroll
            for (int e = 0; e < 8; ++e) { v[e] -= mean; q2 += v[e] * v[e]; }
            q2 = red16(q2);
            const float rs = rsqrtf(q2 * (1.f / 128.f) + 1e-6f);
            u32x4 o;
            o.x = pk2(v[0] * rs * siluf_(gg[0]), v[1] * rs * siluf_(gg[1])); o.y = pk2(v[2] * rs * siluf_(gg[2]), v[3] * rs * siluf_(gg[3]));
            o.z = pk2(v[4] * rs * siluf_(gg[4]), v[5] * rs * siluf_(gg[5])); o.w = pk2(v[6] * rs * siluf_(gg[6]), v[7] * rs * siluf_(gg[7]));
            *(u32x4*)gp = o;
        }
        {
            const bool lat = row < RL; const int mi = lat ? (row >> 13) : 4;
            const float* xin;
            if (lat) xin = (l == 0) ? p.in[0] + (size_t)row * 1024 : p.out + (size_t)row * 1024;
            else xin = (l == 0) ? p.in[2] + (size_t)(row - RL) * 1024 : (const float*)(ws + OFF_CTXS) + (size_t)(row - RL) * 1024;
            const float* modl = MOD + (size_t)(l * 5 + mi) * 6144;
            row_pass(xin, nullptr, nullptr, nullptr, nullptr, true, p.in[4] + (l * 4 + 0) * 1024, modl, modl + 1024, (bf16_t*)(ws + OFF_XBC) + (size_t)row * 1024, lane);
        }
    }
    bf16_t* aB = (bf16_t*)smem;
    bf16_t* gB = aB + 32 * 72;
    float* asL = (float*)(smem + 13312);
    float* gsL = asL + 32 * 512;
    const bf16_t* RW = (const bf16_t*)(ws + OFF_RW);
    bf16_t* P = (bf16_t*)(ws + OFF_PRW);
    const float* mix = p.in[15] + (size_t)l * 1792;
    const int c = tidx;
    const float a0f = p.in[18][(l * 2 + 0) * 512 + c], a0b = p.in[18][(l * 2 + 1) * 512 + c];
    const float kac = p.in[22][l * 512 + c], rkc = p.in[23][l * 512 + c], lw = p.in[24][l * 512 + c], lb = p.in[25][l * 512 + c];
    const float mxr = mix[c], mxk = mix[512 + c], mxv = mix[1024 + c];
    const int wvB = tidx >> 6, frB = lane & 15, fqB = lane >> 4;
    const float* a2 = p.in[19] + (size_t)l * 64 * 512 + wvB * 64 + frB;
    const float* g2 = p.in[20] + (size_t)l * 128 * 512 + wvB * 64 + frB;
    for (int tile = blockIdx.x; tile < nrows / 32; tile += gridDim.x) {
        const int low = tile * 32;
        int s0, s1;
        if (low < RL) { s0 = low & ~8191; s1 = s0 + 8192; } else { s0 = RL + ((low - RL) & ~255); s1 = s0 + 256; }
        {
            for (int e = tidx; e < 32 * 24; e += 512) {
                const int t = e / 24, ch = e - t * 24;
                const u32x4 v = *(const u32x4*)(RW + (size_t)(low + t) * 1792 + 1600 + ch * 8);
                if (ch < 8) *(u32x4*)(aB + t * 72 + ch * 8) = v; else *(u32x4*)(gB + t * 136 + (ch - 8) * 8) = v;
            }
        }
        __syncthreads();
        {
            bf16x8 Aa[2][2], Ag[2][4];
#pragma unroll
            for (int mt = 0; mt < 2; ++mt) {
#pragma unroll
                for (int kc = 0; kc < 2; ++kc) Aa[mt][kc] = *(const bf16x8*)(aB + (mt * 16 + frB) * 72 + kc * 32 + fqB * 8);
#pragma unroll
                for (int kc = 0; kc < 4; ++kc) Ag[mt][kc] = *(const bf16x8*)(gB + (mt * 16 + frB) * 136 + kc * 32 + fqB * 8);
            }
#pragma unroll 1
            for (int nt = 0; nt < 4; ++nt) {
                bf16x8 ba[2], bg[4];
#pragma unroll
                for (int kc = 0; kc < 2; ++kc)
#pragma unroll
                    for (int e = 0; e < 8; ++e) ba[kc][e] = (short)f2bf(a2[(size_t)(kc * 32 + fqB * 8 + e) * 512 + nt * 16]);
#pragma unroll
                for (int kc = 0; kc < 4; ++kc)
#pragma unroll
                    for (int e = 0; e < 8; ++e) bg[kc][e] = (short)f2bf(g2[(size_t)(kc * 32 + fqB * 8 + e) * 512 + nt * 16]);
#pragma unroll
                for (int mt = 0; mt < 2; ++mt) {
                    f32x4 ca = (f32x4){0.f, 0.f, 0.f, 0.f}, cg = (f32x4){0.f, 0.f, 0.f, 0.f};
#pragma unroll
                    for (int kc = 0; kc < 2; ++kc) ca = __builtin_amdgcn_mfma_f32_16x16x32_bf16(Aa[mt][kc], ba[kc], ca, 0, 0, 0);
#pragma unroll
                    for (int kc = 0; kc < 4; ++kc) cg = __builtin_amdgcn_mfma_f32_16x16x32_bf16(Ag[mt][kc], bg[kc], cg, 0, 0, 0);
#pragma unroll
                    for (int r = 0; r < 4; ++r) {
                        const int idx = (mt * 16 + fqB * 4 + r) * 512 + wvB * 64 + nt * 16 + frB;
                        asL[idx] = ca[r]; gsL[idx] = cg[r];
                    }
                }
            }
        }
        __syncthreads();
        const bf16_t* u = RW + (size_t)low * 1792;
#pragma unroll 1
        for (int tb = 0; tb < 32; tb += 8) {
            bf16_t rr[8], kk8[8], vv8[8], yy[8];
#pragma unroll
            for (int i = 0; i < 8; ++i) {
                const bf16_t* un = u + (size_t)(tb + i) * 1792;
                rr[i] = un[c]; kk8[i] = un[512 + c]; vv8[i] = un[1024 + c]; yy[i] = P[(size_t)(low + tb + i) * 512 + c];
            }
#pragma unroll
            for (int i = 0; i < 8; ++i) {
                const int row = low + tb + i;
                const float r = bf2f(rr[i]), k = bf2f(kk8[i]), v = bf2f(vv8[i]), y = bf2f(yy[i]);
                const float ash = asL[(tb + i) * 512 + c];
                const float af = sigmoidf_(a0f + ash), ab = sigmoidf_(a0b + ash);
                const float ks = k * (2.f + (af + ab - 2.f) * kac);
                const float bsum = wave_sum(r * ks * rkc);
                const float mean = wave_sum(y) * (1.f / 64.f);
                const float d = y - mean;
                const float var = wave_sum(d * d) * (1.f / 64.f);
                const float yn = d * rsqrtf(var + 64e-5f) * lw + lb;
                P[(size_t)row * 512 + c] = f2bf((yn + bsum * v) * gsL[(tb + i) * 512 + c]);
            }
        }
        __syncthreads();
    }
}

__device__ __forceinline__ void flat_barrier(unsigned* cnt, unsigned target) {
    asm volatile("s_waitcnt vmcnt(0)" ::: "memory");
    __syncthreads();
    if (threadIdx.x == 0) {
        __builtin_amdgcn_fence(__ATOMIC_RELEASE, "agent");
        asm volatile("s_waitcnt vmcnt(0)" ::: "memory");
        __hip_atomic_fetch_add(cnt, 1u, __ATOMIC_RELAXED, __HIP_MEMORY_SCOPE_AGENT);
        while (__hip_atomic_load(cnt, __ATOMIC_RELAXED, __HIP_MEMORY_SCOPE_AGENT) < target) __builtin_amdgcn_s_sleep(1);
        __builtin_amdgcn_fence(__ATOMIC_ACQUIRE, "agent");
        asm volatile("s_waitcnt vmcnt(0)" ::: "memory");
    }
    __syncthreads();
}

__global__ void __launch_bounds__(512) mega(Params p_arg) {
    extern __shared__ __attribute__((aligned(16))) unsigned char smem[];
    CParams* pbase = (CParams*)__builtin_amdgcn_kernarg_segment_ptr();
    const int ph_lo = p_arg.ph_lo, ph_hi = p_arg.ph_hi;
    for (int ph = ph_lo; ph < ph_hi; ++ph) {
        CParams* pq = pbase;
        asm volatile("" : "+s"(pq));
        CParams& p = *pq;
        int gm = -1, l = 0, sub = -1;
        if (ph >= 2) { l = (ph - 2) / 11; sub = (ph - 2) % 11; }
        const int nrows = (l == 3) ? RL : R;
        if (sub == 0) gm = GM_IN; else if (sub == 5) gm = GM_MERGE; else if (sub == 6) gm = GM_OUT; else if (sub == 8) gm = GM_MLP1; else if (sub == 9) gm = GM_MLP2;
        if (gm >= 0) {
            gemm_phase(p, gm, gm == GM_IN ? 132 : nrows / 256, (LAS unsigned char*)smem);
            __syncthreads();
        } else if (ph == 0) {
            phase_mod(p, smem);
            cvt_win(p, 0, smem, blockIdx.x, gridDim.x);
        } else if (ph == 1) {
            token_phase(p, 0, 0, R);
        } else if (sub == 1) {
            shift_phase(p, l, 0, smem);
        } else if (sub == 2) {
            shift_phase(p, l, 1, smem);
        } else if (sub == 3) {
            scan_phase(p, l, smem);
        } else if (sub == 4) {
            post_phase(p, l, nrows, smem);
        } else if (sub == 7) {
            token_phase(p, l, 1, nrows);
            cvt_mlp(p, l, smem, blockIdx.x, gridDim.x);
        } else if (sub == 10) {
            token_phase(p, l, 2, nrows);
            if (l < 3) cvt_win(p, l + 1, smem, blockIdx.x, gridDim.x);
        }
        if (ph + 1 < ph_hi) {
            if (ph == ph_lo) { __threadfence(); cg::this_grid().sync(); }
            else flat_barrier((unsigned*)(p_arg.ws + OFF_BAR), (unsigned)(ph - ph_lo) * gridDim.x);
        }
    }
}

extern "C" void kernel_launch(void* const* d_in, const int* in_sizes, int n_in, void* d_out, int out_size, void* d_ws, size_t ws_size, hipStream_t stream) {
    static int grid = 0;
    if (grid == 0) {
        if (n_in != 32 || ws_size < WS_END) { fprintf(stderr, "kernel_launch: bad n_in %d or ws %zu < %zu\n", n_in, ws_size, (size_t)WS_END); grid = -1; return; }
        if (hipFuncSetAttribute((const void*)mega, hipFuncAttributeMaxDynamicSharedMemorySize, LDS_BYTES) != hipSuccess) { grid = -1; return; }
        int dev = 0, cus = 0, per_cu = 0;
        hipGetDevice(&dev);
        hipDeviceGetAttribute(&cus, hipDeviceAttributeMultiprocessorCount, dev);
        hipOccupancyMaxActiveBlocksPerMultiprocessor(&per_cu, (const void*)mega, 512, LDS_BYTES);
        (void)hipGetLastError();
        if (per_cu < 1) per_cu = 1;
        grid = cus * per_cu; if (grid > 256) grid = 256;
    }
    if (grid < 0) return;
    Params p{};
    for (int i = 0; i < 32; ++i) p.in[i] = (const float*)d_in[i];
    p.out = (float*)d_out; p.ws = (unsigned char*)d_ws;
    p.ph_lo = 0; p.ph_hi = NPH; p.coop = 1; p.pad = 0;
    if (hipMemsetAsync((char*)d_ws + OFF_BAR, 0, 64, stream) != hipSuccess) return;
    void* args[] = {&p};
    hipError_t e = hipLaunchCooperativeKernel((const void*)mega, dim3(grid), dim3(512), args, LDS_BYTES, stream);
    if (e != hipSuccess) fprintf(stderr, "cooperative launch failed: %s (grid %d)\n", hipGetErrorString(e), grid);
}
```

```cpp
#include <hip/hip_runtime.h>
#include <hip/hip_cooperative_groups.h>
#include <cstdint>
#include <cstdio>
namespace cg = cooperative_groups;

typedef unsigned short bf16_t;
typedef short bf16x8 __attribute__((ext_vector_type(8)));
typedef float f32x4 __attribute__((ext_vector_type(4)));
typedef unsigned u32x2 __attribute__((ext_vector_type(2)));
typedef unsigned u32x4 __attribute__((ext_vector_type(4)));

constexpr int RL = 32768;
constexpr int RC = 1024;
constexpr int R = RL + RC;
constexpr int LDS_BYTES = 153600;
constexpr int NPH = 2 + 11 * 4;
#ifndef PROBE_SCAN
#define PROBE_SCAN 0
#endif
#ifndef PROBE_GEMM
#define PROBE_GEMM 0
#endif

constexpr size_t OFF_MOD = 0;
constexpr size_t OFF_BAR = 491776;
constexpr size_t OFF_CTXS = 524288;
constexpr size_t OFF_DT = OFF_CTXS + 4194304;
constexpr size_t OFF_W = OFF_DT + (size_t)R * 32 * 4;
constexpr size_t OFF_H = OFF_W + 16777216;
constexpr size_t SZ1024 = (size_t)R * 1024 * 2;
constexpr size_t OFF_Z = OFF_H + SZ1024;
constexpr size_t OFF_XBC = OFF_Z + SZ1024;
constexpr size_t OFF_QKV = OFF_XBC + (size_t)R * 1536 * 2;
constexpr size_t OFF_G = OFF_QKV + SZ1024;
constexpr size_t OFF_RW = OFF_G + (size_t)R * 512 * 2;
constexpr size_t OFF_PRET = OFF_RW + (size_t)R * 1792 * 2;
constexpr size_t OFF_PRW = OFF_PRET + (size_t)R * 512 * 2;
constexpr size_t WS_END = OFF_PRW + (size_t)R * 512 * 2;
constexpr size_t W_G = 0, W_SO = 6291456, W_RO = 8388608, W_WO = 9437184, W_O = 10485760;
constexpr size_t W_1 = 0, W_2 = 8388608;
constexpr size_t MSCR_S = 0, MSCR_M = (size_t)256 * 131072;

struct Params {
    const float* in[32];
    float* out;
    unsigned char* ws;
    int ph_lo, ph_hi, coop, pad;
};

typedef const __attribute__((address_space(4))) Params CParams;

__device__ __forceinline__ float bf2f(bf16_t h) { return __uint_as_float(((unsigned)h) << 16); }
__device__ __forceinline__ float bflo(unsigned u) { return __uint_as_float(u << 16); }
__device__ __forceinline__ float bfhi(unsigned u) { return __uint_as_float(u & 0xffff0000u); }
typedef float f32x2_t __attribute__((ext_vector_type(2)));
typedef __bf16 bf16x2_t __attribute__((ext_vector_type(2)));
__device__ __forceinline__ unsigned pk2(float a, float b) { const f32x2_t v = {a, b}; const bf16x2_t r = __builtin_convertvector(v, bf16x2_t); return __builtin_bit_cast(unsigned, r); }
__device__ __forceinline__ bf16_t f2bf(float f) { const __bf16 r = (__bf16)f; return __builtin_bit_cast(unsigned short, r); }
template <int CTRL> __device__ __forceinline__ float dppf(float v) {
    return __builtin_bit_cast(float, __builtin_amdgcn_update_dpp(0, __builtin_bit_cast(int, v), CTRL, 0xf, 0xf, true));
}
__device__ __forceinline__ float red4(float v) { v += dppf<0xB1>(v); v += dppf<0x4E>(v); return v; }
__device__ __forceinline__ float red8(float v) { v = red4(v); v += dppf<0x141>(v); return v; }
__device__ __forceinline__ float red16(float v) { v = red8(v); v += dppf<0x140>(v); return v; }
__device__ __forceinline__ float wave_sum(float v) { v = red16(v); v += __shfl_xor(v, 16); v += __shfl_xor(v, 32); return v; }
__device__ __forceinline__ int opaque_tid() { int t = threadIdx.x; asm volatile("" : "+v"(t)); return t; }
__device__ __forceinline__ float sigmoidf_(float x) { return __builtin_amdgcn_rcpf(1.f + __expf(-x)); }
__device__ __forceinline__ float siluf_(float x) { return x * __builtin_amdgcn_rcpf(1.f + __expf(-x)); }
__device__ __forceinline__ float fast_tanh(float x) { return 1.f - 2.f * __builtin_amdgcn_rcpf(1.f + __expf(2.f * x)); }
__device__ __forceinline__ float fast_softplus(float x) { return x > 20.f ? x : __logf(1.f + __expf(x)); }
__device__ __forceinline__ float softplusf_(float x) { return x > 20.f ? x : log1pf(__expf(x)); }

constexpr int BK = 64, HALF = 128, HT = HALF * BK;
__device__ __forceinline__ int lds_byte(int r, int c) {
    int st = (r >> 4) * 2 + (c >> 5), rr = r & 15, cc = c & 31, ob = rr * 64 + cc * 2;
    return st * 1024 + (ob ^ (((ob >> 9) & 1) << 5));
}
__device__ __forceinline__ void stage_rc(int b, int& Rr, int& Cc) {
    int st = b / 1024, sb = b % 1024, swz = sb ^ (((sb >> 9) & 1) << 5);
    Rr = (st >> 1) * 16 + swz / 64; Cc = (st & 1) * 32 + (swz % 64) / 2;
}

#define LAS __attribute__((address_space(3)))
constexpr int HTB = HALF * BK * 2;

__device__ __forceinline__ bool tile_next(int i, int G, int c, int nM, int nN, int& pm, int& pn) {
    const int nwg = nM * nN;
    const long L = (long)i * G + c; if (L >= nwg) return false;
    int wgid = (int)L; { const int q = nwg / 8, r = nwg % 8, xcd = wgid % 8, off = wgid / 8; wgid = (xcd < r ? xcd * (q + 1) : r * (q + 1) + (xcd - r) * q) + off; }
    const int nig = 8 * nN, gid = wgid / nig, fm = gid * 8, gsz = (nM - fm) < 8 ? (nM - fm) : 8;
    pm = fm + ((wgid % nig) % gsz); pn = (wgid % nig) / gsz; return true;
}

enum { GM_IN = 0, GM_MERGE = 1, GM_OUT = 2, GM_MLP1 = 3, GM_MLP2 = 4 };
struct UnitInfo { const char* A; const char* B; int K, wt, mt, step; };

__device__ __forceinline__ bool get_unit(unsigned char* ws, int mode, int n_mt, int n_wt, int nsteps, int ui, UnitInfo& u) {
    const int it = ui / nsteps, step = ui - it * nsteps;
    int mt, wt;
    if (!tile_next(it, gridDim.x, blockIdx.x, n_mt, n_wt, mt, wt)) return false;
    const size_t tok0 = (size_t)mt * 256;
    const bf16_t* Aw; const bf16_t* Bact; int K = 1024;
    if (mode == GM_IN) { Aw = (const bf16_t*)(ws + OFF_W) + (size_t)wt * 256 * 1024; Bact = (const bf16_t*)(ws + OFF_H) + tok0 * 1024; }
    else if (mode == GM_OUT) { Aw = (const bf16_t*)(ws + OFF_W + W_O) + (size_t)wt * 256 * 1024; Bact = (const bf16_t*)(ws + OFF_QKV) + tok0 * 1024; }
    else if (mode == GM_MLP1) { Aw = (const bf16_t*)(ws + OFF_W + W_1) + (size_t)wt * 256 * 1024; Bact = (const bf16_t*)(ws + OFF_H) + tok0 * 1024; }
    else if (mode == GM_MLP2) { K = 4096; Aw = (const bf16_t*)(ws + OFF_W + W_2) + (size_t)wt * 256 * 4096; Bact = (const bf16_t*)(ws + OFF_Z) + tok0 * 4096; }
    else {
        const int k = step >> 1;
        if ((step & 1) == 0) { Aw = (const bf16_t*)(ws + OFF_W + W_G) + ((size_t)k * 1024 + (size_t)wt * 256) * 1024; Bact = (const bf16_t*)(ws + OFF_XBC) + tok0 * 1024; }
        else if (k == 0) { Aw = (const bf16_t*)(ws + OFF_W + W_SO) + (size_t)wt * 256 * 1024; Bact = (const bf16_t*)(ws + OFF_Z) + tok0 * 1024; }
        else if (k == 1) { K = 512; Aw = (const bf16_t*)(ws + OFF_W + W_RO) + (size_t)wt * 256 * 512; Bact = (const bf16_t*)(ws + OFF_G) + tok0 * 512; }
        else { K = 512; Aw = (const bf16_t*)(ws + OFF_W + W_WO) + (size_t)wt * 256 * 512; Bact = (const bf16_t*)(ws + OFF_PRW) + tok0 * 512; }
    }
    u.A = (const char*)Bact; u.B = (const char*)Aw; u.K = K; u.wt = wt; u.mt = mt; u.step = step;
    return true;
}

__device__ __forceinline__ void gemm_epilogue(unsigned char* ws, int mode, const UnitInfo& u, const f32x4 (&acc)[2][2][4][2], int wr, int wc, int fr, int fq, int tidx) {
    const size_t tok0 = (size_t)u.mt * 256; const int wt = u.wt, step = u.step;
    if (mode == GM_MERGE) {
        u32x4* sp = (u32x4*)(ws + OFF_RW + MSCR_S) + ((size_t)blockIdx.x * 8 * 512 + tidx) * 2;
        f32x4* mp = (f32x4*)(ws + OFF_RW + MSCR_M) + ((size_t)blockIdx.x * 8 * 512 + tidx) * 4;
        bf16_t* MG = (bf16_t*)(ws + OFF_QKV);
#pragma unroll
        for (int ai = 0; ai < 2; ++ai)
#pragma unroll
            for (int bj = 0; bj < 2; ++bj)
#pragma unroll
                for (int mh = 0; mh < 2; ++mh) {
                    if ((step & 1) == 0) {
                        unsigned o[8];
#pragma unroll
                        for (int k = 0; k < 4; ++k) {
                            const f32x4 v = acc[ai][bj][mh * 2 + (k >> 1)][k & 1];
                            o[2 * k] = pk2(sigmoidf_(v.x), sigmoidf_(v.y)); o[2 * k + 1] = pk2(sigmoidf_(v.z), sigmoidf_(v.w));
                        }
                        sp[0] = (u32x4){o[0], o[1], o[2], o[3]}; sp[1] = (u32x4){o[4], o[5], o[6], o[7]};
                    } else {
                        const u32x4 sa_ = sp[0], sb_ = sp[1];
                        const unsigned s8[8] = {sa_.x, sa_.y, sa_.z, sa_.w, sb_.x, sb_.y, sb_.z, sb_.w};
                        f32x4 m4[4];
                        if (step > 1) {
#pragma unroll
                            for (int k = 0; k < 4; ++k) m4[k] = mp[k];
                        }
#pragma unroll
                        for (int k = 0; k < 4; ++k) {
                            const int m = mh * 2 + (k >> 1), n = k & 1;
                            const f32x4 v = acc[ai][bj][m][n];
                            f32x4 mm = (f32x4){bflo(s8[2 * k]) * v.x, bfhi(s8[2 * k]) * v.y, bflo(s8[2 * k + 1]) * v.z, bfhi(s8[2 * k + 1]) * v.w};
                            if (step > 1) mm += m4[k];
                            if (step < 5) mp[k] = mm;
                            else {
                                const size_t tok = tok0 + ai * 128 + wr * 64 + m * 16 + fr;
                                const int feat = wt * 256 + bj * 128 + wc * 32 + fq * 8 + n * 4;
                                u32x2 o; o.x = pk2(mm.x, mm.y); o.y = pk2(mm.z, mm.w);
                                *(u32x2*)(MG + tok * 1024 + feat) = o;
                            }
                        }
                    }
                    sp += 512 * 2; mp += 512 * 4;
                    asm volatile("" : "+v"(sp), "+v"(mp) :: "memory");
                }
    } else if (mode == GM_IN && wt == 23) {
        float* DT = (float*)(ws + OFF_DT);
        if (wc == 0) {
#pragma unroll
            for (int ai = 0; ai < 2; ++ai)
#pragma unroll
                for (int m = 0; m < 4; ++m)
#pragma unroll
                    for (int n = 0; n < 2; ++n) {
                        const size_t tok = tok0 + ai * 128 + wr * 64 + m * 16 + fr;
                        *(f32x4*)(DT + tok * 32 + fq * 8 + n * 4) = acc[ai][0][m][n];
                    }
        }
    } else {
        bf16_t* base; int ld, col0;
        if (mode == GM_IN) {
            if (wt < 4) { base = (bf16_t*)(ws + OFF_Z); ld = 1024; col0 = wt * 256; }
            else if (wt < 10) { base = (bf16_t*)(ws + OFF_XBC); ld = 1536; col0 = (wt - 4) * 256; }
            else if (wt < 14) { base = (bf16_t*)(ws + OFF_QKV); ld = 1024; col0 = (wt - 10) * 256; }
            else if (wt < 16) { base = (bf16_t*)(ws + OFF_G); ld = 512; col0 = (wt - 14) * 256; }
            else { base = (bf16_t*)(ws + OFF_RW); ld = 1792; col0 = (wt - 16) * 256; }
        } else if (mode == GM_MLP1) { base = (bf16_t*)(ws + OFF_Z); ld = 4096; col0 = wt * 256; }
        else { base = (bf16_t*)(ws + OFF_H); ld = 1024; col0 = wt * 256; }
        const bool relu2 = (mode == GM_MLP1);
#pragma unroll
        for (int ai = 0; ai < 2; ++ai)
#pragma unroll
            for (int m = 0; m < 4; ++m) {
                const size_t tok = tok0 + ai * 128 + wr * 64 + m * 16 + fr;
                bf16_t* rowp = base + tok * ld + col0 + wc * 32 + fq * 8;
#pragma unroll
                for (int bj = 0; bj < 2; ++bj) {
                    f32x4 v = acc[ai][bj][m][0], w = acc[ai][bj][m][1];
                    if (relu2) { v.x = v.x > 0.f ? v.x * v.x : 0.f; v.y = v.y > 0.f ? v.y * v.y : 0.f; v.z = v.z > 0.f ? v.z * v.z : 0.f; v.w = v.w > 0.f ? v.w * v.w : 0.f;
                                 w.x = w.x > 0.f ? w.x * w.x : 0.f; w.y = w.y > 0.f ? w.y * w.y : 0.f; w.z = w.z > 0.f ? w.z * w.z : 0.f; w.w = w.w > 0.f ? w.w * w.w : 0.f; }
                    u32x4 o; o.x = pk2(v.x, v.y); o.y = pk2(v.z, v.w); o.z = pk2(w.x, w.y); o.w = pk2(w.z, w.w);
                    *(u32x4*)(rowp + bj * 128) = o;
                }
            }
    }
}

__device__ __forceinline__ void gemm_phase(CParams& p_in, const int mode, const int n_mt, LAS unsigned char* lds) {
    CParams* pq_ = &p_in; asm volatile("" : "+s"(pq_)); CParams& p = *pq_;
    const int tid = opaque_tid(), wid = __builtin_amdgcn_readfirstlane(tid >> 6), lane = tid & 63, wr = wid >> 2, wc = wid & 3, fr = lane & 15, fq = lane >> 4;
    unsigned char* ws = p.ws;
    int n_wt, nsteps = 1;
    if (mode == GM_IN) n_wt = 24; else if (mode == GM_MLP1) n_wt = 16; else n_wt = 4;
    if (mode == GM_MERGE) nsteps = 6;
    unsigned vR[2], vC[2];
#pragma unroll
    for (int i = 0; i < 2; ++i) { int Rr, Cc; stage_rc(tid * 16 + i * 8192, Rr, Cc); vR[i] = (unsigned)Rr * 2u; vC[i] = (unsigned)Cc * 2u; }
    const size_t kstep = (size_t)(BK * 2);
    const unsigned ldsw = (unsigned)wid * 1024u;
    const int aoff = lds_byte(wr * 64 + fr, fq * 8), boff = lds_byte(wc * 32 + fr, fq * 8);
#define PG8_SA(b, h) (((b) * 2 + (h)) * HTB)
#define PG8_SB(b, h) ((4 + (b) * 2 + (h)) * HTB)
#define PG8_STAGE(bufoff, gbase, v0, v1) do { \
        __builtin_amdgcn_global_load_lds((const unsigned*)((const char*)(gbase) + (v0)), (LAS unsigned*)(lds + (bufoff) + ldsw), 16, 0, 0); \
        __builtin_amdgcn_global_load_lds((const unsigned*)((const char*)(gbase) + (v1)), (LAS unsigned*)(lds + (bufoff) + ldsw + 8192), 16, 0, 0); } while (0)
#define PG8_LDA(dst, b, h) do { _Pragma("unroll") for (int m = 0; m < 4; ++m) _Pragma("unroll") for (int k = 0; k < 2; ++k) dst[m][k] = *(const LAS bf16x8*)(lds + PG8_SA(b, h) + aoff + m * 2048 + k * 1024); } while (0)
#define PG8_LDB(dst, b, h) do { _Pragma("unroll") for (int n = 0; n < 2; ++n) _Pragma("unroll") for (int k = 0; k < 2; ++k) dst[n][k] = *(const LAS bf16x8*)(lds + PG8_SB(b, h) + boff + n * 2048 + k * 1024); } while (0)
#define PG8_MMA(ai, bj, At, Bt) do { __builtin_amdgcn_s_setprio(1); _Pragma("unroll") for (int m = 0; m < 4; ++m) _Pragma("unroll") for (int n = 0; n < 2; ++n) _Pragma("unroll") for (int k = 0; k < 2; ++k) \
        acc[ai][bj][m][n] = __builtin_amdgcn_mfma_f32_16x16x32_bf16(Bt[n][k], At[m][k], acc[ai][bj][m][n], 0, 0, 0); __builtin_amdgcn_s_setprio(0); } while (0)
#define PG8_WAIT_V(n) asm volatile("s_waitcnt vmcnt(" #n ")" ::: "memory")
#define PG8_WAIT_L(n) asm volatile("s_waitcnt lgkmcnt(" #n ")" ::: "memory")
#define PG8_BAR __builtin_amdgcn_s_barrier()
#define PG8_SCHED __builtin_amdgcn_sched_barrier(0)
    UnitInfo cur, nxt; int ui = 0;
    if (!get_unit(ws, mode, n_mt, n_wt, nsteps, 0, cur)) return;
    f32x4 acc[2][2][4][2];
#pragma unroll
    for (int a = 0; a < 2; ++a)
#pragma unroll
        for (int b = 0; b < 2; ++b)
#pragma unroll
            for (int m = 0; m < 4; ++m)
#pragma unroll
                for (int n = 0; n < 2; ++n) acc[a][b][m][n] = (f32x4){0.f, 0.f, 0.f, 0.f};
    bf16x8 At[4][2], B0[2][2], B1[2][2];
    const char* cA = cur.A; const char* cB = cur.B;
    unsigned vc0 = vR[0] * (unsigned)cur.K + vC[0], vc1 = vR[1] * (unsigned)cur.K + vC[1];
    size_t hstep = (size_t)HALF * cur.K * 2;
    PG8_STAGE(PG8_SB(0, 0), cB, vc0, vc1); PG8_STAGE(PG8_SA(0, 0), cA, vc0, vc1); PG8_STAGE(PG8_SB(0, 1), cB + hstep, vc0, vc1); PG8_STAGE(PG8_SA(0, 1), cA + hstep, vc0, vc1);
    if (wr == 1) PG8_BAR;
    PG8_WAIT_V(4); PG8_BAR;
    PG8_STAGE(PG8_SB(1, 0), cB + kstep, vc0, vc1); PG8_STAGE(PG8_SA(1, 0), cA + kstep, vc0, vc1); PG8_STAGE(PG8_SB(1, 1), cB + hstep + kstep, vc0, vc1);
    PG8_WAIT_V(6); PG8_BAR;
    for (;;) {
        const bool has_next = get_unit(ws, mode, n_mt, n_wt, nsteps, ui + 1, nxt);
        const char* nA = has_next ? nxt.A : cA; const char* nB = has_next ? nxt.B : cB;
        const int Kn = has_next ? nxt.K : cur.K;
        const unsigned vn0 = vR[0] * (unsigned)Kn + vC[0], vn1 = vR[1] * (unsigned)Kn + vC[1];
        const size_t hstepn = (size_t)HALF * Kn * 2;
        const int nt = cur.K / BK;
        for (int t = 0; t < nt; t += 2) {
            const bool last = (t == nt - 2);
            const char* a1 = cA + (size_t)(t + 1) * kstep;
            const char* a2 = last ? nA : cA + (size_t)(t + 2) * kstep; const char* b2 = last ? nB : cB + (size_t)(t + 2) * kstep;
            const char* a3 = a2 + kstep; const char* b3 = b2 + kstep;
            const unsigned w0 = last ? vn0 : vc0, w1 = last ? vn1 : vc1;
            const size_t hs2 = last ? hstepn : hstep;
            PG8_LDB(B0, 0, 0); PG8_SCHED; PG8_LDA(At, 0, 0); PG8_STAGE(PG8_SA(1, 1), a1 + hstep, vc0, vc1);
            PG8_WAIT_L(8); PG8_BAR; PG8_WAIT_L(0); PG8_MMA(0, 0, At, B0); PG8_BAR; PG8_SCHED;
            PG8_LDB(B1, 0, 1); PG8_STAGE(PG8_SB(0, 0), b2, w0, w1);
            PG8_BAR; PG8_WAIT_L(0); PG8_MMA(0, 1, At, B1); PG8_BAR;
            PG8_LDA(At, 0, 1); PG8_STAGE(PG8_SA(0, 0), a2, w0, w1);
            PG8_BAR; PG8_WAIT_L(0); PG8_MMA(1, 0, At, B0); PG8_BAR; PG8_SCHED;
            PG8_STAGE(PG8_SB(0, 1), b2 + hs2, w0, w1);
            PG8_WAIT_V(6); PG8_BAR; PG8_MMA(1, 1, At, B1); PG8_BAR;
            PG8_LDB(B0, 1, 0); PG8_SCHED; PG8_LDA(At, 1, 0); PG8_STAGE(PG8_SA(0, 1), a2 + hs2, w0, w1);
            PG8_WAIT_L(8); PG8_BAR; PG8_WAIT_L(0); PG8_MMA(0, 0, At, B0); PG8_BAR; PG8_SCHED;
            PG8_LDB(B1, 1, 1); PG8_STAGE(PG8_SB(1, 0), b3, w0, w1);
            PG8_BAR; PG8_WAIT_L(0); PG8_MMA(0, 1, At, B1); PG8_BAR;
            PG8_LDA(At, 1, 1); PG8_STAGE(PG8_SA(1, 0), a3, w0, w1);
            PG8_BAR; PG8_WAIT_L(0); PG8_MMA(1, 0, At, B0); PG8_BAR; PG8_SCHED;
            PG8_STAGE(PG8_SB(1, 1), b3 + hs2, w0, w1);
            PG8_WAIT_V(6); PG8_BAR; PG8_MMA(1, 1, At, B1); PG8_BAR;
        }
        gemm_epilogue(ws, mode, cur, acc, wr, wc, fr, fq, tid);
        if (!has_next) break;
#pragma unroll
        for (int a = 0; a < 2; ++a)
#pragma unroll
            for (int b = 0; b < 2; ++b)
#pragma unroll
                for (int m = 0; m < 4; ++m)
#pragma unroll
                    for (int n = 0; n < 2; ++n) acc[a][b][m][n] = (f32x4){0.f, 0.f, 0.f, 0.f};
        cur = nxt; cA = nA; cB = nB; vc0 = vn0; vc1 = vn1; hstep = hstepn; ++ui;
    }
    PG8_WAIT_V(0);
    if (wr == 0) PG8_BAR;
    PG8_BAR;
}

__device__ __forceinline__ void phase_mod(CParams& p_in, unsigned char* smem) {
    CParams* pq_ = &p_in; asm volatile("" : "+s"(pq_)); CParams& p = *pq_;
    const int tidx = opaque_tid();
    float* sc = (float*)smem;
    float* red = sc + 5 * 1024;
    for (int i = tidx; i < 5 * 1024; i += 512) { int r = i >> 10, k = i & 1023; float v = r < 4 ? p.in[1][r * 1024 + k] : p.in[3][k]; sc[i] = siluf_(v); }
    __syncthreads();
    float* MOD = (float*)(p.ws + OFF_MOD);
    const int col = tidx & 63, kp = tidx >> 6;
    for (int item = blockIdx.x; item < 4 * 96; item += gridDim.x) {
        const int l = item / 96, n0 = (item % 96) * 64;
        const float* W = p.in[5] + (size_t)l * 1024 * 6144 + n0 + col;
        float a0 = 0.f, a1 = 0.f, a2 = 0.f, a3 = 0.f, a4 = 0.f;
        for (int k0 = kp * 128; k0 < kp * 128 + 128; k0 += 16) {
            float w[16];
#pragma unroll
            for (int j = 0; j < 16; ++j) w[j] = W[(size_t)(k0 + j) * 6144];
#pragma unroll
            for (int j = 0; j < 16; ++j) { const int k = k0 + j; a0 += sc[k] * w[j]; a1 += sc[1024 + k] * w[j]; a2 += sc[2048 + k] * w[j]; a3 += sc[3072 + k] * w[j]; a4 += sc[4096 + k] * w[j]; }
        }
        red[(kp * 5 + 0) * 64 + col] = a0; red[(kp * 5 + 1) * 64 + col] = a1; red[(kp * 5 + 2) * 64 + col] = a2;
        red[(kp * 5 + 3) * 64 + col] = a3; red[(kp * 5 + 4) * 64 + col] = a4;
        __syncthreads();
        if (tidx < 320) {
            const int r = tidx >> 6; float s = 0.f;
            for (int q = 0; q < 8; ++q) s += red[(q * 5 + r) * 64 + col];
            MOD[(size_t)(l * 5 + r) * 6144 + n0 + col] = s + p.in[6][l * 6144 + n0 + col];
        }
        __syncthreads();
    }
}

__device__ __forceinline__ void cvt_job(const float* W, int ldw, int col0, int ncols, int K, bf16_t* WT, int row0, unsigned char* smem, int cb, int cn) {
    const int tidx = opaque_tid();
    const int wave = tidx >> 6, lane = tidx & 63;
    float* scr = (float*)smem + wave * (64 * 33);
    const int nblk = ncols / 32, nitems = (K / 64) * nblk;
    for (int base = cb * 8; base < nitems; base += cn * 8) {
        const int it = base + wave; const bool valid = it < nitems;
        const int kb = valid ? it / nblk : 0, nb = valid ? it % nblk : 0, k0 = kb * 64, n0 = nb * 32;
        if (valid) {
#pragma unroll 8
            for (int i = 0; i < 32; ++i) { const int kk = 2 * i + (lane >> 5); scr[kk * 33 + (lane & 31)] = W[(size_t)(k0 + kk) * ldw + col0 + n0 + (lane & 31)]; }
        }
        __syncthreads();
        if (valid) {
            const int c = lane & 7;
#pragma unroll
            for (int j = 0; j < 4; ++j) {
                const int n = (lane >> 3) + 8 * j; const float* s = scr + (8 * c) * 33 + n;
                u32x4 o; o.x = pk2(s[0], s[33]); o.y = pk2(s[66], s[99]); o.z = pk2(s[132], s[165]); o.w = pk2(s[198], s[231]);
                const int rho = ((n >> 2) & 1) * 16 + (n >> 3) * 4 + (n & 3);
                *(u32x4*)(WT + (size_t)(row0 + n0 + rho) * K + k0 + 8 * c) = o;
            }
        }
        __syncthreads();
    }
}
__device__ __forceinline__ void cvt_win(CParams& p_in, int l_in, unsigned char* smem, int cb, int cn) {
    CParams* pq_ = &p_in; asm volatile("" : "+s"(pq_)); CParams& p = *pq_;
    int l = l_in; asm volatile("" : "+s"(l));
    const float* W = p.in[7] + (size_t)l * 1024 * 8992; bf16_t* WB = (bf16_t*)(p.ws + OFF_W);
    cvt_job(W, 8992, 3072, 2560, 1024, WB, 0, smem, cb, cn);
    cvt_job(W, 8992, 5664, 3328, 1024, WB, 2560, smem, cb, cn);
    cvt_job(W, 8992, 5632, 256, 1024, WB, 5888, smem, cb, cn);
}
__device__ __forceinline__ void cvt_mix(CParams& p_in, int l_in, unsigned char* smem, int cb, int cn) {
    CParams* pq_ = &p_in; asm volatile("" : "+s"(pq_)); CParams& p = *pq_;
    int l = l_in; asm volatile("" : "+s"(l));
    cvt_job(p.in[7] + (size_t)l * 1024 * 8992, 8992, 0, 3072, 1024, (bf16_t*)(p.ws + OFF_W + W_G), 0, smem, cb, cn);
    cvt_job(p.in[26] + (size_t)l * 1024 * 1024, 1024, 0, 1024, 1024, (bf16_t*)(p.ws + OFF_W + W_SO), 0, smem, cb, cn);
    cvt_job(p.in[27] + (size_t)l * 512 * 1024, 1024, 0, 1024, 512, (bf16_t*)(p.ws + OFF_W + W_RO), 0, smem, cb, cn);
    cvt_job(p.in[28] + (size_t)l * 512 * 1024, 1024, 0, 1024, 512, (bf16_t*)(p.ws + OFF_W + W_WO), 0, smem, cb, cn);
    cvt_job(p.in[29] + (size_t)l * 1024 * 1024, 1024, 0, 1024, 1024, (bf16_t*)(p.ws + OFF_W + W_O), 0, smem, cb, cn);
}
__device__ __forceinline__ void cvt_mlp(CParams& p_in, int l_in, unsigned char* smem, int cb, int cn) {
    CParams* pq_ = &p_in; asm volatile("" : "+s"(pq_)); CParams& p = *pq_;
    int l = l_in; asm volatile("" : "+s"(l));
    cvt_job(p.in[30] + (size_t)l * 1024 * 4096, 4096, 0, 4096, 1024, (bf16_t*)(p.ws + OFF_W + W_1), 0, smem, cb, cn);
    cvt_job(p.in[31] + (size_t)l * 4096 * 1024, 1024, 0, 1024, 4096, (bf16_t*)(p.ws + OFF_W + W_2), 0, smem, cb, cn);
}

__device__ __forceinline__ void row_pass(const float* xrow, const bf16_t* yrow, const float* gate, const float* nwA, float* xout,
                                         bool do_h, const float* nwB, const float* sh, const float* sc, bf16_t* hrow, int lane) {
    f32x4 x[4];
#pragma unroll
    for (int j = 0; j < 4; ++j) x[j] = *(const f32x4*)(xrow + j * 256 + lane * 4);
    u32x2 yraw[4]; f32x4 gw[4];
    if (yrow) {
#pragma unroll
        for (int j = 0; j < 4; ++j) yraw[j] = *(const u32x2*)(yrow + j * 256 + lane * 4);
#pragma unroll
        for (int j = 0; j < 4; ++j) gw[j] = *(const f32x4*)(gate + j * 256 + lane * 4) * *(const f32x4*)(nwA + j * 256 + lane * 4);
    }
    f32x4 hm[4], hs[4];
    if (do_h) {
#pragma unroll
        for (int j = 0; j < 4; ++j) {
            hm[j] = *(const f32x4*)(nwB + j * 256 + lane * 4) * (*(const f32x4*)(sc + j * 256 + lane * 4) + 1.f);
            hs[j] = *(const f32x4*)(sh + j * 256 + lane * 4);
        }
    }
    if (yrow) {
        f32x4 y[4]; float ss = 0.f;
#pragma unroll
        for (int j = 0; j < 4; ++j) {
            y[j] = (f32x4){bflo(yraw[j].x), bfhi(yraw[j].x), bflo(yraw[j].y), bfhi(yraw[j].y)};
            ss += y[j].x * y[j].x + y[j].y * y[j].y + y[j].z * y[j].z + y[j].w * y[j].w;
        }
        ss = wave_sum(ss);
        const float rs = rsqrtf(ss * (1.f / 1024.f) + 1e-6f);
#pragma unroll
        for (int j = 0; j < 4; ++j) x[j] += gw[j] * (y[j] * rs);
    }
    if (xout) {
#pragma unroll
        for (int j = 0; j < 4; ++j) *(f32x4*)(xout + j * 256 + lane * 4) = x[j];
    }
    if (do_h) {
        float ss = 0.f;
#pragma unroll
        for (int j = 0; j < 4; ++j) ss += x[j].x * x[j].x + x[j].y * x[j].y + x[j].z * x[j].z + x[j].w * x[j].w;
        ss = wave_sum(ss);
        const float rs = rsqrtf(ss * (1.f / 1024.f) + 1e-6f);
#pragma unroll
        for (int j = 0; j < 4; ++j) {
            const f32x4 h = (x[j] * rs) * hm[j] + hs[j];
            u32x2 o; o.x = pk2(h.x, h.y); o.y = pk2(h.z, h.w);
            *(u32x2*)(hrow + j * 256 + lane * 4) = o;
        }
    }
}

__device__ __forceinline__ void token_phase(CParams& p_in, int l_in, int kind, int nrows) {
    CParams* pq_ = &p_in; asm volatile("" : "+s"(pq_)); CParams& p = *pq_;
    int l = l_in; asm volatile("" : "+s"(l));
    const int tidx = opaque_tid();
    const int lane = tidx & 63, gw = blockIdx.x * 8 + (tidx >> 6), ngw = gridDim.x * 8;
    const float* MOD = (const float*)(p.ws + OFF_MOD);
    const float* NW = p.in[4];
    bf16_t* H = (bf16_t*)(p.ws + OFF_H);
    float* CTXS = (float*)(p.ws + OFF_CTXS);
    for (int row = gw; row < nrows; row += ngw) {
        const bool lat = row < RL; const int mi = lat ? (row >> 13) : 4;
        const float* xin; float* xout = nullptr;
        const bool from_input = (l == 0 && kind <= 1);
        if (lat) xin = from_input ? p.in[0] + (size_t)row * 1024 : p.out + (size_t)row * 1024;
        else xin = from_input ? p.in[2] + (size_t)(row - RL) * 1024 : CTXS + (size_t)(row - RL) * 1024;
        if (kind > 0) xout = lat ? p.out + (size_t)row * 1024 : CTXS + (size_t)(row - RL) * 1024;
        const float* modl = MOD + (size_t)(l * 5 + mi) * 6144;
        bf16_t* hrow = H + (size_t)row * 1024;
        if (kind == 0) row_pass(xin, nullptr, nullptr, nullptr, nullptr, true, NW + (l * 4 + 0) * 1024, modl, modl + 1024, hrow, lane);
        else if (kind == 1) row_pass(xin, hrow, modl + 2048, NW + (l * 4 + 1) * 1024, xout, true, NW + (l * 4 + 2) * 1024, modl + 3072, modl + 4096, hrow, lane);
        else {
            const bool nxt = l < 3; const float* modn = MOD + (size_t)((l + 1) * 5 + mi) * 6144;
            row_pass(xin, hrow, modl + 5120, NW + (l * 4 + 3) * 1024, xout, nxt, NW + ((l + 1) * 4 + 0) * 1024, modn, modn + 1024, hrow, lane);
        }
    }
}

template <int NQ, int PB>
__device__ __forceinline__ void lin_steps(float (&S)[16], const float* qL, const float* kL, const float* vL, const float* dtL, const float* decL, float* yL, int dir, int nq, int pl) {
    constexpr int N = NQ * 16;
    for (int j = 0; j < 32; ++j) {
        const int tt = dir ? 31 - j : j;
        const float xdt = vL[tt * PB + pl] * dtL[tt];
        const float dec = decL[tt];
        const f32x4* kp = (const f32x4*)(kL + tt * N + nq * 16);
        const f32x4* qp = (const f32x4*)(qL + tt * N + nq * 16);
        float part = 0.f;
#pragma unroll
        for (int q4 = 0; q4 < 4; ++q4) {
            const f32x4 kv = kp[q4], qv = qp[q4];
            S[q4 * 4 + 0] = dec * S[q4 * 4 + 0] + kv.x * xdt; part += qv.x * S[q4 * 4 + 0];
            S[q4 * 4 + 1] = dec * S[q4 * 4 + 1] + kv.y * xdt; part += qv.y * S[q4 * 4 + 1];
            S[q4 * 4 + 2] = dec * S[q4 * 4 + 2] + kv.z * xdt; part += qv.z * S[q4 * 4 + 2];
            S[q4 * 4 + 3] = dec * S[q4 * 4 + 3] + kv.w * xdt; part += qv.w * S[q4 * 4 + 3];
        }
        part = (NQ == 8) ? red8(part) : red4(part);
        if (nq == 0) yL[tt * PB + pl] = part;
    }
}

__device__ __forceinline__ void scan_tile(int b, int dir, int tau, int& low, int& s0, int& s1, bool& isctx, bool& first) {
    int ti, nt;
    isctx = tau < 8;
    if (isctx) { ti = dir ? 7 - tau : tau; s0 = RL + b * 256; s1 = s0 + 256; nt = 8; }
    else { ti = dir ? 255 - (tau - 8) : tau - 8; s0 = b * 8192; s1 = s0 + 8192; nt = 256; }
    low = s0 + ti * 32;
    first = (dir == 0) == (ti < nt / 2);
}

template <int NK> struct CsL {
    static constexpr int SN = NK + 8, SS = 40;
    static constexpr int O_CN = 0, O_BN = O_CN + 32 * SN * 2, O_BWT = O_BN + 32 * SN * 2, O_XT = O_BWT + NK * SS * 2, O_PM = O_XT + 64 * SS * 2,
                         O_ST = O_PM + 32 * SS * 2, O_F = O_ST + 64 * SN * 2, O_Y = O_F + 544, O_RAW = (NK == 128) ? O_Y : O_Y + 8192;
};
template <int NK>
__device__ __forceinline__ void cs_core(unsigned char* base, f32x4 (&accS)[NK / 16], int dir, int w, int fr, int fq) {
    typedef CsL<NK> L;
    constexpr int SN = L::SN, SS = L::SS, KC = NK / 32, NT = NK / 16;
    bf16_t* Cn = (bf16_t*)(base + L::O_CN); bf16_t* Bn = (bf16_t*)(base + L::O_BN); bf16_t* BwT = (bf16_t*)(base + L::O_BWT);
    bf16_t* XT = (bf16_t*)(base + L::O_XT); bf16_t* Pm = (bf16_t*)(base + L::O_PM); bf16_t* ST = (bf16_t*)(base + L::O_ST);
    float* cumL = (float*)(base + L::O_F); float* dtL = cumL + 32; float* eL = dtL + 32; float* totL = eL + 64;
    float* yL = (float*)(base + ((NK == 128) ? L::O_BN : L::O_Y));
    f32x4 acc4[2];
    {
        const int mt = w >> 1, nt = w & 1;
        f32x4 g = (f32x4){0.f, 0.f, 0.f, 0.f};
#pragma unroll
        for (int kc = 0; kc < KC; ++kc) {
            const bf16x8 A = *(const bf16x8*)(Cn + (mt * 16 + fr) * SN + kc * 32 + fq * 8);
            const bf16x8 Bf = *(const bf16x8*)(Bn + (nt * 16 + fr) * SN + kc * 32 + fq * 8);
            g = __builtin_amdgcn_mfma_f32_16x16x32_bf16(A, Bf, g, 0, 0, 0);
        }
        const int s = nt * 16 + fr; const float cs = cumL[s], ds = dtL[s];
#pragma unroll
        for (int r = 0; r < 4; ++r) {
            const int t = mt * 16 + fq * 4 + r;
            const bool ok = dir ? (s >= t) : (s <= t);
            const float val = ok ? g[r] * __expf(cumL[t] - cs) * ds : 0.f;
            Pm[t * SS + s] = f2bf(val);
        }
#pragma unroll
        for (int mt2 = 0; mt2 < 2; ++mt2) {
            acc4[mt2] = (f32x4){0.f, 0.f, 0.f, 0.f};
#pragma unroll
            for (int kc = 0; kc < KC; ++kc) {
                const bf16x8 A = *(const bf16x8*)(Cn + (mt2 * 16 + fr) * SN + kc * 32 + fq * 8);
                const bf16x8 Bf = *(const bf16x8*)(ST + (w * 16 + fr) * SN + kc * 32 + fq * 8);
                acc4[mt2] = __builtin_amdgcn_mfma_f32_16x16x32_bf16(A, Bf, acc4[mt2], 0, 0, 0);
            }
        }
    }
    __syncthreads();
    {
        const bf16x8 Xf = *(const bf16x8*)(XT + (w * 16 + fr) * SS + fq * 8);
#pragma unroll
        for (int mt2 = 0; mt2 < 2; ++mt2) {
            const bf16x8 A = *(const bf16x8*)(Pm + (mt2 * 16 + fr) * SS + fq * 8);
            f32x4 a3 = (f32x4){0.f, 0.f, 0.f, 0.f};
            a3 = __builtin_amdgcn_mfma_f32_16x16x32_bf16(A, Xf, a3, 0, 0, 0);
#pragma unroll
            for (int r = 0; r < 4; ++r) { const int t = mt2 * 16 + fq * 4 + r; yL[t * 64 + w * 16 + fr] = a3[r] + eL[t] * acc4[mt2][r]; }
        }
        const float dtot = __expf(totL[0]);
#pragma unroll
        for (int n8 = 0; n8 < NT; ++n8) {
            const bf16x8 Bf = *(const bf16x8*)(BwT + (n8 * 16 + fr) * SS + fq * 8);
            accS[n8] = accS[n8] * dtot;
            accS[n8] = __builtin_amdgcn_mfma_f32_16x16x32_bf16(Xf, Bf, accS[n8], 0, 0, 0);
#pragma unroll
            for (int r = 0; r < 4; ++r) ST[(w * 16 + fq * 4 + r) * SN + n8 * 16 + fr] = f2bf(accS[n8][r]);
        }
    }
    __syncthreads();
}

template <int NK, bool DX>
__device__ __forceinline__ void cs_writeout(unsigned char* base, bf16_t* pp, u32x4 pv, int tl, float Dh) {
    typedef CsL<NK> L;
    const float* yL = (const float*)(base + ((NK == 128) ? L::O_BN : L::O_Y));
    const bf16_t* XT = (const bf16_t*)(base + L::O_XT);
    const int t = tl >> 3, pg = tl & 7;
    const f32x4 ya = *(const f32x4*)(yL + t * 64 + pg * 8), yb = *(const f32x4*)(yL + t * 64 + pg * 8 + 4);
    float y[8] = {ya.x, ya.y, ya.z, ya.w, yb.x, yb.y, yb.z, yb.w};
    const unsigned pa[4] = {pv.x, pv.y, pv.z, pv.w};
#pragma unroll
    for (int j = 0; j < 4; ++j) { y[2 * j] += bflo(pa[j]); y[2 * j + 1] += bfhi(pa[j]); }
    if (DX) {
#pragma unroll
        for (int j = 0; j < 8; ++j) y[j] += Dh * bf2f(XT[(pg * 8 + j) * L::SS + t]);
    }
    u32x4 o; o.x = pk2(y[0], y[1]); o.y = pk2(y[2], y[3]); o.z = pk2(y[4], y[5]); o.w = pk2(y[6], y[7]);
    *(u32x4*)pp = o;
}

__device__ __forceinline__ void ssd_scan_item(CParams& p_in, int l_in, int item, unsigned char* smem) {
    CParams* pq_ = &p_in; asm volatile("" : "+s"(pq_)); CParams& p = *pq_;
    int l = l_in; asm volatile("" : "+s"(l));
    const int tidx = opaque_tid();
    typedef CsL<128> L;
    constexpr int SN = L::SN, SS = L::SS;
    const int b = item >> 4, h = item & 15, g = h >> 3;
    const int tid = tidx, dir = tid >> 8, tl = tid & 255, lane = tid & 63, w = tl >> 6, fr = lane & 15, fq = lane >> 4;
    unsigned char* base = smem + dir * 76800;
    bf16_t* Cn = (bf16_t*)(base + L::O_CN); bf16_t* Bn = (bf16_t*)(base + L::O_BN); bf16_t* BwT = (bf16_t*)(base + L::O_BWT);
    bf16_t* XT = (bf16_t*)(base + L::O_XT); bf16_t* ST = (bf16_t*)(base + L::O_ST);
    float* cumL = (float*)(base + L::O_F); float* dtL = cumL + 32; float* eL = dtL + 32; float* wL = eL + 32; float* totL = eL + 64;
    bf16_t* rawL = (bf16_t*)(base + L::O_RAW);
    const bf16_t* XBC = (const bf16_t*)(p.ws + OFF_XBC);
    const float* DT = (const float*)(p.ws + OFF_DT);
    bf16_t* P = (bf16_t*)(p.ws + OFF_H);
    const float* cw = p.in[8] + (size_t)l * 5 * 1536; const float* cbias = p.in[9] + (size_t)l * 1536;
    const float dtb = p.in[10][l * 32 + dir * 16 + h];
    const float aneg = -__expf(p.in[11][l * 32 + dir * 16 + h]);
    const float Dh = p.in[12][l * 16 + h];
    const int xc1 = 1024 + g * 128 + (tl & 127) * 2;
    const int xc1c = ((tl & 127) < 64) ? xc1 : 1280 + g * 128 + ((tl & 127) - 64) * 2;
    const f32x2_t cw0 = {cw[xc1c], cw[xc1c + 1]}, cw1 = {cw[1536 + xc1c], cw[1536 + xc1c + 1]}, cw2 = {cw[2 * 1536 + xc1c], cw[2 * 1536 + xc1c + 1]},
                  cw3 = {cw[3 * 1536 + xc1c], cw[3 * 1536 + xc1c + 1]}, cw4 = {cw[4 * 1536 + xc1c], cw[4 * 1536 + xc1c + 1]}, cwb = {cbias[xc1c], cbias[xc1c + 1]};
    const int xc2 = h * 64 + (tl & 63);
    const float c20 = cw[xc2], c21 = cw[1536 + xc2], c22 = cw[2 * 1536 + xc2], c23 = cw[3 * 1536 + xc2], c24 = cw[4 * 1536 + xc2], c2b = cbias[xc2];
    for (int i = tl; i < 64 * SN; i += 256) ST[i] = 0;
    f32x4 accS[8];
#pragma unroll
    for (int i = 0; i < 8; ++i) accS[i] = (f32x4){0.f, 0.f, 0.f, 0.f};
    u32x4 rv[6]; float dtr = 0.f;
    int pf_rr[6], pf_off[6], pf_lds[6];
#pragma unroll
    for (int i = 0; i < 6; ++i) {
        const int e = tl + 256 * i; const int rr = e / 40, ch = e - rr * 40;
        const int xc = ch < 16 ? 1024 + g * 128 + ch * 8 : (ch < 32 ? 1280 + g * 128 + (ch - 16) * 8 : h * 64 + (ch - 32) * 8);
        pf_rr[i] = rr; pf_off[i] = rr * 1536 + xc; pf_lds[i] = (e < 36 * 40) ? rr * 320 + ch * 8 : -1;
    }
#define SSD_PREFETCH(tau_) do { int low_, s0_, s1_; bool ic_, fi_; scan_tile(b, dir, (tau_), low_, s0_, s1_, ic_, fi_); \
        const bf16_t* rb_ = XBC + (size_t)(low_ - 2) * 1536; \
        _Pragma("unroll") for (int i = 0; i < 6; ++i) { \
            const int row = low_ - 2 + pf_rr[i]; \
            rv[i] = (u32x4){0u, 0u, 0u, 0u}; \
            if (pf_lds[i] >= 0 && row >= s0_ && row < s1_) rv[i] = *(const u32x4*)(rb_ + pf_off[i]); } \
        if (tl < 32) dtr = DT[(size_t)(low_ + tl) * 32 + dir * 16 + h]; } while (0)
    SSD_PREFETCH(0);
    for (int tau = 0; tau < 264; ++tau) {
        int low, s0, s1; bool isctx, first;
        scan_tile(b, dir, tau, low, s0, s1, isctx, first);
#pragma unroll
        for (int i = 0; i < 6; ++i) { if (pf_lds[i] >= 0) *(u32x4*)(rawL + pf_lds[i]) = rv[i]; }
        if (tl < 64) {
            const float dt = fast_softplus(dtr + dtb);
            const float la = dt * aneg;
            float c = la;
#pragma unroll
            for (int o = 1; o < 32; o <<= 1) { const float v = __shfl_up(c, o); if (lane >= o) c += v; }
            const float total = __shfl(c, 31);
            const float cd = dir ? (total - c + la) : c;
            if (tl < 32) { cumL[tl] = cd; dtL[tl] = dt; eL[tl] = __expf(cd); wL[tl] = __expf(total - cd) * dt; if (tl == 0) totL[0] = total; }
        }
        bf16_t* pp = P + (size_t)(low + (tl >> 3)) * 1024 + h * 64 + (tl & 7) * 8;
        u32x4 pv = (u32x4){0u, 0u, 0u, 0u};
        if (!first) pv = *(const u32x4*)pp;
        __syncthreads();
        {
            const bf16_t* __restrict__ rawR = rawL;
            {
                const int cp = tl & 127, th = tl >> 7, c0 = cp * 2, tb = th * 16;
                f32x2_t q0, q1, q2, q3;
                { const unsigned a = *(const unsigned*)(rawR + (tb) * 320 + c0), bq = *(const unsigned*)(rawR + (tb + 1) * 320 + c0), cq = *(const unsigned*)(rawR + (tb + 2) * 320 + c0), dq = *(const unsigned*)(rawR + (tb + 3) * 320 + c0);
                  q0 = (f32x2_t){bflo(a), bfhi(a)}; q1 = (f32x2_t){bflo(bq), bfhi(bq)}; q2 = (f32x2_t){bflo(cq), bfhi(cq)}; q3 = (f32x2_t){bflo(dq), bfhi(dq)}; }
#pragma unroll 8
                for (int j = 0; j < 16; ++j) {
                    const int t = tb + j;
                    const unsigned e = *(const unsigned*)(rawR + (t + 4) * 320 + c0);
                    const f32x2_t q4 = {bflo(e), bfhi(e)};
                    f32x2_t o = __builtin_elementwise_fma(cw4, q4, cwb);
                    o = __builtin_elementwise_fma(cw3, q3, o); o = __builtin_elementwise_fma(cw2, q2, o);
                    o = __builtin_elementwise_fma(cw1, q1, o); o = __builtin_elementwise_fma(cw0, q0, o);
                    o.x = siluf_(o.x); o.y = siluf_(o.y);
                    if (cp < 64) {
                        *(unsigned*)(Bn + t * SN + c0) = pk2(o.x, o.y);
                        const float wt = wL[t];
                        const unsigned bw = pk2(o.x * wt, o.y * wt);
                        BwT[c0 * SS + t] = (bf16_t)(bw & 0xffffu); BwT[(c0 + 1) * SS + t] = (bf16_t)(bw >> 16);
                    } else *(unsigned*)(Cn + t * SN + c0 - 128) = pk2(o.x, o.y);
                    q0 = q1; q1 = q2; q2 = q3; q3 = q4;
                }
            }
            const int xcol = 256 + (tl & 63), tq = tl >> 6;
            float q0 = bf2f(rawL[(tq * 8) * 320 + xcol]), q1 = bf2f(rawL[(tq * 8 + 1) * 320 + xcol]), q2 = bf2f(rawL[(tq * 8 + 2) * 320 + xcol]), q3 = bf2f(rawL[(tq * 8 + 3) * 320 + xcol]);
            unsigned xo[4];
#pragma unroll
            for (int j = 0; j < 8; ++j) {
                const float q4 = bf2f(rawL[(tq * 8 + j + 4) * 320 + xcol]);
                const float o = siluf_(c20 * q0 + c21 * q1 + c22 * q2 + c23 * q3 + c24 * q4 + c2b);
                if (j & 1) xo[j >> 1] |= ((unsigned)f2bf(o)) << 16; else xo[j >> 1] = f2bf(o);
                q0 = q1; q1 = q2; q2 = q3; q3 = q4;
            }
            *(u32x4*)(XT + (tl & 63) * SS + tq * 8) = (u32x4){xo[0], xo[1], xo[2], xo[3]};
        }
        __syncthreads();
        if (tau + 1 < 264) SSD_PREFETCH(tau + 1);
        cs_core<128>(base, accS, dir, w, fr, fq);
        cs_writeout<128, true>(base, pp, pv, tl, first ? 0.f : Dh);
        if (tau == 3 || tau == 135) __syncthreads();
    }
#undef SSD_PREFETCH
}

__device__ __forceinline__ void ret_scan_item(CParams& p_in, int l_in, int item, unsigned char* smem) {
    CParams* pq_ = &p_in; asm volatile("" : "+s"(pq_)); CParams& p = *pq_;
    int l = l_in; asm volatile("" : "+s"(l));
    const int tidx = opaque_tid();
    typedef CsL<64> L;
    constexpr int SN = L::SN, SS = L::SS;
    const int b = item >> 3, hd = (item >> 1) & 3, phalf = item & 1;
    const int tid = tidx, dir = tid >> 8, tl = tid & 255, lane = tid & 63, w = tl >> 6, fr = lane & 15, fq = lane >> 4;
    unsigned char* base = smem + dir * 76800;
    bf16_t* Cn = (bf16_t*)(base + L::O_CN); bf16_t* Bn = (bf16_t*)(base + L::O_BN); bf16_t* BwT = (bf16_t*)(base + L::O_BWT);
    bf16_t* XT = (bf16_t*)(base + L::O_XT); bf16_t* ST = (bf16_t*)(base + L::O_ST);
    float* cumL = (float*)(base + L::O_F); float* dtL = cumL + 32; float* eL = dtL + 32; float* wL = eL + 32; float* totL = eL + 64;
    bf16_t* rawL = (bf16_t*)(base + L::O_RAW);
    const bf16_t* QKV = (const bf16_t*)(p.ws + OFF_QKV);
    bf16_t* P = (bf16_t*)(p.ws + OFF_PRET);
    const float lg = -fast_softplus(-p.in[14][l * 8 + dir * 4 + hd]);
    if (tl < 32) {
        const float cd = dir ? (float)(32 - tl) * lg : (float)(tl + 1) * lg;
        const float total = 32.f * lg;
        cumL[tl] = cd; dtL[tl] = 1.f; eL[tl] = __expf(cd); wL[tl] = __expf(total - cd); if (tl == 0) totL[0] = total;
    }
    for (int i = tl; i < 64 * SN; i += 256) ST[i] = 0;
    f32x4 accS[4];
#pragma unroll
    for (int i = 0; i < 4; ++i) accS[i] = (f32x4){0.f, 0.f, 0.f, 0.f};
    const int pairidx = tl & 63, tq = tl >> 6, which = pairidx >> 5, pi = pairidx & 31;
    const float inv = exp2f(-(float)(pi & 15) * (13.287712379549449f / 16.f));
    u32x4 rv[3];
#define RET_PREFETCH(tau_) do { int low_, s0_, s1_; bool ic_, fi_; scan_tile(b, dir, (tau_), low_, s0_, s1_, ic_, fi_); \
        _Pragma("unroll") for (int i = 0; i < 3; ++i) { \
            const int e = tl + 256 * i; const int rr = e / 24, ch = e - rr * 24; \
            const int col = ch < 8 ? hd * 64 + ch * 8 : (ch < 16 ? 256 + hd * 64 + (ch - 8) * 8 : 512 + hd * 128 + phalf * 64 + (ch - 16) * 8); \
            rv[i] = *(const u32x4*)(QKV + (size_t)(low_ + rr) * 1024 + col); } } while (0)
    RET_PREFETCH(0);
    for (int tau = 0; tau < 264; ++tau) {
        int low, s0, s1; bool isctx, first;
        scan_tile(b, dir, tau, low, s0, s1, isctx, first);
#pragma unroll
        for (int i = 0; i < 3; ++i) { const int e = tl + 256 * i; const int rr = e / 24, ch = e - rr * 24; *(u32x4*)(rawL + rr * 192 + ch * 8) = rv[i]; }
        bf16_t* pp = P + (size_t)(low + (tl >> 3)) * 512 + hd * 128 + phalf * 64 + (tl & 7) * 8;
        u32x4 pv = (u32x4){0u, 0u, 0u, 0u};
        if (!first) pv = *(const u32x4*)pp;
        __syncthreads();
        {
#pragma unroll
            for (int j = 0; j < 8; ++j) {
                const int t = tq * 8 + j;
                const unsigned raw = *(const unsigned*)(rawL + t * 192 + which * 64 + 2 * pi);
                const float x1 = bflo(raw), x2 = bfhi(raw);
                float c = 1.f, s = 0.f;
                if (!isctx) { const int pos = low + t - s0; const float ppos = (pi < 16) ? (float)(pos >> 6) : (float)(pos & 63); const float ang = ppos * inv; c = __cosf(ang); s = __sinf(ang); }
                const float o1 = x1 * c - x2 * s, o2 = x1 * s + x2 * c;
                if (which == 0) *(unsigned*)(Cn + t * SN + 2 * pi) = pk2(o1, o2);
                else {
                    const float k1 = o1 * 0.125f, k2 = o2 * 0.125f, wt = wL[t];
                    *(unsigned*)(Bn + t * SN + 2 * pi) = pk2(k1, k2);
                    BwT[(2 * pi) * SS + t] = f2bf(k1 * wt); BwT[(2 * pi + 1) * SS + t] = f2bf(k2 * wt);
                }
            }
            unsigned xo[4];
#pragma unroll
            for (int j = 0; j < 8; ++j) { const unsigned v = rawL[(tq * 8 + j) * 192 + 128 + pairidx]; if (j & 1) xo[j >> 1] |= v << 16; else xo[j >> 1] = v; }
            *(u32x4*)(XT + pairidx * SS + tq * 8) = (u32x4){xo[0], xo[1], xo[2], xo[3]};
        }
        __syncthreads();
        if (tau + 1 < 264) RET_PREFETCH(tau + 1);
        cs_core<64>(base, accS, dir, w, fr, fq);
        cs_writeout<64, false>(base, pp, pv, tl, 0.f);
        if (tau == 3 || tau == 135) __syncthreads();
    }
#undef RET_PREFETCH
}

__device__ __forceinline__ void shift_phase(CParams& p_in, int l_in, int part, unsigned char* smem) {
    CParams* pq_ = &p_in; asm volatile("" : "+s"(pq_)); CParams& p = *pq_;
    int l = l_in; asm volatile("" : "+s"(l));
    const int tidx = opaque_tid();
    bf16_t* RW = (bf16_t*)(p.ws + OFF_RW);
    u32x2* halo = (u32x2*)smem;
    const int c0 = tidx * 4;
    if (tidx >= 448) return;
    if (part == 0) {
        for (int k = 0; k < 5; ++k) {
            const int chunk = blockIdx.x + k * gridDim.x; if (chunk >= R / 32) break;
            const int lo = chunk * 32; int s0, s1;
            if (lo < RL) { s0 = lo & ~8191; s1 = s0 + 8192; } else { s0 = RL + ((lo - RL) & ~255); s1 = s0 + 256; }
            u32x2 a = (u32x2){0u, 0u}, b = (u32x2){0u, 0u};
            if (lo - 1 >= s0) a = *(const u32x2*)(RW + (size_t)(lo - 1) * 1792 + c0);
            if (lo + 32 < s1) b = *(const u32x2*)(RW + (size_t)(lo + 32) * 1792 + c0);
            halo[(k * 2 + 0) * 448 + tidx] = a; halo[(k * 2 + 1) * 448 + tidx] = b;
        }
        return;
    }
    const f32x4 mx = *(const f32x4*)(p.in[15] + (size_t)l * 1792 + c0);
    const int kind = (c0 >= 1536 && c0 < 1600) ? 1 : (c0 >= 1664 ? 2 : 0);
    for (int k = 0; k < 5; ++k) {
        const int chunk = blockIdx.x + k * gridDim.x; if (chunk >= R / 32) break;
        bf16_t* base = RW + (size_t)chunk * 32 * 1792 + c0;
        u32x2 rows[34];
        rows[0] = halo[(k * 2 + 0) * 448 + tidx]; rows[33] = halo[(k * 2 + 1) * 448 + tidx];
#pragma unroll
        for (int t = 0; t < 32; ++t) rows[t + 1] = *(const u32x2*)(base + (size_t)t * 1792);
#pragma unroll
        for (int t = 0; t < 32; ++t) {
            const u32x2 a = rows[t], b = rows[t + 1], c = rows[t + 2];
            f32x4 u0 = (f32x4){bflo(a.x), bfhi(a.x), bflo(a.y), bfhi(a.y)}, u1 = (f32x4){bflo(b.x), bfhi(b.x), bflo(b.y), bfhi(b.y)}, u2 = (f32x4){bflo(c.x), bfhi(c.x), bflo(c.y), bfhi(c.y)};
            f32x4 v = u1 + mx * ((u0 + u2) * 0.5f - u1);
            if (kind == 1) { v.x = fast_tanh(v.x); v.y = fast_tanh(v.y); v.z = fast_tanh(v.z); v.w = fast_tanh(v.w); }
            else if (kind == 2) { v.x = sigmoidf_(v.x); v.y = sigmoidf_(v.y); v.z = sigmoidf_(v.z); v.w = sigmoidf_(v.w); }
            u32x2 o; o.x = pk2(v.x, v.y); o.y = pk2(v.z, v.w);
            *(u32x2*)(base + (size_t)t * 1792) = o;
        }
    }
}

__device__ __forceinline__ void rwkv_scan_item(CParams& p_in, int l_in, int item, unsigned char* smem) {
    CParams* pq_ = &p_in; asm volatile("" : "+s"(pq_)); CParams& p = *pq_;
    int l = l_in; asm volatile("" : "+s"(l));
    const int tidx = opaque_tid();
    const int b = item >> 5, h = (item >> 2) & 7, rq = item & 3;
    const int tid = tidx, dir = tid >> 8, tl = tid & 255, lane = tid & 63, wv = tl >> 6;
    const int kq = lane & 15, rloc = wv * 4 + (lane >> 4);
    const int fr = lane & 15, fq = lane >> 4;
    unsigned char* base = smem + dir * 67072;
    float* rL = (float*)base;
    float *kL = rL + 2048, *wL = kL + 2048, *bL = wL + 2048, *nkL = bL + 2048, *vL = nkL + 2048, *yL = vL + 1024;
    float* kdL = (float*)(base + 58880);
    bf16_t* twB = (bf16_t*)(yL + 1024);
    bf16_t* aloB = twB + 2048;
    float* invn = (float*)(aloB + 2048);
    const bf16_t* RW = (const bf16_t*)(p.ws + OFF_RW);
    bf16_t* P = (bf16_t*)(p.ws + OFF_PRW);
    const int cch = h * 64 + wv * 16 + fr;
    bf16x8 Bw[2], Ba[2];
    {
        const float* w2g = p.in[17] + ((size_t)(l * 2 + dir) * 64) * 512 + cch;
        const float* a2g = p.in[19] + ((size_t)l * 64) * 512 + cch;
#pragma unroll
        for (int kc = 0; kc < 2; ++kc)
#pragma unroll
            for (int e = 0; e < 8; ++e) {
                const int j = kc * 32 + fq * 8 + e;
                Bw[kc][e] = (short)f2bf(w2g[(size_t)j * 512]); Ba[kc][e] = (short)f2bf(a2g[(size_t)j * 512]);
            }
    }
    const float w0c = p.in[16][(l * 2 + dir) * 512 + cch], a0c = p.in[18][(l * 2 + dir) * 512 + cch];
    const float kkc = p.in[21][l * 512 + cch], kac = p.in[22][l * 512 + cch];
    const int t2 = tl >> 3, part2 = tl & 7;
    f32x4 kk2a = *(const f32x4*)(p.in[21] + l * 512 + h * 64 + part2 * 8), kk2b = *(const f32x4*)(p.in[21] + l * 512 + h * 64 + part2 * 8 + 4);
    float S[4];
#pragma unroll
    for (int i = 0; i < 4; ++i) S[i] = 0.f;
    u32x4 rv[5];
    int pf_off[5], pf_dst[5], pf_mode[5];
#pragma unroll
    for (int i = 0; i < 5; ++i) {
        const int e = tl + 256 * i; const int rr = e / 34, ch = e - rr * 34;
        const int col = ch < 8 ? h * 64 + ch * 8 : (ch < 16 ? 512 + h * 64 + (ch - 8) * 8 : (ch < 32 ? 1536 + (ch - 16) * 8 : 1024 + h * 64 + rq * 16 + (ch - 32) * 8));
        pf_off[i] = rr * 1792 + col;
        int dst, mode;
        if (ch < 8) { dst = (int)((unsigned char*)(rL + rr * 64 + ch * 8) - base); mode = 0; }
        else if (ch < 16) { dst = (int)((unsigned char*)(kL + rr * 64 + (ch - 8) * 8) - base); mode = 0; }
        else if (ch < 24) { dst = (int)((unsigned char*)(twB + rr * 64 + (ch - 16) * 8) - base); mode = 1; }
        else if (ch < 32) { dst = (int)((unsigned char*)(aloB + rr * 64 + (ch - 24) * 8) - base); mode = 1; }
        else { dst = (int)((unsigned char*)(vL + rr * 16 + (ch - 32) * 8) - base); mode = 0; }
        pf_dst[i] = dst; pf_mode[i] = (e < 32 * 34) ? mode : -1;
    }
#define RW_PREFETCH(tau_) do { int low_, s0_, s1_; bool ic_, fi_; scan_tile(b, dir, (tau_), low_, s0_, s1_, ic_, fi_); \
        const bf16_t* rb_ = RW + (size_t)low_ * 1792; \
        _Pragma("unroll") for (int i = 0; i < 5; ++i) { \
            rv[i] = (u32x4){0u, 0u, 0u, 0u}; \
            if (pf_mode[i] >= 0) rv[i] = *(const u32x4*)(rb_ + pf_off[i]); } } while (0)
    RW_PREFETCH(0);
    for (int tau = 0; tau < 264; ++tau) {
        int low, s0, s1; bool isctx, first;
        scan_tile(b, dir, tau, low, s0, s1, isctx, first);
#pragma unroll
        for (int i = 0; i < 5; ++i) {
            if (pf_mode[i] == 1) *(u32x4*)(base + pf_dst[i]) = rv[i];
            else if (pf_mode[i] == 0) {
                *(f32x4*)(base + pf_dst[i]) = (f32x4){bflo(rv[i].x), bfhi(rv[i].x), bflo(rv[i].y), bfhi(rv[i].y)};
                *(f32x4*)(base + pf_dst[i] + 16) = (f32x4){bflo(rv[i].z), bfhi(rv[i].z), bflo(rv[i].w), bfhi(rv[i].w)};
            }
        }
        bf16_t* pp = P + (size_t)(low + t2) * 512 + h * 64 + rq * 16 + part2 * 2;
        unsigned pv = 0u;
        if (!first) pv = *(const unsigned*)pp;
        __syncthreads();
        {
            const f32x4 ka = *(const f32x4*)(kL + t2 * 64 + part2 * 8), kb = *(const f32x4*)(kL + t2 * 64 + part2 * 8 + 4);
            const f32x4 pa = ka * kk2a, pb = kb * kk2b;
            float ss = pa.x * pa.x + pa.y * pa.y + pa.z * pa.z + pa.w * pa.w + pb.x * pb.x + pb.y * pb.y + pb.z * pb.z + pb.w * pb.w;
            ss = red8(ss);
            if (part2 == 0) { const float iv = __builtin_amdgcn_rcpf(fmaxf(sqrtf(ss), 1e-12f)); invn[t2] = iv * iv; }
        }
        f32x4 accw[2], acca[2];
#pragma unroll
        for (int mt = 0; mt < 2; ++mt) {
            accw[mt] = (f32x4){0.f, 0.f, 0.f, 0.f}; acca[mt] = (f32x4){0.f, 0.f, 0.f, 0.f};
#pragma unroll
            for (int kc = 0; kc < 2; ++kc) {
                const bf16x8 Aw = *(const bf16x8*)(twB + (mt * 16 + fr) * 64 + kc * 32 + fq * 8);
                const bf16x8 Aa = *(const bf16x8*)(aloB + (mt * 16 + fr) * 64 + kc * 32 + fq * 8);
                accw[mt] = __builtin_amdgcn_mfma_f32_16x16x32_bf16(Aw, Bw[kc], accw[mt], 0, 0, 0);
                acca[mt] = __builtin_amdgcn_mfma_f32_16x16x32_bf16(Aa, Ba[kc], acca[mt], 0, 0, 0);
            }
        }
#pragma unroll
        for (int mt = 0; mt < 2; ++mt)
#pragma unroll
            for (int r = 0; r < 4; ++r) {
                const int t = mt * 16 + fq * 4 + r, c = wv * 16 + fr;
                const float wl = w0c + accw[mt][r];
                const float decay = __expf(-0.6065306597f * sigmoidf_(wl));
                const float a = sigmoidf_(a0c + acca[mt][r]);
                const float kraw = kL[t * 64 + c];
                const float kk = kraw * kkc;
                wL[t * 64 + c] = decay;
                kdL[t * 64 + c] = kraw * (1.f + (a - 1.f) * kac);
                bL[t * 64 + c] = kk * a;
                nkL[t * 64 + c] = -kk;
            }
        __syncthreads();
        if (tau + 1 < 264) RW_PREFETCH(tau + 1);
        {
            const float* __restrict__ nkR = nkL + kq * 4; const float* __restrict__ wR = wL + kq * 4; const float* __restrict__ bR = bL + kq * 4;
            const float* __restrict__ kR = kdL + kq * 4; const float* __restrict__ rR = rL + kq * 4; const float* __restrict__ vR = vL + rloc;
            float* __restrict__ yW = yL + rloc;
            const int t0 = dir ? 31 : 0, dt = dir ? -1 : 1;
            f32x4 n0 = *(const f32x4*)(nkR + t0 * 64), wa = *(const f32x4*)(wR + t0 * 64), ba = *(const f32x4*)(bR + t0 * 64);
            f32x4 ka = *(const f32x4*)(kR + t0 * 64), ra = *(const f32x4*)(rR + t0 * 64);
            float vv = vR[t0 * 16], iv2 = invn[t0];
            f32x2_t S01 = {S[0], S[1]}, S23 = {S[2], S[3]};
            float yprev = 0.f; int tprev = t0;
#pragma unroll 2
            for (int j = 0; j < 32; ++j) {
                const int tt = t0 + dt * j;
                const int tn = (j < 31) ? tt + dt : tt;
                const f32x4 n0n = *(const f32x4*)(nkR + tn * 64), wan = *(const f32x4*)(wR + tn * 64), ban = *(const f32x4*)(bR + tn * 64);
                const f32x4 kan = *(const f32x4*)(kR + tn * 64), ran = *(const f32x4*)(rR + tn * 64);
                const float vvn = vR[tn * 16], iv2n = invn[tn];
                f32x2_t pp2 = S01 * (f32x2_t){n0.x, n0.y};
                pp2 = __builtin_elementwise_fma(S23, (f32x2_t){n0.z, n0.w}, pp2);
                float ra_ = pp2.x + pp2.y, rb_ = yprev;
                ra_ += dppf<0xB1>(ra_); rb_ += dppf<0xB1>(rb_);
                ra_ += dppf<0x4E>(ra_); rb_ += dppf<0x4E>(rb_);
                ra_ += dppf<0x141>(ra_); rb_ += dppf<0x141>(rb_);
                ra_ += dppf<0x140>(ra_); rb_ += dppf<0x140>(rb_);
                if (kq == 0 && j > 0) yW[tprev * 16] = rb_;
                const float sa = ra_ * iv2;
                const f32x2_t sav = {sa, sa}, vvv = {vv, vv};
                f32x2_t t01 = vvv * (f32x2_t){ka.x, ka.y}, t23 = vvv * (f32x2_t){ka.z, ka.w};
                t01 = __builtin_elementwise_fma(sav, (f32x2_t){ba.x, ba.y}, t01);
                t23 = __builtin_elementwise_fma(sav, (f32x2_t){ba.z, ba.w}, t23);
                S01 = __builtin_elementwise_fma(S01, (f32x2_t){wa.x, wa.y}, t01);
                S23 = __builtin_elementwise_fma(S23, (f32x2_t){wa.z, wa.w}, t23);
                f32x2_t qq = S01 * (f32x2_t){ra.x, ra.y};
                qq = __builtin_elementwise_fma(S23, (f32x2_t){ra.z, ra.w}, qq);
                yprev = qq.x + qq.y; tprev = tt;
                n0 = n0n; wa = wan; ba = ban; ka = kan; ra = ran; vv = vvn; iv2 = iv2n;
            }
            { const float y = red16(yprev); if (kq == 0) yW[tprev * 16] = y; }
            S[0] = S01.x; S[1] = S01.y; S[2] = S23.x; S[3] = S23.y;
        }
        __syncthreads();
        {
            const float y0 = yL[t2 * 16 + part2 * 2], y1 = yL[t2 * 16 + part2 * 2 + 1];
            *(unsigned*)pp = pk2(bflo(pv) + y0, bfhi(pv) + y1);
        }
        if (tau == 3 || tau == 135) __syncthreads();
    }
#undef RW_PREFETCH
}

__device__ __forceinline__ void scan_phase(CParams& p, int l, unsigned char* smem) {
    for (int it = blockIdx.x; it < 224; it += gridDim.x) {
        const int xcd = it & 7;
        if (it < 128) { const int j = it >> 3;
            rwkv_scan_item(p, l, ((xcd * 4 + (j >> 2)) << 2) | (j & 3), smem); }
        else if (it < 192) { const int j = (it - 128) >> 3;
            ssd_scan_item(p, l, ((xcd >> 1) << 4) | ((xcd & 1) << 3) | j, smem); }
        else { const int j = (it - 192) >> 3;
            ret_scan_item(p, l, ((xcd >> 1) << 3) | ((((xcd & 1) << 1) | (j >> 1)) << 1) | (j & 1), smem); }
        __syncthreads();
    }
    int cb = (int)blockIdx.x - 224, cn = (int)gridDim.x - 224;
    if (cn <= 0) { cb = blockIdx.x; cn = gridDim.x; }
    if (cb >= 0) cvt_mix(p, l, smem, cb, cn);
}

__device__ __forceinline__ void post_phase(CParams& p_in, int l_in, int nrows, unsigned char* smem) {
    CParams* pq_ = &p_in; asm volatile("" : "+s"(pq_)); CParams& p = *pq_;
    int l = l_in; asm volatile("" : "+s"(l));
    const int tidx = opaque_tid();
    const int lane = tidx & 63, gw = blockIdx.x * 8 + (tidx >> 6), ngw = gridDim.x * 8;
    unsigned char* ws = p.ws;
    const float* MOD = (const float*)(ws + OFF_MOD);
    for (int row = gw; row < nrows; row += ngw) {
        {
            const bf16_t* yp = (const bf16_t*)(ws + OFF_H) + (size_t)row * 1024 + lane * 16;
            bf16_t* zp = (bf16_t*)(ws + OFF_Z) + (size_t)row * 1024 + lane * 16;
            const float* nw = p.in[13] + (size_t)l * 1024 + lane * 16;
            float v[16]; float ss = 0.f;
#pragma unroll
            for (int q = 0; q < 2; ++q) {
                const u32x4 yr = *(const u32x4*)(yp + q * 8), zr = *(const u32x4*)(zp + q * 8);
                const unsigned ya[4] = {yr.x, yr.y, yr.z, yr.w}, za[4] = {zr.x, zr.y, zr.z, zr.w};
#pragma unroll
                for (int e = 0; e < 4; ++e) {
                    const float y0 = bflo(ya[e]), y1 = bfhi(ya[e]), z0 = bflo(za[e]), z1 = bfhi(za[e]);
                    const float a = y0 * siluf_(z0), c = y1 * siluf_(z1);
                    v[q * 8 + e * 2] = a; v[q * 8 + e * 2 + 1] = c; ss += a * a + c * c;
                }
            }
            ss = red16(ss); ss += __shfl_xor(ss, 16);
            const float rs = rsqrtf(ss * (1.f / 512.f) + 1e-6f);
#pragma unroll
            for (int q = 0; q < 2; ++q) {
                const f32x4 wa = *(const f32x4*)(nw + q * 8), wb = *(const f32x4*)(nw + q * 8 + 4);
                u32x4 o;
                o.x = pk2(v[q * 8 + 0] * rs * wa.x, v[q * 8 + 1] * rs * wa.y); o.y = pk2(v[q * 8 + 2] * rs * wa.z, v[q * 8 + 3] * rs * wa.w);
                o.z = pk2(v[q * 8 + 4] * rs * wb.x, v[q * 8 + 5] * rs * wb.y); o.w = pk2(v[q * 8 + 6] * rs * wb.z, v[q * 8 + 7] * rs * wb.w);
                *(u32x4*)(zp + q * 8) = o;
            }
        }
        {
            const bf16_t* yp = (const bf16_t*)(ws + OFF_PRET) + (size_t)row * 512 + lane * 8;
            bf16_t* gp = (bf16_t*)(ws + OFF_G) + (size_t)row * 512 + lane * 8;
            const u32x4 yr = *(const u32x4*)yp, gr = *(const u32x4*)gp;
            const unsigned ya[4] = {yr.x, yr.y, yr.z, yr.w}, ga[4] = {gr.x, gr.y, gr.z, gr.w};
            float v[8], gg[8]; float s = 0.f;
#pragma unroll
            for (int e = 0; e < 4; ++e) { v[2 * e] = bflo(ya[e]); v[2 * e + 1] = bfhi(ya[e]); gg[2 * e] = bflo(ga[e]); gg[2 * e + 1] = bfhi(ga[e]); s += v[2 * e] + v[2 * e + 1]; }
            s = red16(s);
            const float mean = s * (1.f / 128.f); float q2 = 0.f;
#pragma unroll
            for (int e = 0; e < 8; ++e) { v[e] -= mean; q2 += v[e] * v[e]; }
            q2 = red16(q2);
            const float rs = rsqrtf(q2 * (1.f / 128.f) + 1e-6f);
            u32x4 o;
            o.x = pk2(v[0] * rs * siluf_(gg[0]), v[1] * rs * siluf_(gg[1])); o.y = pk2(v[2] * rs * siluf_(gg[2]), v[3] * rs * siluf_(gg[3]));
            o.z = pk2(v[4] * rs * siluf_(gg[4]), v[5] * rs * siluf_(gg[5])); o.w = pk2(v[6] * rs * siluf_(gg[6]), v[7] * rs * siluf_(gg[7]));
            *(u32x4*)gp = o;
        }
        {
            const bool lat = row < RL; const int mi = lat ? (row >> 13) : 4;
            const float* xin;
            if (lat) xin = (l == 0) ? p.in[0] + (size_t)row * 1024 : p.out + (size_t)row * 1024;
            else xin = (l == 0) ? p.in[2] + (size_t)(row - RL) * 1024 : (const float*)(ws + OFF_CTXS) + (size_t)(row - RL) * 1024;
            const float* modl = MOD + (size_t)(l * 5 + mi) * 6144;
            row_pass(xin, nullptr, nullptr, nullptr, nullptr, true, p.in[4] + (l * 4 + 0) * 1024, modl, modl + 1024, (bf16_t*)(ws + OFF_XBC) + (size_t)row * 1024, lane);
        }
    }
    bf16_t* aB = (bf16_t*)smem;
    bf16_t* gB = aB + 32 * 72;
    float* asL = (float*)(smem + 13312);
    float* gsL = asL + 32 * 512;
    const bf16_t* RW = (const bf16_t*)(ws + OFF_RW);
    bf16_t* P = (bf16_t*)(ws + OFF_PRW);
    const float* mix = p.in[15] + (size_t)l * 1792;
    const int c = tidx;
    const float a0f = p.in[18][(l * 2 + 0) * 512 + c], a0b = p.in[18][(l * 2 + 1) * 512 + c];
    const float kac = p.in[22][l * 512 + c], rkc = p.in[23][l * 512 + c], lw = p.in[24][l * 512 + c], lb = p.in[25][l * 512 + c];
    const float mxr = mix[c], mxk = mix[512 + c], mxv = mix[1024 + c];
    const int wvB = tidx >> 6, frB = lane & 15, fqB = lane >> 4;
    const float* a2 = p.in[19] + (size_t)l * 64 * 512 + wvB * 64 + frB;
    const float* g2 = p.in[20] + (size_t)l * 128 * 512 + wvB * 64 + frB;
    for (int tile = blockIdx.x; tile < nrows / 32; tile += gridDim.x) {
        const int low = tile * 32;
        int s0, s1;
        if (low < RL) { s0 = low & ~8191; s1 = s0 + 8192; } else { s0 = RL + ((low - RL) & ~255); s1 = s0 + 256; }
        {
            for (int e = tidx; e < 32 * 24; e += 512) {
                const int t = e / 24, ch = e - t * 24;
                const u32x4 v = *(const u32x4*)(RW + (size_t)(low + t) * 1792 + 1600 + ch * 8);
                if (ch < 8) *(u32x4*)(aB + t * 72 + ch * 8) = v; else *(u32x4*)(gB + t * 136 + (ch - 8) * 8) = v;
            }
        }
        __syncthreads();
        {
            bf16x8 Aa[2][2], Ag[2][4];
#pragma unroll
            for (int mt = 0; mt < 2; ++mt) {
#pragma unroll
                for (int kc = 0; kc < 2; ++kc) Aa[mt][kc] = *(const bf16x8*)(aB + (mt * 16 + frB) * 72 + kc * 32 + fqB * 8);
#pragma unroll
                for (int kc = 0; kc < 4; ++kc) Ag[mt][kc] = *(const bf16x8*)(gB + (mt * 16 + frB) * 136 + kc * 32 + fqB * 8);
            }
#pragma unroll 1
            for (int nt = 0; nt < 4; ++nt) {
                bf16x8 ba[2], bg[4];
#pragma unroll
                for (int kc = 0; kc < 2; ++kc)
#pragma unroll
                    for (int e = 0; e < 8; ++e) ba[kc][e] = (short)f2bf(a2[(size_t)(kc * 32 + fqB * 8 + e) * 512 + nt * 16]);
#pragma unroll
                for (int kc = 0; kc < 4; ++kc)
#pragma unroll
                    for (int e = 0; e < 8; ++e) bg[kc][e] = (short)f2bf(g2[(size_t)(kc * 32 + fqB * 8 + e) * 512 + nt * 16]);
#pragma unroll
                for (int mt = 0; mt < 2; ++mt) {
                    f32x4 ca = (f32x4){0.f, 0.f, 0.f, 0.f}, cg = (f32x4){0.f, 0.f, 0.f, 0.f};
#pragma unroll
                    for (int kc = 0; kc < 2; ++kc) ca = __builtin_amdgcn_mfma_f32_16x16x32_bf16(Aa[mt][kc], ba[kc], ca, 0, 0, 0);
#pragma unroll
                    for (int kc = 0; kc < 4; ++kc) cg = __builtin_amdgcn_mfma_f32_16x16x32_bf16(Ag[mt][kc], bg[kc], cg, 0, 0, 0);
#pragma unroll
                    for (int r = 0; r < 4; ++r) {
                        const int idx = (mt * 16 + fqB * 4 + r) * 512 + wvB * 64 + nt * 16 + frB;
                        asL[idx] = ca[r]; gsL[idx] = cg[r];
                    }
                }
            }
        }
        __syncthreads();
        const bf16_t* u = RW + (size_t)low * 1792;
#pragma unroll 1
        for (int tb = 0; tb < 32; tb += 8) {
            bf16_t rr[8], kk8[8], vv8[8], yy[8];
#pragma unroll
            for (int i = 0; i < 8; ++i) {
                const bf16_t* un = u + (size_t)(tb + i) * 1792;
                rr[i] = un[c]; kk8[i] = un[512 + c]; vv8[i] = un[1024 + c]; yy[i] = P[(size_t)(low + tb + i) * 512 + c];
            }
#pragma unroll
            for (int i = 0; i < 8; ++i) {
                const int row = low + tb + i;
                const float r = bf2f(rr[i]), k = bf2f(kk8[i]), v = bf2f(vv8[i]), y = bf2f(yy[i]);
                const float ash = asL[(tb + i) * 512 + c];
                const float af = sigmoidf_(a0f + ash), ab = sigmoidf_(a0b + ash);
                const float ks = k * (2.f + (af + ab - 2.f) * kac);
                const float bsum = wave_sum(r * ks * rkc);
                const float mean = wave_sum(y) * (1.f / 64.f);
                const float d = y - mean;
                const float var = wave_sum(d * d) * (1.f / 64.f);
                const float yn = d * rsqrtf(var + 64e-5f) * lw + lb;
                P[(size_t)row * 512 + c] = f2bf((yn + bsum * v) * gsL[(tb + i) * 512 + c]);
            }
        }
        __syncthreads();
    }
}

__device__ __forceinline__ void flat_barrier(unsigned* cnt, unsigned target) {
    asm volatile("s_waitcnt vmcnt(0)" ::: "memory");
    __syncthreads();
    if (threadIdx.x == 0) {
        __builtin_amdgcn_fence(__ATOMIC_RELEASE, "agent");
        asm volatile("s_waitcnt vmcnt(0)" ::: "memory");
        __hip_atomic_fetch_add(cnt, 1u, __ATOMIC_RELAXED, __HIP_MEMORY_SCOPE_AGENT);
        while (__hip_atomic_load(cnt, __ATOMIC_RELAXED, __HIP_MEMORY_SCOPE_AGENT) < target) __builtin_amdgcn_s_sleep(1);
        __builtin_amdgcn_fence(__ATOMIC_ACQUIRE, "agent");
        asm volatile("s_waitcnt vmcnt(0)" ::: "memory");
    }
    __syncthreads();
}

__global__ void __launch_bounds__(512) mega(Params p_arg) {
    extern __shared__ __attribute__((aligned(16))) unsigned char smem[];
    CParams* pbase = (CParams*)__builtin_amdgcn_kernarg_segment_ptr();
    const int ph_lo = p_arg.ph_lo, ph_hi = p_arg.ph_hi;
    for (int ph = ph_lo; ph < ph_hi; ++ph) {
        CParams* pq = pbase;
        asm volatile("" : "+s"(pq));
        CParams& p = *pq;
        int gm = -1, l = 0, sub = -1;
        if (ph >= 2) { l = (ph - 2) / 11; sub = (ph - 2) % 11; }
        const int nrows = (l == 3) ? RL : R;
        if (sub == 0) gm = GM_IN; else if (sub == 5) gm = GM_MERGE; else if (sub == 6) gm = GM_OUT; else if (sub == 8) gm = GM_MLP1; else if (sub == 9) gm = GM_MLP2;
        if (gm >= 0) {
            gemm_phase(p, gm, gm == GM_IN ? 132 : nrows / 256, (LAS unsigned char*)smem);
            __syncthreads();
        } else if (ph == 0) {
            phase_mod(p, smem);
            cvt_win(p, 0, smem, blockIdx.x, gridDim.x);
        } else if (ph == 1) {
            token_phase(p, 0, 0, R);
        } else if (sub == 1) {
            shift_phase(p, l, 0, smem);
        } else if (sub == 2) {
            shift_phase(p, l, 1, smem);
        } else if (sub == 3) {
            scan_phase(p, l, smem);
        } else if (sub == 4) {
            post_phase(p, l, nrows, smem);
        } else if (sub == 7) {
            token_phase(p, l, 1, nrows);
            cvt_mlp(p, l, smem, blockIdx.x, gridDim.x);
        } else if (sub == 10) {
            token_phase(p, l, 2, nrows);
            if (l < 3) cvt_win(p, l + 1, smem, blockIdx.x, gridDim.x);
        }
        if (ph + 1 < ph_hi) {
            if (ph == ph_lo) { __threadfence(); cg::this_grid().sync(); }
            else flat_barrier((unsigned*)(p_arg.ws + OFF_BAR), (unsigned)(ph - ph_lo) * gridDim.x);
        }
    }
}

extern "C" void kernel_launch(void* const* d_in, const int* in_sizes, int n_in, void* d_out, int out_size, void* d_ws, size_t ws_size, hipStream_t stream) {
    static int grid = 0;
    if (grid == 0) {
        if (n_in != 32 || ws_size < WS_END) { fprintf(stderr, "kernel_launch: bad n_in %d or ws %zu < %zu\n", n_in, ws_size, (size_t)WS_END); grid = -1; return; }
        if (hipFuncSetAttribute((const void*)mega, hipFuncAttributeMaxDynamicSharedMemorySize, LDS_BYTES) != hipSuccess) { grid = -1; return; }
        int dev = 0, cus = 0, per_cu = 0;
        hipGetDevice(&dev);
        hipDeviceGetAttribute(&cus, hipDeviceAttributeMultiprocessorCount, dev);
        hipOccupancyMaxActiveBlocksPerMultiprocessor(&per_cu, (const void*)mega, 512, LDS_BYTES);
        (void)hipGetLastError();
        if (per_cu < 1) per_cu = 1;
        grid = cus * per_cu; if (grid > 256) grid = 256;
    }
    if (grid < 0) return;
    Params p{};
    for (int i = 0; i < 32; ++i) p.in[i] = (const float*)d_in[i];
    p.out = (float*)d_out; p.ws = (unsigned char*)d_ws;
    p.ph_lo = 0; p.ph_hi = NPH; p.coop = 1; p.pad = 0;
    if (hipMemsetAsync((char*)d_ws + OFF_BAR, 0, 64, stream) != hipSuccess) return;
    void* args[] = {&p};
    hipError_t e = hipLaunchCooperativeKernel((const void*)mega, dim3(grid), dim3(512), args, LDS_BYTES, stream);
    if (e != hipSuccess) fprintf(stderr, "cooperative launch failed: %s (grid %d)\n", hipGetErrorString(e), grid);
}
```

```cpp
#include <hip/hip_runtime.h>
#include <hip/hip_cooperative_groups.h>
#include <cstdint>
#include <cstdio>
namespace cg = cooperative_groups;

typedef unsigned short bf16_t;
typedef short bf16x8 __attribute__((ext_vector_type(8)));
typedef float f32x4 __attribute__((ext_vector_type(4)));
typedef unsigned u32x2 __attribute__((ext_vector_type(2)));
typedef unsigned u32x4 __attribute__((ext_vector_type(4)));

constexpr int RL = 32768;
constexpr int RC = 1024;
constexpr int R = RL + RC;
constexpr int LDS_BYTES = 153600;
constexpr int NPH = 2 + 11 * 4;
#ifndef PROBE_SCAN
#define PROBE_SCAN 0
#endif
#ifndef PROBE_GEMM
#define PROBE_GEMM 0
#endif

constexpr size_t OFF_MOD = 0;
constexpr size_t OFF_BAR = 491776;
constexpr size_t OFF_CTXS = 524288;
constexpr size_t OFF_DT = OFF_CTXS + 4194304;
constexpr size_t OFF_W = OFF_DT + (size_t)R * 32 * 4;
constexpr size_t OFF_H = OFF_W + 16777216;
constexpr size_t SZ1024 = (size_t)R * 1024 * 2;
constexpr size_t OFF_Z = OFF_H + SZ1024;
constexpr size_t OFF_XBC = OFF_Z + SZ1024;
constexpr size_t OFF_QKV = OFF_XBC + (size_t)R * 1536 * 2;
constexpr size_t OFF_G = OFF_QKV + SZ1024;
constexpr size_t OFF_RW = OFF_G + (size_t)R * 512 * 2;
constexpr size_t OFF_PRET = OFF_RW + (size_t)R * 1792 * 2;
constexpr size_t OFF_PRW = OFF_PRET + (size_t)R * 512 * 2;
constexpr size_t WS_END = OFF_PRW + (size_t)R * 512 * 2;
constexpr size_t W_G = 0, W_SO = 6291456, W_RO = 8388608, W_WO = 9437184, W_O = 10485760;
constexpr size_t W_1 = 0, W_2 = 8388608;
constexpr size_t MSCR_S = 0, MSCR_M = (size_t)256 * 131072;

struct Params {
    const float* in[32];
    float* out;
    unsigned char* ws;
    int ph_lo, ph_hi, coop, pad;
};

typedef const __attribute__((address_space(4))) Params CParams;

__device__ __forceinline__ float bf2f(bf16_t h) { return __uint_as_float(((unsigned)h) << 16); }
__device__ __forceinline__ float bflo(unsigned u) { return __uint_as_float(u << 16); }
__device__ __forceinline__ float bfhi(unsigned u) { return __uint_as_float(u & 0xffff0000u); }
typedef float f32x2_t __attribute__((ext_vector_type(2)));
typedef __bf16 bf16x2_t __attribute__((ext_vector_type(2)));
__device__ __forceinline__ unsigned pk2(float a, float b) { const f32x2_t v = {a, b}; const bf16x2_t r = __builtin_convertvector(v, bf16x2_t); return __builtin_bit_cast(unsigned, r); }
__device__ __forceinline__ bf16_t f2bf(float f) { const __bf16 r = (__bf16)f; return __builtin_bit_cast(unsigned short, r); }
template <int CTRL> __device__ __forceinline__ float dppf(float v) {
    return __builtin_bit_cast(float, __builtin_amdgcn_update_dpp(0, __builtin_bit_cast(int, v), CTRL, 0xf, 0xf, true));
}
__device__ __forceinline__ float red4(float v) { v += dppf<0xB1>(v); v += dppf<0x4E>(v); return v; }
__device__ __forceinline__ float red8(float v) { v = red4(v); v += dppf<0x141>(v); return v; }
__device__ __forceinline__ float red16(float v) { v = red8(v); v += dppf<0x140>(v); return v; }
__device__ __forceinline__ float wave_sum(float v) { v = red16(v); v += __shfl_xor(v, 16); v += __shfl_xor(v, 32); return v; }
__device__ __forceinline__ int opaque_tid() { int t = threadIdx.x; asm volatile("" : "+v"(t)); return t; }
__device__ __forceinline__ float sigmoidf_(float x) { return __builtin_amdgcn_rcpf(1.f + __expf(-x)); }
__device__ __forceinline__ float siluf_(float x) { return x * __builtin_amdgcn_rcpf(1.f + __expf(-x)); }
__device__ __forceinline__ float fast_tanh(float x) { return 1.f - 2.f * __builtin_amdgcn_rcpf(1.f + __expf(2.f * x)); }
__device__ __forceinline__ float fast_softplus(float x) { return x > 20.f ? x : __logf(1.f + __expf(x)); }
__device__ __forceinline__ float softplusf_(float x) { return x > 20.f ? x : log1pf(__expf(x)); }

constexpr int BK = 64, HALF = 128, HT = HALF * BK;
__device__ __forceinline__ int lds_byte(int r, int c) {
    int st = (r >> 4) * 2 + (c >> 5), rr = r & 15, cc = c & 31, ob = rr * 64 + cc * 2;
    return st * 1024 + (ob ^ (((ob >> 9) & 1) << 5));
}
__device__ __forceinline__ void stage_rc(int b, int& Rr, int& Cc) {
    int st = b / 1024, sb = b % 1024, swz = sb ^ (((sb >> 9) & 1) << 5);
    Rr = (st >> 1) * 16 + swz / 64; Cc = (st & 1) * 32 + (swz % 64) / 2;
}

#define LAS __attribute__((address_space(3)))
constexpr int HTB = HALF * BK * 2;

__device__ __forceinline__ bool tile_next(int i, int G, int c, int nM, int nN, int& pm, int& pn) {
    const int nwg = nM * nN;
    const long L = (long)i * G + c; if (L >= nwg) return false;
    int wgid = (int)L; { const int q = nwg / 8, r = nwg % 8, xcd = wgid % 8, off = wgid / 8; wgid = (xcd < r ? xcd * (q + 1) : r * (q + 1) + (xcd - r) * q) + off; }
    const int nig = 8 * nN, gid = wgid / nig, fm = gid * 8, gsz = (nM - fm) < 8 ? (nM - fm) : 8;
    pm = fm + ((wgid % nig) % gsz); pn = (wgid % nig) / gsz; return true;
}

enum { GM_IN = 0, GM_MERGE = 1, GM_OUT = 2, GM_MLP1 = 3, GM_MLP2 = 4 };
struct UnitInfo { const char* A; const char* B; int K, wt, mt, step; };

__device__ __forceinline__ bool get_unit(unsigned char* ws, int mode, int n_mt, int n_wt, int nsteps, int ui, UnitInfo& u) {
    const int it = ui / nsteps, step = ui - it * nsteps;
    int mt, wt;
    if (!tile_next(it, gridDim.x, blockIdx.x, n_mt, n_wt, mt, wt)) return false;
    const size_t tok0 = (size_t)mt * 256;
    const bf16_t* Aw; const bf16_t* Bact; int K = 1024;
    if (mode == GM_IN) { Aw = (const bf16_t*)(ws + OFF_W) + (size_t)wt * 256 * 1024; Bact = (const bf16_t*)(ws + OFF_H) + tok0 * 1024; }
    else if (mode == GM_OUT) { Aw = (const bf16_t*)(ws + OFF_W + W_O) + (size_t)wt * 256 * 1024; Bact = (const bf16_t*)(ws + OFF_QKV) + tok0 * 1024; }
    else if (mode == GM_MLP1) { Aw = (const bf16_t*)(ws + OFF_W + W_1) + (size_t)wt * 256 * 1024; Bact = (const bf16_t*)(ws + OFF_H) + tok0 * 1024; }
    else if (mode == GM_MLP2) { K = 4096; Aw = (const bf16_t*)(ws + OFF_W + W_2) + (size_t)wt * 256 * 4096; Bact = (const bf16_t*)(ws + OFF_Z) + tok0 * 4096; }
    else {
        const int k = step >> 1;
        if ((step & 1) == 0) { Aw = (const bf16_t*)(ws + OFF_W + W_G) + ((size_t)k * 1024 + (size_t)wt * 256) * 1024; Bact = (const bf16_t*)(ws + OFF_XBC) + tok0 * 1024; }
        else if (k == 0) { Aw = (const bf16_t*)(ws + OFF_W + W_SO) + (size_t)wt * 256 * 1024; Bact = (const bf16_t*)(ws + OFF_Z) + tok0 * 1024; }
        else if (k == 1) { K = 512; Aw = (const bf16_t*)(ws + OFF_W + W_RO) + (size_t)wt * 256 * 512; Bact = (const bf16_t*)(ws + OFF_G) + tok0 * 512; }
        else { K = 512; Aw = (const bf16_t*)(ws + OFF_W + W_WO) + (size_t)wt * 256 * 512; Bact = (const bf16_t*)(ws + OFF_PRW) + tok0 * 512; }
    }
    u.A = (const char*)Bact; u.B = (const char*)Aw; u.K = K; u.wt = wt; u.mt = mt; u.step = step;
    return true;
}

__device__ __forceinline__ void gemm_epilogue(unsigned char* ws, int mode, const UnitInfo& u, const f32x4 (&acc)[2][2][4][2], int wr, int wc, int fr, int fq, int tidx) {
    const size_t tok0 = (size_t)u.mt * 256; const int wt = u.wt, step = u.step;
    if (mode == GM_MERGE) {
        u32x4* sp = (u32x4*)(ws + OFF_RW + MSCR_S) + ((size_t)blockIdx.x * 8 * 512 + tidx) * 2;
        f32x4* mp = (f32x4*)(ws + OFF_RW + MSCR_M) + ((size_t)blockIdx.x * 8 * 512 + tidx) * 4;
        bf16_t* MG = (bf16_t*)(ws + OFF_QKV);
#pragma unroll
        for (int ai = 0; ai < 2; ++ai)
#pragma unroll
            for (int bj = 0; bj < 2; ++bj)
#pragma unroll
                for (int mh = 0; mh < 2; ++mh) {
                    if ((step & 1) == 0) {
                        unsigned o[8];
#pragma unroll
                        for (int k = 0; k < 4; ++k) {
                            const f32x4 v = acc[ai][bj][mh * 2 + (k >> 1)][k & 1];
                            o[2 * k] = pk2(sigmoidf_(v.x), sigmoidf_(v.y)); o[2 * k + 1] = pk2(sigmoidf_(v.z), sigmoidf_(v.w));
                        }
                        sp[0] = (u32x4){o[0], o[1], o[2], o[3]}; sp[1] = (u32x4){o[4], o[5], o[6], o[7]};
                    } else {
                        const u32x4 sa_ = sp[0], sb_ = sp[1];
                        const unsigned s8[8] = {sa_.x, sa_.y, sa_.z, sa_.w, sb_.x, sb_.y, sb_.z, sb_.w};
                        f32x4 m4[4];
                        if (step > 1) {
#pragma unroll
                            for (int k = 0; k < 4; ++k) m4[k] = mp[k];
                        }
#pragma unroll
                        for (int k = 0; k < 4; ++k) {
                            const int m = mh * 2 + (k >> 1), n = k & 1;
                            const f32x4 v = acc[ai][bj][m][n];
                            f32x4 mm = (f32x4){bflo(s8[2 * k]) * v.x, bfhi(s8[2 * k]) * v.y, bflo(s8[2 * k + 1]) * v.z, bfhi(s8[2 * k + 1]) * v.w};
                            if (step > 1) mm += m4[k];
                            if (step < 5) mp[k] = mm;
                            else {
                                const size_t tok = tok0 + ai * 128 + wr * 64 + m * 16 + fr;
                                const int feat = wt * 256 + bj * 128 + wc * 32 + fq * 8 + n * 4;
                                u32x2 o; o.x = pk2(mm.x, mm.y); o.y = pk2(mm.z, mm.w);
                                *(u32x2*)(MG + tok * 1024 + feat) = o;
                            }
                        }
                    }
                    sp += 512 * 2; mp += 512 * 4;
                    asm volatile("" : "+v"(sp), "+v"(mp) :: "memory");
                }
    } else if (mode == GM_IN && wt == 23) {
        float* DT = (float*)(ws + OFF_DT);
        if (wc == 0) {
#pragma unroll
            for (int ai = 0; ai < 2; ++ai)
#pragma unroll
                for (int m = 0; m < 4; ++m)
#pragma unroll
                    for (int n = 0; n < 2; ++n) {
                        const size_t tok = tok0 + ai * 128 + wr * 64 + m * 16 + fr;
                        *(f32x4*)(DT + tok * 32 + fq * 8 + n * 4) = acc[ai][0][m][n];
                    }
        }
    } else {
        bf16_t* base; int ld, col0;
        if (mode == GM_IN) {
            if (wt < 4) { base = (bf16_t*)(ws + OFF_Z); ld = 1024; col0 = wt * 256; }
            else if (wt < 10) { base = (bf16_t*)(ws + OFF_XBC); ld = 1536; col0 = (wt - 4) * 256; }
            else if (wt < 14) { base = (bf16_t*)(ws + OFF_QKV); ld = 1024; col0 = (wt - 10) * 256; }
            else if (wt < 16) { base = (bf16_t*)(ws + OFF_G); ld = 512; col0 = (wt - 14) * 256; }
            else { base = (bf16_t*)(ws + OFF_RW); ld = 1792; col0 = (wt - 16) * 256; }
        } else if (mode == GM_MLP1) { base = (bf16_t*)(ws + OFF_Z); ld = 4096; col0 = wt * 256; }
        else { base = (bf16_t*)(ws + OFF_H); ld = 1024; col0 = wt * 256; }
        const bool relu2 = (mode == GM_MLP1);
#pragma unroll
        for (int ai = 0; ai < 2; ++ai)
#pragma unroll
            for (int m = 0; m < 4; ++m) {
                const size_t tok = tok0 + ai * 128 + wr * 64 + m * 16 + fr;
                bf16_t* rowp = base + tok * ld + col0 + wc * 32 + fq * 8;
#pragma unroll
                for (int bj = 0; bj < 2; ++bj) {
                    f32x4 v = acc[ai][bj][m][0], w = acc[ai][bj][m][1];
                    if (relu2) { v.x = v.x > 0.f ? v.x * v.x : 0.f; v.y = v.y > 0.f ? v.y * v.y : 0.f; v.z = v.z > 0.f ? v.z * v.z : 0.f; v.w = v.w > 0.f ? v.w * v.w : 0.f;
                                 w.x = w.x > 0.f ? w.x * w.x : 0.f; w.y = w.y > 0.f ? w.y * w.y : 0.f; w.z = w.z > 0.f ? w.z * w.z : 0.f; w.w = w.w > 0.f ? w.w * w.w : 0.f; }
                    u32x4 o; o.x = pk2(v.x, v.y); o.y = pk2(v.z, v.w); o.z = pk2(w.x, w.y); o.w = pk2(w.z, w.w);
                    *(u32x4*)(rowp + bj * 128) = o;
                }
            }
    }
}

__device__ __forceinline__ void gemm_phase(CParams& p_in, const int mode, const int n_mt, LAS unsigned char* lds) {
    CParams* pq_ = &p_in; asm volatile("" : "+s"(pq_)); CParams& p = *pq_;
    const int tid = opaque_tid(), wid = __builtin_amdgcn_readfirstlane(tid >> 6), lane = tid & 63, wr = wid >> 2, wc = wid & 3, fr = lane & 15, fq = lane >> 4;
    unsigned char* ws = p.ws;
    int n_wt, nsteps = 1;
    if (mode == GM_IN) n_wt = 24; else if (mode == GM_MLP1) n_wt = 16; else n_wt = 4;
    if (mode == GM_MERGE) nsteps = 6;
    unsigned vR[2], vC[2];
#pragma unroll
    for (int i = 0; i < 2; ++i) { int Rr, Cc; stage_rc(tid * 16 + i * 8192, Rr, Cc); vR[i] = (unsigned)Rr * 2u; vC[i] = (unsigned)Cc * 2u; }
    const size_t kstep = (size_t)(BK * 2);
    const unsigned ldsw = (unsigned)wid * 1024u;
    const int aoff = lds_byte(wr * 64 + fr, fq * 8), boff = lds_byte(wc * 32 + fr, fq * 8);
#define PG8_SA(b, h) (((b) * 2 + (h)) * HTB)
#define PG8_SB(b, h) ((4 + (b) * 2 + (h)) * HTB)
#define PG8_STAGE(bufoff, gbase, v0, v1) do { \
        __builtin_amdgcn_global_load_lds((const unsigned*)((const char*)(gbase) + (v0)), (LAS unsigned*)(lds + (bufoff) + ldsw), 16, 0, 0); \
        __builtin_amdgcn_global_load_lds((const unsigned*)((const char*)(gbase) + (v1)), (LAS unsigned*)(lds + (bufoff) + ldsw + 8192), 16, 0, 0); } while (0)
#define PG8_LDA(dst, b, h) do { _Pragma("unroll") for (int m = 0; m < 4; ++m) _Pragma("unroll") for (int k = 0; k < 2; ++k) dst[m][k] = *(const LAS bf16x8*)(lds + PG8_SA(b, h) + aoff + m * 2048 + k * 1024); } while (0)
#define PG8_LDB(dst, b, h) do { _Pragma("unroll") for (int n = 0; n < 2; ++n) _Pragma("unroll") for (int k = 0; k < 2; ++k) dst[n][k] = *(const LAS bf16x8*)(lds + PG8_SB(b, h) + boff + n * 2048 + k * 1024); } while (0)
#define PG8_MMA(ai, bj, At, Bt) do { __builtin_amdgcn_s_setprio(1); _Pragma("unroll") for (int m = 0; m < 4; ++m) _Pragma("unroll") for (int n = 0; n < 2; ++n) _Pragma("unroll") for (int k = 0; k < 2; ++k) \
        acc[ai][bj][m][n] = __builtin_amdgcn_mfma_f32_16x16x32_bf16(Bt[n][k], At[m][k], acc[ai][bj][m][n], 0, 0, 0); __builtin_amdgcn_s_setprio(0); } while (0)
#define PG8_WAIT_V(n) asm volatile("s_waitcnt vmcnt(" #n ")" ::: "memory")
#define PG8_WAIT_L(n) asm volatile("s_waitcnt lgkmcnt(" #n ")" ::: "memory")
#define PG8_BAR __builtin_amdgcn_s_barrier()
#define PG8_SCHED __builtin_amdgcn_sched_barrier(0)
    UnitInfo cur, nxt; int ui = 0;
    if (!get_unit(ws, mode, n_mt, n_wt, nsteps, 0, cur)) return;
    f32x4 acc[2][2][4][2];
#pragma unroll
    for (int a = 0; a < 2; ++a)
#pragma unroll
        for (int b = 0; b < 2; ++b)
#pragma unroll
            for (int m = 0; m < 4; ++m)
#pragma unroll
                for (int n = 0; n < 2; ++n) acc[a][b][m][n] = (f32x4){0.f, 0.f, 0.f, 0.f};
    bf16x8 At[4][2], B0[2][2], B1[2][2];
    const char* cA = cur.A; const char* cB = cur.B;
    unsigned vc0 = vR[0] * (unsigned)cur.K + vC[0], vc1 = vR[1] * (unsigned)cur.K + vC[1];
    size_t hstep = (size_t)HALF * cur.K * 2;
    PG8_STAGE(PG8_SB(0, 0), cB, vc0, vc1); PG8_STAGE(PG8_SA(0, 0), cA, vc0, vc1); PG8_STAGE(PG8_SB(0, 1), cB + hstep, vc0, vc1); PG8_STAGE(PG8_SA(0, 1), cA + hstep, vc0, vc1);
    if (wr == 1) PG8_BAR;
    PG8_WAIT_V(4); PG8_BAR;
    PG8_STAGE(PG8_SB(1, 0), cB + kstep, vc0, vc1); PG8_STAGE(PG8_SA(1, 0), cA + kstep, vc0, vc1); PG8_STAGE(PG8_SB(1, 1), cB + hstep + kstep, vc0, vc1);
    PG8_WAIT_V(6); PG8_BAR;
    for (;;) {
        const bool has_next = get_unit(ws, mode, n_mt, n_wt, nsteps, ui + 1, nxt);
        const char* nA = has_next ? nxt.A : cA; const char* nB = has_next ? nxt.B : cB;
        const int Kn = has_next ? nxt.K : cur.K;
        const unsigned vn0 = vR[0] * (unsigned)Kn + vC[0], vn1 = vR[1] * (unsigned)Kn + vC[1];
        const size_t hstepn = (size_t)HALF * Kn * 2;
        const int nt = cur.K / BK;
        for (int t = 0; t < nt; t += 2) {
            const bool last = (t == nt - 2);
            const char* a1 = cA + (size_t)(t + 1) * kstep;
            const char* a2 = last ? nA : cA + (size_t)(t + 2) * kstep; const char* b2 = last ? nB : cB + (size_t)(t + 2) * kstep;
            const char* a3 = a2 + kstep; const char* b3 = b2 + kstep;
            const unsigned w0 = last ? vn0 : vc0, w1 = last ? vn1 : vc1;
            const size_t hs2 = last ? hstepn : hstep;
            PG8_LDB(B0, 0, 0); PG8_SCHED; PG8_LDA(At, 0, 0); PG8_STAGE(PG8_SA(1, 1), a1 + hstep, vc0, vc1);
            PG8_WAIT_L(8); PG8_BAR; PG8_WAIT_L(0); PG8_MMA(0, 0, At, B0); PG8_BAR; PG8_SCHED;
            PG8_LDB(B1, 0, 1); PG8_STAGE(PG8_SB(0, 0), b2, w0, w1);
            PG8_BAR; PG8_WAIT_L(0); PG8_MMA(0, 1, At, B1); PG8_BAR;
            PG8_LDA(At, 0, 1); PG8_STAGE(PG8_SA(0, 0), a2, w0, w1);
            PG8_BAR; PG8_WAIT_L(0); PG8_MMA(1, 0, At, B0); PG8_BAR; PG8_SCHED;
            PG8_STAGE(PG8_SB(0, 1), b2 + hs2, w0, w1);
            PG8_WAIT_V(6); PG8_BAR; PG8_MMA(1, 1, At, B1); PG8_BAR;
            PG8_LDB(B0, 1, 0); PG8_SCHED; PG8_LDA(At, 1, 0); PG8_STAGE(PG8_SA(0, 1), a2 + hs2, w0, w1);
            PG8_WAIT_L(8); PG8_BAR; PG8_WAIT_L(0); PG8_MMA(0, 0, At, B0); PG8_BAR; PG8_SCHED;
            PG8_LDB(B1, 1, 1); PG8_STAGE(PG8_SB(1, 0), b3, w0, w1);
            PG8_BAR; PG8_WAIT_L(0); PG8_MMA(0, 1, At, B1); PG8_BAR;
            PG8_LDA(At, 1, 1); PG8_STAGE(PG8_SA(1, 0), a3, w0, w1);
            PG8_BAR; PG8_WAIT_L(0); PG8_MMA(1, 0, At, B0); PG8_BAR; PG8_SCHED;
            PG8_STAGE(PG8_SB(1, 1), b3 + hs2, w0, w1);
            PG8_WAIT_V(6); PG8_BAR; PG8_MMA(1, 1, At, B1); PG8_BAR;
        }
        gemm_epilogue(ws, mode, cur, acc, wr, wc, fr, fq, tid);
        if (!has_next) break;
#pragma unroll
        for (int a = 0; a < 2; ++a)
#pragma unroll
            for (int b = 0; b < 2; ++b)
#pragma unroll
                for (int m = 0; m < 4; ++m)
#pragma unroll
                    for (int n = 0; n < 2; ++n) acc[a][b][m][n] = (f32x4){0.f, 0.f, 0.f, 0.f};
        cur = nxt; cA = nA; cB = nB; vc0 = vn0; vc1 = vn1; hstep = hstepn; ++ui;
    }
    PG8_WAIT_V(0);
    if (wr == 0) PG8_BAR;
    PG8_BAR;
}

__device__ __forceinline__ void phase_mod(CParams& p_in, unsigned char* smem) {
    CParams* pq_ = &p_in; asm volatile("" : "+s"(pq_)); CParams& p = *pq_;
    const int tidx = opaque_tid();
    float* sc = (float*)smem;
    float* red = sc + 5 * 1024;
    for (int i = tidx; i < 5 * 1024; i += 512) { int r = i >> 10, k = i & 1023; float v = r < 4 ? p.in[1][r * 1024 + k] : p.in[3][k]; sc[i] = siluf_(v); }
    __syncthreads();
    float* MOD = (float*)(p.ws + OFF_MOD);
    const int col = tidx & 63, kp = tidx >> 6;
    for (int item = blockIdx.x; item < 4 * 96; item += gridDim.x) {
        const int l = item / 96, n0 = (item % 96) * 64;
        const float* W = p.in[5] + (size_t)l * 1024 * 6144 + n0 + col;
        float a0 = 0.f, a1 = 0.f, a2 = 0.f, a3 = 0.f, a4 = 0.f;
        for (int k0 = kp * 128; k0 < kp * 128 + 128; k0 += 16) {
            float w[16];
#pragma unroll
            for (int j = 0; j < 16; ++j) w[j] = W[(size_t)(k0 + j) * 6144];
#pragma unroll
            for (int j = 0; j < 16; ++j) { const int k = k0 + j; a0 += sc[k] * w[j]; a1 += sc[1024 + k] * w[j]; a2 += sc[2048 + k] * w[j]; a3 += sc[3072 + k] * w[j]; a4 += sc[4096 + k] * w[j]; }
        }
        red[(kp * 5 + 0) * 64 + col] = a0; red[(kp * 5 + 1) * 64 + col] = a1; red[(kp * 5 + 2) * 64 + col] = a2;
        red[(kp * 5 + 3) * 64 + col] = a3; red[(kp * 5 + 4) * 64 + col] = a4;
        __syncthreads();
        if (tidx < 320) {
            const int r = tidx >> 6; float s = 0.f;
            for (int q = 0; q < 8; ++q) s += red[(q * 5 + r) * 64 + col];
            MOD[(size_t)(l * 5 + r) * 6144 + n0 + col] = s + p.in[6][l * 6144 + n0 + col];
        }
        __syncthreads();
    }
}

__device__ __forceinline__ void cvt_job(const float* W, int ldw, int col0, int ncols, int K, bf16_t* WT, int row0, unsigned char* smem, int cb, int cn) {
    const int tidx = opaque_tid();
    const int wave = tidx >> 6, lane = tidx & 63;
    float* scr = (float*)smem + wave * (64 * 33);
    const int nblk = ncols / 32, nitems = (K / 64) * nblk;
    for (int base = cb * 8; base < nitems; base += cn * 8) {
        const int it = base + wave; const bool valid = it < nitems;
        const int kb = valid ? it / nblk : 0, nb = valid ? it % nblk : 0, k0 = kb * 64, n0 = nb * 32;
        if (valid) {
#pragma unroll 8
            for (int i = 0; i < 32; ++i) { const int kk = 2 * i + (lane >> 5); scr[kk * 33 + (lane & 31)] = W[(size_t)(k0 + kk) * ldw + col0 + n0 + (lane & 31)]; }
        }
        __syncthreads();
        if (valid) {
            const int c = lane & 7;
#pragma unroll
            for (int j = 0; j < 4; ++j) {
                const int n = (lane >> 3) + 8 * j; const float* s = scr + (8 * c) * 33 + n;
                u32x4 o; o.x = pk2(s[0], s[33]); o.y = pk2(s[66], s[99]); o.z = pk2(s[132], s[165]); o.w = pk2(s[198], s[231]);
                const int rho = ((n >> 2) & 1) * 16 + (n >> 3) * 4 + (n & 3);
                *(u32x4*)(WT + (size_t)(row0 + n0 + rho) * K + k0 + 8 * c) = o;
            }
        }
        __syncthreads();
    }
}
__device__ __forceinline__ void cvt_win(CParams& p_in, int l_in, unsigned char* smem, int cb, int cn) {
    CParams* pq_ = &p_in; asm volatile("" : "+s"(pq_)); CParams& p = *pq_;
    int l = l_in; asm volatile("" : "+s"(l));
    const float* W = p.in[7] + (size_t)l * 1024 * 8992; bf16_t* WB = (bf16_t*)(p.ws + OFF_W);
    cvt_job(W, 8992, 3072, 2560, 1024, WB, 0, smem, cb, cn);
    cvt_job(W, 8992, 5664, 3328, 1024, WB, 2560, smem, cb, cn);
    cvt_job(W, 8992, 5632, 256, 1024, WB, 5888, smem, cb, cn);
}
__device__ __forceinline__ void cvt_mix(CParams& p_in, int l_in, unsigned char* smem, int cb, int cn) {
    CParams* pq_ = &p_in; asm volatile("" : "+s"(pq_)); CParams& p = *pq_;
    int l = l_in; asm volatile("" : "+s"(l));
    cvt_job(p.in[7] + (size_t)l * 1024 * 8992, 8992, 0, 3072, 1024, (bf16_t*)(p.ws + OFF_W + W_G), 0, smem, cb, cn);
    cvt_job(p.in[26] + (size_t)l * 1024 * 1024, 1024, 0, 1024, 1024, (bf16_t*)(p.ws + OFF_W + W_SO), 0, smem, cb, cn);
    cvt_job(p.in[27] + (size_t)l * 512 * 1024, 1024, 0, 1024, 512, (bf16_t*)(p.ws + OFF_W + W_RO), 0, smem, cb, cn);
    cvt_job(p.in[28] + (size_t)l * 512 * 1024, 1024, 0, 1024, 512, (bf16_t*)(p.ws + OFF_W + W_WO), 0, smem, cb, cn);
    cvt_job(p.in[29] + (size_t)l * 1024 * 1024, 1024, 0, 1024, 1024, (bf16_t*)(p.ws + OFF_W + W_O), 0, smem, cb, cn);
}
__device__ __forceinline__ void cvt_mlp(CParams& p_in, int l_in, unsigned char* smem, int cb, int cn) {
    CParams* pq_ = &p_in; asm volatile("" : "+s"(pq_)); CParams& p = *pq_;
    int l = l_in; asm volatile("" : "+s"(l));
    cvt_job(p.in[30] + (size_t)l * 1024 * 4096, 4096, 0, 4096, 1024, (bf16_t*)(p.ws + OFF_W + W_1), 0, smem, cb, cn);
    cvt_job(p.in[31] + (size_t)l * 4096 * 1024, 1024, 0, 1024, 4096, (bf16_t*)(p.ws + OFF_W + W_2), 0, smem, cb, cn);
}

__device__ __forceinline__ void row_pass(const float* xrow, const bf16_t* yrow, const float* gate, const float* nwA, float* xout,
                                         bool do_h, const float* nwB, const float* sh, const float* sc, bf16_t* hrow, int lane) {
    f32x4 x[4];
#pragma unroll
    for (int j = 0; j < 4; ++j) x[j] = *(const f32x4*)(xrow + j * 256 + lane * 4);
    u32x2 yraw[4]; f32x4 gw[4];
    if (yrow) {
#pragma unroll
        for (int j = 0; j < 4; ++j) yraw[j] = *(const u32x2*)(yrow + j * 256 + lane * 4);
#pragma unroll
        for (int j = 0; j < 4; ++j) gw[j] = *(const f32x4*)(gate + j * 256 + lane * 4) * *(const f32x4*)(nwA + j * 256 + lane * 4);
    }
    f32x4 hm[4], hs[4];
    if (do_h) {
#pragma unroll
        for (int j = 0; j < 4; ++j) {
            hm[j] = *(const f32x4*)(nwB + j * 256 + lane * 4) * (*(const f32x4*)(sc + j * 256 + lane * 4) + 1.f);
            hs[j] = *(const f32x4*)(sh + j * 256 + lane * 4);
        }
    }
    if (yrow) {
        f32x4 y[4]; float ss = 0.f;
#pragma unroll
        for (int j = 0; j < 4; ++j) {
            y[j] = (f32x4){bflo(yraw[j].x), bfhi(yraw[j].x), bflo(yraw[j].y), bfhi(yraw[j].y)};
            ss += y[j].x * y[j].x + y[j].y * y[j].y + y[j].z * y[j].z + y[j].w * y[j].w;
        }
        ss = wave_sum(ss);
        const float rs = rsqrtf(ss * (1.f / 1024.f) + 1e-6f);
#pragma unroll
        for (int j = 0; j < 4; ++j) x[j] += gw[j] * (y[j] * rs);
    }
    if (xout) {
#pragma unroll
        for (int j = 0; j < 4; ++j) *(f32x4*)(xout + j * 256 + lane * 4) = x[j];
    }
    if (do_h) {
        float ss = 0.f;
#pragma unroll
        for (int j = 0; j < 4; ++j) ss += x[j].x * x[j].x + x[j].y * x[j].y + x[j].z * x[j].z + x[j].w * x[j].w;
        ss = wave_sum(ss);
        const float rs = rsqrtf(ss * (1.f / 1024.f) + 1e-6f);
#pragma unroll
        for (int j = 0; j < 4; ++j) {
            const f32x4 h = (x[j] * rs) * hm[j] + hs[j];
            u32x2 o; o.x = pk2(h.x, h.y); o.y = pk2(h.z, h.w);
            *(u32x2*)(hrow + j * 256 + lane * 4) = o;
        }
    }
}

__device__ __forceinline__ void token_phase(CParams& p_in, int l_in, int kind, int nrows) {
    CParams* pq_ = &p_in; asm volatile("" : "+s"(pq_)); CParams& p = *pq_;
    int l = l_in; asm volatile("" : "+s"(l));
    const int tidx = opaque_tid();
    const int lane = tidx & 63, gw = blockIdx.x * 8 + (tidx >> 6), ngw = gridDim.x * 8;
    const float* MOD = (const float*)(p.ws + OFF_MOD);
    const float* NW = p.in[4];
    bf16_t* H = (bf16_t*)(p.ws + OFF_H);
    float* CTXS = (float*)(p.ws + OFF_CTXS);
    for (int row = gw; row < nrows; row += ngw) {
        const bool lat = row < RL; const int mi = lat ? (row >> 13) : 4;
        const float* xin; float* xout = nullptr;
        const bool from_input = (l == 0 && kind <= 1);
        if (lat) xin = from_input ? p.in[0] + (size_t)row * 1024 : p.out + (size_t)row * 1024;
        else xin = from_input ? p.in[2] + (size_t)(row - RL) * 1024 : CTXS + (size_t)(row - RL) * 1024;
        if (kind > 0) xout = lat ? p.out + (size_t)row * 1024 : CTXS + (size_t)(row - RL) * 1024;
        const float* modl = MOD + (size_t)(l * 5 + mi) * 6144;
        bf16_t* hrow = H + (size_t)row * 1024;
        if (kind == 0) row_pass(xin, nullptr, nullptr, nullptr, nullptr, true, NW + (l * 4 + 0) * 1024, modl, modl + 1024, hrow, lane);
        else if (kind == 1) row_pass(xin, hrow, modl + 2048, NW + (l * 4 + 1) * 1024, xout, true, NW + (l * 4 + 2) * 1024, modl + 3072, modl + 4096, hrow, lane);
        else {
            const bool nxt = l < 3; const float* modn = MOD + (size_t)((l + 1) * 5 + mi) * 6144;
            row_pass(xin, hrow, modl + 5120, NW + (l * 4 + 3) * 1024, xout, nxt, NW + ((l + 1) * 4 + 0) * 1024, modn, modn + 1024, hrow, lane);
        }
    }
}

template <int NQ, int PB>
__device__ __forceinline__ void lin_steps(float (&S)[16], const float* qL, const float* kL, const float* vL, const float* dtL, const float* decL, float* yL, int dir, int nq, int pl) {
    constexpr int N = NQ * 16;
    for (int j = 0; j < 32; ++j) {
        const int tt = dir ? 31 - j : j;
        const float xdt = vL[tt * PB + pl] * dtL[tt];
        const float dec = decL[tt];
        const f32x4* kp = (const f32x4*)(kL + tt * N + nq * 16);
        const f32x4* qp = (const f32x4*)(qL + tt * N + nq * 16);
        float part = 0.f;
#pragma unroll
        for (int q4 = 0; q4 < 4; ++q4) {
            const f32x4 kv = kp[q4], qv = qp[q4];
            S[q4 * 4 + 0] = dec * S[q4 * 4 + 0] + kv.x * xdt; part += qv.x * S[q4 * 4 + 0];
            S[q4 * 4 + 1] = dec * S[q4 * 4 + 1] + kv.y * xdt; part += qv.y * S[q4 * 4 + 1];
            S[q4 * 4 + 2] = dec * S[q4 * 4 + 2] + kv.z * xdt; part += qv.z * S[q4 * 4 + 2];
            S[q4 * 4 + 3] = dec * S[q4 * 4 + 3] + kv.w * xdt; part += qv.w * S[q4 * 4 + 3];
        }
        part = (NQ == 8) ? red8(part) : red4(part);
        if (nq == 0) yL[tt * PB + pl] = part;
    }
}

__device__ __forceinline__ void scan_tile(int b, int dir, int tau, int& low, int& s0, int& s1, bool& isctx, bool& first) {
    int ti, nt;
    isctx = tau < 8;
    if (isctx) { ti = dir ? 7 - tau : tau; s0 = RL + b * 256; s1 = s0 + 256; nt = 8; }
    else { ti = dir ? 255 - (tau - 8) : tau - 8; s0 = b * 8192; s1 = s0 + 8192; nt = 256; }
    low = s0 + ti * 32;
    first = (dir == 0) == (ti < nt / 2);
}

template <int NK> struct CsL {
    static constexpr int SN = NK + 8, SS = 40;
    static constexpr int O_CN = 0, O_BN = O_CN + 32 * SN * 2, O_BWT = O_BN + 32 * SN * 2, O_XT = O_BWT + NK * SS * 2, O_PM = O_XT + 64 * SS * 2,
                         O_ST = O_PM + 32 * SS * 2, O_F = O_ST + 64 * SN * 2, O_Y = O_F + 544, O_RAW = (NK == 128) ? O_Y : O_Y + 8192;
};
template <int NK>
__device__ __forceinline__ void cs_core(unsigned char* base, f32x4 (&accS)[NK / 16], int dir, int w, int fr, int fq) {
    typedef CsL<NK> L;
    constexpr int SN = L::SN, SS = L::SS, KC = NK / 32, NT = NK / 16;
    bf16_t* Cn = (bf16_t*)(base + L::O_CN); bf16_t* Bn = (bf16_t*)(base + L::O_BN); bf16_t* BwT = (bf16_t*)(base + L::O_BWT);
    bf16_t* XT = (bf16_t*)(base + L::O_XT); bf16_t* Pm = (bf16_t*)(base + L::O_PM); bf16_t* ST = (bf16_t*)(base + L::O_ST);
    float* cumL = (float*)(base + L::O_F); float* dtL = cumL + 32; float* eL = dtL + 32; float* totL = eL + 64;
    float* yL = (float*)(base + ((NK == 128) ? L::O_BN : L::O_Y));
    f32x4 acc4[2];
    {
        const int mt = w >> 1, nt = w & 1;
        f32x4 g = (f32x4){0.f, 0.f, 0.f, 0.f};
#pragma unroll
        for (int kc = 0; kc < KC; ++kc) {
            const bf16x8 A = *(const bf16x8*)(Cn + (mt * 16 + fr) * SN + kc * 32 + fq * 8);
            const bf16x8 Bf = *(const bf16x8*)(Bn + (nt * 16 + fr) * SN + kc * 32 + fq * 8);
            g = __builtin_amdgcn_mfma_f32_16x16x32_bf16(A, Bf, g, 0, 0, 0);
        }
        const int s = nt * 16 + fr; const float cs = cumL[s], ds = dtL[s];
#pragma unroll
        for (int r = 0; r < 4; ++r) {
            const int t = mt * 16 + fq * 4 + r;
            const bool ok = dir ? (s >= t) : (s <= t);
            const float val = ok ? g[r] * __expf(cumL[t] - cs) * ds : 0.f;
            Pm[t * SS + s] = f2bf(val);
        }
#pragma unroll
        for (int mt2 = 0; mt2 < 2; ++mt2) {
            acc4[mt2] = (f32x4){0.f, 0.f, 0.f, 0.f};
#pragma unroll
            for (int kc = 0; kc < KC; ++kc) {
                const bf16x8 A = *(const bf16x8*)(Cn + (mt2 * 16 + fr) * SN + kc * 32 + fq * 8);
                const bf16x8 Bf = *(const bf16x8*)(ST + (w * 16 + fr) * SN + kc * 32 + fq * 8);
                acc4[mt2] = __builtin_amdgcn_mfma_f32_16x16x32_bf16(A, Bf, acc4[mt2], 0, 0, 0);
            }
        }
    }
    __syncthreads();
    {
        const bf16x8 Xf = *(const bf16x8*)(XT + (w * 16 + fr) * SS + fq * 8);
#pragma unroll
        for (int mt2 = 0; mt2 < 2; ++mt2) {
            const bf16x8 A = *(const bf16x8*)(Pm + (mt2 * 16 + fr) * SS + fq * 8);
            f32x4 a3 = (f32x4){0.f, 0.f, 0.f, 0.f};
            a3 = __builtin_amdgcn_mfma_f32_16x16x32_bf16(A, Xf, a3, 0, 0, 0);
#pragma unroll
            for (int r = 0; r < 4; ++r) { const int t = mt2 * 16 + fq * 4 + r; yL[t * 64 + w * 16 + fr] = a3[r] + eL[t] * acc4[mt2][r]; }
        }
        const float dtot = __expf(totL[0]);
#pragma unroll
        for (int n8 = 0; n8 < NT; ++n8) {
            const bf16x8 Bf = *(const bf16x8*)(BwT + (n8 * 16 + fr) * SS + fq * 8);
            accS[n8] = accS[n8] * dtot;
            accS[n8] = __builtin_amdgcn_mfma_f32_16x16x32_bf16(Xf, Bf, accS[n8], 0, 0, 0);
#pragma unroll
            for (int r = 0; r < 4; ++r) ST[(w * 16 + fq * 4 + r) * SN + n8 * 16 + fr] = f2bf(accS[n8][r]);
        }
    }
    __syncthreads();
}

template <int NK, bool DX>
__device__ __forceinline__ void cs_writeout(unsigned char* base, bf16_t* pp, u32x4 pv, int tl, float Dh) {
    typedef CsL<NK> L;
    const float* yL = (const float*)(base + ((NK == 128) ? L::O_BN : L::O_Y));
    const bf16_t* XT = (const bf16_t*)(base + L::O_XT);
    const int t = tl >> 3, pg = tl & 7;
    const f32x4 ya = *(const f32x4*)(yL + t * 64 + pg * 8), yb = *(const f32x4*)(yL + t * 64 + pg * 8 + 4);
    float y[8] = {ya.x, ya.y, ya.z, ya.w, yb.x, yb.y, yb.z, yb.w};
    const unsigned pa[4] = {pv.x, pv.y, pv.z, pv.w};
#pragma unroll
    for (int j = 0; j < 4; ++j) { y[2 * j] += bflo(pa[j]); y[2 * j + 1] += bfhi(pa[j]); }
    if (DX) {
#pragma unroll
        for (int j = 0; j < 8; ++j) y[j] += Dh * bf2f(XT[(pg * 8 + j) * L::SS + t]);
    }
    u32x4 o; o.x = pk2(y[0], y[1]); o.y = pk2(y[2], y[3]); o.z = pk2(y[4], y[5]); o.w = pk2(y[6], y[7]);
    *(u32x4*)pp = o;
}

__device__ __forceinline__ void ssd_scan_item(CParams& p_in, int l_in, int item, unsigned char* smem) {
    CParams* pq_ = &p_in; asm volatile("" : "+s"(pq_)); CParams& p = *pq_;
    int l = l_in; asm volatile("" : "+s"(l));
    const int tidx = opaque_tid();
    typedef CsL<128> L;
    constexpr int SN = L::SN, SS = L::SS;
    const int b = item >> 4, h = item & 15, g = h >> 3;
    const int tid = tidx, dir = tid >> 8, tl = tid & 255, lane = tid & 63, w = tl >> 6, fr = lane & 15, fq = lane >> 4;
    unsigned char* base = smem + dir * 76800;
    bf16_t* Cn = (bf16_t*)(base + L::O_CN); bf16_t* Bn = (bf16_t*)(base + L::O_BN); bf16_t* BwT = (bf16_t*)(base + L::O_BWT);
    bf16_t* XT = (bf16_t*)(base + L::O_XT); bf16_t* ST = (bf16_t*)(base + L::O_ST);
    float* cumL = (float*)(base + L::O_F); float* dtL = cumL + 32; float* eL = dtL + 32; float* wL = eL + 32; float* totL = eL + 64;
    bf16_t* rawL = (bf16_t*)(base + L::O_RAW);
    const bf16_t* XBC = (const bf16_t*)(p.ws + OFF_XBC);
    const float* DT = (const float*)(p.ws + OFF_DT);
    bf16_t* P = (bf16_t*)(p.ws + OFF_H);
    const float* cw = p.in[8] + (size_t)l * 5 * 1536; const float* cbias = p.in[9] + (size_t)l * 1536;
    const float dtb = p.in[10][l * 32 + dir * 16 + h];
    const float aneg = -__expf(p.in[11][l * 32 + dir * 16 + h]);
    const float Dh = p.in[12][l * 16 + h];
    const int xc1 = 1024 + g * 128 + (tl & 127) * 2;
    const int xc1c = ((tl & 127) < 64) ? xc1 : 1280 + g * 128 + ((tl & 127) - 64) * 2;
    const f32x2_t cw0 = {cw[xc1c], cw[xc1c + 1]}, cw1 = {cw[1536 + xc1c], cw[1536 + xc1c + 1]}, cw2 = {cw[2 * 1536 + xc1c], cw[2 * 1536 + xc1c + 1]},
                  cw3 = {cw[3 * 1536 + xc1c], cw[3 * 1536 + xc1c + 1]}, cw4 = {cw[4 * 1536 + xc1c], cw[4 * 1536 + xc1c + 1]}, cwb = {cbias[xc1c], cbias[xc1c + 1]};
    const int xc2 = h * 64 + (tl & 63);
    const float c20 = cw[xc2], c21 = cw[1536 + xc2], c22 = cw[2 * 1536 + xc2], c23 = cw[3 * 1536 + xc2], c24 = cw[4 * 1536 + xc2], c2b = cbias[xc2];
    for (int i = tl; i < 64 * SN; i += 256) ST[i] = 0;
    f32x4 accS[8];
#pragma unroll
    for (int i = 0; i < 8; ++i) accS[i] = (f32x4){0.f, 0.f, 0.f, 0.f};
    u32x4 rv[6]; float dtr = 0.f;
    int pf_rr[6], pf_off[6], pf_lds[6];
#pragma unroll
    for (int i = 0; i < 6; ++i) {
        const int e = tl + 256 * i; const int rr = e / 40, ch = e - rr * 40;
        const int xc = ch < 16 ? 1024 + g * 128 + ch * 8 : (ch < 32 ? 1280 + g * 128 + (ch - 16) * 8 : h * 64 + (ch - 32) * 8);
        pf_rr[i] = rr; pf_off[i] = rr * 1536 + xc; pf_lds[i] = (e < 36 * 40) ? rr * 320 + ch * 8 : -1;
    }
#define SSD_PREFETCH(tau_) do { int low_, s0_, s1_; bool ic_, fi_; scan_tile(b, dir, (tau_), low_, s0_, s1_, ic_, fi_); \
        const bf16_t* rb_ = XBC + (size_t)(low_ - 2) * 1536; \
        _Pragma("unroll") for (int i = 0; i < 6; ++i) { \
            const int row = low_ - 2 + pf_rr[i]; \
            rv[i] = (u32x4){0u, 0u, 0u, 0u}; \
            if (pf_lds[i] >= 0 && row >= s0_ && row < s1_) rv[i] = *(const u32x4*)(rb_ + pf_off[i]); } \
        if (tl < 32) dtr = DT[(size_t)(low_ + tl) * 32 + dir * 16 + h]; } while (0)
    SSD_PREFETCH(0);
    for (int tau = 0; tau < 264; ++tau) {
        int low, s0, s1; bool isctx, first;
        scan_tile(b, dir, tau, low, s0, s1, isctx, first);
#pragma unroll
        for (int i = 0; i < 6; ++i) { if (pf_lds[i] >= 0) *(u32x4*)(rawL + pf_lds[i]) = rv[i]; }
        if (tl < 64) {
            const float dt = fast_softplus(dtr + dtb);
            const float la = dt * aneg;
            float c = la;
#pragma unroll
            for (int o = 1; o < 32; o <<= 1) { const float v = __shfl_up(c, o); if (lane >= o) c += v; }
            const float total = __shfl(c, 31);
            const float cd = dir ? (total - c + la) : c;
            if (tl < 32) { cumL[tl] = cd; dtL[tl] = dt; eL[tl] = __expf(cd); wL[tl] = __expf(total - cd) * dt; if (tl == 0) totL[0] = total; }
        }
        bf16_t* pp = P + (size_t)(low + (tl >> 3)) * 1024 + h * 64 + (tl & 7) * 8;
        u32x4 pv = (u32x4){0u, 0u, 0u, 0u};
        if (!first) pv = *(const u32x4*)pp;
        __syncthreads();
        {
            const bf16_t* __restrict__ rawR = rawL;
            {
                const int cp = tl & 127, th = tl >> 7, c0 = cp * 2, tb = th * 16;
                f32x2_t q0, q1, q2, q3;
                { const unsigned a = *(const unsigned*)(rawR + (tb) * 320 + c0), bq = *(const unsigned*)(rawR + (tb + 1) * 320 + c0), cq = *(const unsigned*)(rawR + (tb + 2) * 320 + c0), dq = *(const unsigned*)(rawR + (tb + 3) * 320 + c0);
                  q0 = (f32x2_t){bflo(a), bfhi(a)}; q1 = (f32x2_t){bflo(bq), bfhi(bq)}; q2 = (f32x2_t){bflo(cq), bfhi(cq)}; q3 = (f32x2_t){bflo(dq), bfhi(dq)}; }
#pragma unroll 8
                for (int j = 0; j < 16; ++j) {
                    const int t = tb + j;
                    const unsigned e = *(const unsigned*)(rawR + (t + 4) * 320 + c0);
                    const f32x2_t q4 = {bflo(e), bfhi(e)};
                    f32x2_t o = __builtin_elementwise_fma(cw4, q4, cwb);
                    o = __builtin_elementwise_fma(cw3, q3, o); o = __builtin_elementwise_fma(cw2, q2, o);
                    o = __builtin_elementwise_fma(cw1, q1, o); o = __builtin_elementwise_fma(cw0, q0, o);
                    o.x = siluf_(o.x); o.y = siluf_(o.y);
                    if (cp < 64) {
                        *(unsigned*)(Bn + t * SN + c0) = pk2(o.x, o.y);
                        const float wt = wL[t];
                        const unsigned bw = pk2(o.x * wt, o.y * wt);
                        BwT[c0 * SS + t] = (bf16_t)(bw & 0xffffu); BwT[(c0 + 1) * SS + t] = (bf16_t)(bw >> 16);
                    } else *(unsigned*)(Cn + t * SN + c0 - 128) = pk2(o.x, o.y);
                    q0 = q1; q1 = q2; q2 = q3; q3 = q4;
                }
            }
            const int xcol = 256 + (tl & 63), tq = tl >> 6;
            float q0 = bf2f(rawL[(tq * 8) * 320 + xcol]), q1 = bf2f(rawL[(tq * 8 + 1) * 320 + xcol]), q2 = bf2f(rawL[(tq * 8 + 2) * 320 + xcol]), q3 = bf2f(rawL[(tq * 8 + 3) * 320 + xcol]);
            unsigned xo[4];
#pragma unroll
            for (int j = 0; j < 8; ++j) {
                const float q4 = bf2f(rawL[(tq * 8 + j + 4) * 320 + xcol]);
                const float o = siluf_(c20 * q0 + c21 * q1 + c22 * q2 + c23 * q3 + c24 * q4 + c2b);
                if (j & 1) xo[j >> 1] |= ((unsigned)f2bf(o)) << 16; else xo[j >> 1] = f2bf(o);
                q0 = q1; q1 = q2; q2 = q3; q3 = q4;
            }
            *(u32x4*)(XT + (tl & 63) * SS + tq * 8) = (u32x4){xo[0], xo[1], xo[2], xo[3]};
        }
        __syncthreads();
        if (tau + 1 < 264) SSD_PREFETCH(tau + 1);
        cs_core<128>(base, accS, dir, w, fr, fq);
        cs_writeout<128, true>(base, pp, pv, tl, first ? 0.f : Dh);
        if (tau == 3 || tau == 135) __syncthreads();
    }
#undef SSD_PREFETCH
}

__device__ __forceinline__ void ret_scan_item(CParams& p_in, int l_in, int item, unsigned char* smem) {
    CParams* pq_ = &p_in; asm volatile("" : "+s"(pq_)); CParams& p = *pq_;
    int l = l_in; asm volatile("" : "+s"(l));
    const int tidx = opaque_tid();
    typedef CsL<64> L;
    constexpr int SN = L::SN, SS = L::SS;
    const int b = item >> 3, hd = (item >> 1) & 3, phalf = item & 1;
    const int tid = tidx, dir = tid >> 8, tl = tid & 255, lane = tid & 63, w = tl >> 6, fr = lane & 15, fq = lane >> 4;
    unsigned char* base = smem + dir * 76800;
    bf16_t* Cn = (bf16_t*)(base + L::O_CN); bf16_t* Bn = (bf16_t*)(base + L::O_BN); bf16_t* BwT = (bf16_t*)(base + L::O_BWT);
    bf16_t* XT = (bf16_t*)(base + L::O_XT); bf16_t* ST = (bf16_t*)(base + L::O_ST);
    float* cumL = (float*)(base + L::O_F); float* dtL = cumL + 32; float* eL = dtL + 32; float* wL = eL + 32; float* totL = eL + 64;
    bf16_t* rawL = (bf16_t*)(base + L::O_RAW);
    const bf16_t* QKV = (const bf16_t*)(p.ws + OFF_QKV);
    bf16_t* P = (bf16_t*)(p.ws + OFF_PRET);
    const float lg = -fast_softplus(-p.in[14][l * 8 + dir * 4 + hd]);
    if (tl < 32) {
        const float cd = dir ? (float)(32 - tl) * lg : (float)(tl + 1) * lg;
        const float total = 32.f * lg;
        cumL[tl] = cd; dtL[tl] = 1.f; eL[tl] = __expf(cd); wL[tl] = __expf(total - cd); if (tl == 0) totL[0] = total;
    }
    for (int i = tl; i < 64 * SN; i += 256) ST[i] = 0;
    f32x4 accS[4];
#pragma unroll
    for (int i = 0; i < 4; ++i) accS[i] = (f32x4){0.f, 0.f, 0.f, 0.f};
    const int pairidx = tl & 63, tq = tl >> 6, which = pairidx >> 5, pi = pairidx & 31;
    const float inv = exp2f(-(float)(pi & 15) * (13.287712379549449f / 16.f));
    u32x4 rv[3];
#define RET_PREFETCH(tau_) do { int low_, s0_, s1_; bool ic_, fi_; scan_tile(b, dir, (tau_), low_, s0_, s1_, ic_, fi_); \
        _Pragma("unroll") for (int i = 0; i < 3; ++i) { \
            const int e = tl + 256 * i; const int rr = e / 24, ch = e - rr * 24; \
            const int col = ch < 8 ? hd * 64 + ch * 8 : (ch < 16 ? 256 + hd * 64 + (ch - 8) * 8 : 512 + hd * 128 + phalf * 64 + (ch - 16) * 8); \
            rv[i] = *(const u32x4*)(QKV + (size_t)(low_ + rr) * 1024 + col); } } while (0)
    RET_PREFETCH(0);
    for (int tau = 0; tau < 264; ++tau) {
        int low, s0, s1; bool isctx, first;
        scan_tile(b, dir, tau, low, s0, s1, isctx, first);
#pragma unroll
        for (int i = 0; i < 3; ++i) { const int e = tl + 256 * i; const int rr = e / 24, ch = e - rr * 24; *(u32x4*)(rawL + rr * 192 + ch * 8) = rv[i]; }
        bf16_t* pp = P + (size_t)(low + (tl >> 3)) * 512 + hd * 128 + phalf * 64 + (tl & 7) * 8;
        u32x4 pv = (u32x4){0u, 0u, 0u, 0u};
        if (!first) pv = *(const u32x4*)pp;
        __syncthreads();
        {
#pragma unroll
            for (int j = 0; j < 8; ++j) {
                const int t = tq * 8 + j;
                const unsigned raw = *(const unsigned*)(rawL + t * 192 + which * 64 + 2 * pi);
                const float x1 = bflo(raw), x2 = bfhi(raw);
                float c = 1.f, s = 0.f;
                if (!isctx) { const int pos = low + t - s0; const float ppos = (pi < 16) ? (float)(pos >> 6) : (float)(pos & 63); const float ang = ppos * inv; c = __cosf(ang); s = __sinf(ang); }
                const float o1 = x1 * c - x2 * s, o2 = x1 * s + x2 * c;
                if (which == 0) *(unsigned*)(Cn + t * SN + 2 * pi) = pk2(o1, o2);
                else {
                    const float k1 = o1 * 0.125f, k2 = o2 * 0.125f, wt = wL[t];
                    *(unsigned*)(Bn + t * SN + 2 * pi) = pk2(k1, k2);
                    BwT[(2 * pi) * SS + t] = f2bf(k1 * wt); BwT[(2 * pi + 1) * SS + t] = f2bf(k2 * wt);
                }
            }
            unsigned xo[4];
#pragma unroll
            for (int j = 0; j < 8; ++j) { const unsigned v = rawL[(tq * 8 + j) * 192 + 128 + pairidx]; if (j & 1) xo[j >> 1] |= v << 16; else xo[j >> 1] = v; }
            *(u32x4*)(XT + pairidx * SS + tq * 8) = (u32x4){xo[0], xo[1], xo[2], xo[3]};
        }
        __syncthreads();
        if (tau + 1 < 264) RET_PREFETCH(tau + 1);
        cs_core<64>(base, accS, dir, w, fr, fq);
        cs_writeout<64, false>(base, pp, pv, tl, 0.f);
        if (tau == 3 || tau == 135) __syncthreads();
    }
#undef RET_PREFETCH
}

__device__ __forceinline__ void shift_phase(CParams& p_in, int l_in, int part, unsigned char* smem) {
    CParams* pq_ = &p_in; asm volatile("" : "+s"(pq_)); CParams& p = *pq_;
    int l = l_in; asm volatile("" : "+s"(l));
    const int tidx = opaque_tid();
    bf16_t* RW = (bf16_t*)(p.ws + OFF_RW);
    u32x2* halo = (u32x2*)smem;
    const int c0 = tidx * 4;
    if (tidx >= 448) return;
    if (part == 0) {
        for (int k = 0; k < 5; ++k) {
            const int chunk = blockIdx.x + k * gridDim.x; if (chunk >= R / 32) break;
            const int lo = chunk * 32; int s0, s1;
            if (lo < RL) { s0 = lo & ~8191; s1 = s0 + 8192; } else { s0 = RL + ((lo - RL) & ~255); s1 = s0 + 256; }
            u32x2 a = (u32x2){0u, 0u}, b = (u32x2){0u, 0u};
            if (lo - 1 >= s0) a = *(const u32x2*)(RW + (size_t)(lo - 1) * 1792 + c0);
            if (lo + 32 < s1) b = *(const u32x2*)(RW + (size_t)(lo + 32) * 1792 + c0);
            halo[(k * 2 + 0) * 448 + tidx] = a; halo[(k * 2 + 1) * 448 + tidx] = b;
        }
        return;
    }
    const f32x4 mx = *(const f32x4*)(p.in[15] + (size_t)l * 1792 + c0);
    const int kind = (c0 >= 1536 && c0 < 1600) ? 1 : (c0 >= 1664 ? 2 : 0);
    for (int k = 0; k < 5; ++k) {
        const int chunk = blockIdx.x + k * gridDim.x; if (chunk >= R / 32) break;
        bf16_t* base = RW + (size_t)chunk * 32 * 1792 + c0;
        u32x2 rows[34];
        rows[0] = halo[(k * 2 + 0) * 448 + tidx]; rows[33] = halo[(k * 2 + 1) * 448 + tidx];
#pragma unroll
        for (int t = 0; t < 32; ++t) rows[t + 1] = *(const u32x2*)(base + (size_t)t * 1792);
#pragma unroll
        for (int t = 0; t < 32; ++t) {
            const u32x2 a = rows[t], b = rows[t + 1], c = rows[t + 2];
            f32x4 u0 = (f32x4){bflo(a.x), bfhi(a.x), bflo(a.y), bfhi(a.y)}, u1 = (f32x4){bflo(b.x), bfhi(b.x), bflo(b.y), bfhi(b.y)}, u2 = (f32x4){bflo(c.x), bfhi(c.x), bflo(c.y), bfhi(c.y)};
            f32x4 v = u1 + mx * ((u0 + u2) * 0.5f - u1);
            if (kind == 1) { v.x = fast_tanh(v.x); v.y = fast_tanh(v.y); v.z = fast_tanh(v.z); v.w = fast_tanh(v.w); }
            else if (kind == 2) { v.x = sigmoidf_(v.x); v.y = sigmoidf_(v.y); v.z = sigmoidf_(v.z); v.w = sigmoidf_(v.w); }
            u32x2 o; o.x = pk2(v.x, v.y); o.y = pk2(v.z, v.w);
            *(u32x2*)(base + (size_t)t * 1792) = o;
        }
    }
}

__device__ __forceinline__ void rwkv_scan_item(CParams& p_in, int l_in, int item, unsigned char* smem) {
    CParams* pq_ = &p_in; asm volatile("" : "+s"(pq_)); CParams& p = *pq_;
    int l = l_in; asm volatile("" : "+s"(l));
    const int tidx = opaque_tid();
    const int b = item >> 5, h = (item >> 2) & 7, rq = item & 3;
    const int tid = tidx, dir = tid >> 8, tl = tid & 255, lane = tid & 63, wv = tl >> 6;
    const int kq = lane & 15, rloc = wv * 4 + (lane >> 4);
    const int fr = lane & 15, fq = lane >> 4;
    unsigned char* base = smem + dir * 67072;
    float* rL = (float*)base;
    float *kL = rL + 2048, *wL = kL + 2048, *bL = wL + 2048, *nkL = bL + 2048, *vL = nkL + 2048, *yL = vL + 1024;
    float* kdL = (float*)(base + 58880);
    bf16_t* twB = (bf16_t*)(yL + 1024);
    bf16_t* aloB = twB + 2048;
    float* invn = (float*)(aloB + 2048);
    const bf16_t* RW = (const bf16_t*)(p.ws + OFF_RW);
    bf16_t* P = (bf16_t*)(p.ws + OFF_PRW);
    const int cch = h * 64 + wv * 16 + fr;
    bf16x8 Bw[2], Ba[2];
    {
        const float* w2g = p.in[17] + ((size_t)(l * 2 + dir) * 64) * 512 + cch;
        const float* a2g = p.in[19] + ((size_t)l * 64) * 512 + cch;
#pragma unroll
        for (int kc = 0; kc < 2; ++kc)
#pragma unroll
            for (int e = 0; e < 8; ++e) {
                const int j = kc * 32 + fq * 8 + e;
                Bw[kc][e] = (short)f2bf(w2g[(size_t)j * 512]); Ba[kc][e] = (short)f2bf(a2g[(size_t)j * 512]);
            }
    }
    const float w0c = p.in[16][(l * 2 + dir) * 512 + cch], a0c = p.in[18][(l * 2 + dir) * 512 + cch];
    const float kkc = p.in[21][l * 512 + cch], kac = p.in[22][l * 512 + cch];
    const int t2 = tl >> 3, part2 = tl & 7;
    f32x4 kk2a = *(const f32x4*)(p.in[21] + l * 512 + h * 64 + part2 * 8), kk2b = *(const f32x4*)(p.in[21] + l * 512 + h * 64 + part2 * 8 + 4);
    float S[4];
#pragma unroll
    for (int i = 0; i < 4; ++i) S[i] = 0.f;
    u32x4 rv[5];
    int pf_off[5], pf_dst[5], pf_mode[5];
#pragma unroll
    for (int i = 0; i < 5; ++i) {
        const int e = tl + 256 * i; const int rr = e / 34, ch = e - rr * 34;
        const int col = ch < 8 ? h * 64 + ch * 8 : (ch < 16 ? 512 + h * 64 + (ch - 8) * 8 : (ch < 32 ? 1536 + (ch - 16) * 8 : 1024 + h * 64 + rq * 16 + (ch - 32) * 8));
        pf_off[i] = rr * 1792 + col;
        int dst, mode;
        if (ch < 8) { dst = (int)((unsigned char*)(rL + rr * 64 + ch * 8) - base); mode = 0; }
        else if (ch < 16) { dst = (int)((unsigned char*)(kL + rr * 64 + (ch - 8) * 8) - base); mode = 0; }
        else if (ch < 24) { dst = (int)((unsigned char*)(twB + rr * 64 + (ch - 16) * 8) - base); mode = 1; }
        else if (ch < 32) { dst = (int)((unsigned char*)(aloB + rr * 64 + (ch - 24) * 8) - base); mode = 1; }
        else { dst = (int)((unsigned char*)(vL + rr * 16 + (ch - 32) * 8) - base); mode = 0; }
        pf_dst[i] = dst; pf_mode[i] = (e < 32 * 34) ? mode : -1;
    }
#define RW_PREFETCH(tau_) do { int low_, s0_, s1_; bool ic_, fi_; scan_tile(b, dir, (tau_), low_, s0_, s1_, ic_, fi_); \
        const bf16_t* rb_ = RW + (size_t)low_ * 1792; \
        _Pragma("unroll") for (int i = 0; i < 5; ++i) { \
            rv[i] = (u32x4){0u, 0u, 0u, 0u}; \
            if (pf_mode[i] >= 0) rv[i] = *(const u32x4*)(rb_ + pf_off[i]); } } while (0)
    RW_PREFETCH(0);
    for (int tau = 0; tau < 264; ++tau) {
        int low, s0, s1; bool isctx, first;
        scan_tile(b, dir, tau, low, s0, s1, isctx, first);
#pragma unroll
        for (int i = 0; i < 5; ++i) {
            if (pf_mode[i] == 1) *(u32x4*)(base + pf_dst[i]) = rv[i];
            else if (pf_mode[i] == 0) {
                *(f32x4*)(base + pf_dst[i]) = (f32x4){bflo(rv[i].x), bfhi(rv[i].x), bflo(rv[i].y), bfhi(rv[i].y)};
                *(f32x4*)(base + pf_dst[i] + 16) = (f32x4){bflo(rv[i].z), bfhi(rv[i].z), bflo(rv[i].w), bfhi(rv[i].w)};
            }
        }
        bf16_t* pp = P + (size_t)(low + t2) * 512 + h * 64 + rq * 16 + part2 * 2;
        unsigned pv = 0u;
        if (!first) pv = *(const unsigned*)pp;
        __syncthreads();
        {
            const f32x4 ka = *(const f32x4*)(kL + t2 * 64 + part2 * 8), kb = *(const f32x4*)(kL + t2 * 64 + part2 * 8 + 4);
            const f32x4 pa = ka * kk2a, pb = kb * kk2b;
            float ss = pa.x * pa.x + pa.y * pa.y + pa.z * pa.z + pa.w * pa.w + pb.x * pb.x + pb.y * pb.y + pb.z * pb.z + pb.w * pb.w;
            ss = red8(ss);
            if (part2 == 0) { const float iv = __builtin_amdgcn_rcpf(fmaxf(sqrtf(ss), 1e-12f)); invn[t2] = iv * iv; }
        }
        f32x4 accw[2], acca[2];
#pragma unroll
        for (int mt = 0; mt < 2; ++mt) {
            accw[mt] = (f32x4){0.f, 0.f, 0.f, 0.f}; acca[mt] = (f32x4){0.f, 0.f, 0.f, 0.f};
#pragma unroll
            for (int kc = 0; kc < 2; ++kc) {
                const bf16x8 Aw = *(const bf16x8*)(twB + (mt * 16 + fr) * 64 + kc * 32 + fq * 8);
                const bf16x8 Aa = *(const bf16x8*)(aloB + (mt * 16 + fr) * 64 + kc * 32 + fq * 8);
                accw[mt] = __builtin_amdgcn_mfma_f32_16x16x32_bf16(Aw, Bw[kc], accw[mt], 0, 0, 0);
                acca[mt] = __builtin_amdgcn_mfma_f32_16x16x32_bf16(Aa, Ba[kc], acca[mt], 0, 0, 0);
            }
        }
#pragma unroll
        for (int mt = 0; mt < 2; ++mt)
#pragma unroll
            for (int r = 0; r < 4; ++r) {
                const int t = mt * 16 + fq * 4 + r, c = wv * 16 + fr;
                const float wl = w0c + accw[mt][r];
                const float decay = __expf(-0.6065306597f * sigmoidf_(wl));
                const float a = sigmoidf_(a0c + acca[mt][r]);
                const float kraw = kL[t * 64 + c];
                const float kk = kraw * kkc;
                wL[t * 64 + c] = decay;
                kdL[t * 64 + c] = kraw * (1.f + (a - 1.f) * kac);
                bL[t * 64 + c] = kk * a;
                nkL[t * 64 + c] = -kk;
            }
        __syncthreads();
        if (tau + 1 < 264) RW_PREFETCH(tau + 1);
        {
            const float* __restrict__ nkR = nkL + kq * 4; const float* __restrict__ wR = wL + kq * 4; const float* __restrict__ bR = bL + kq * 4;
            const float* __restrict__ kR = kdL + kq * 4; const float* __restrict__ rR = rL + kq * 4; const float* __restrict__ vR = vL + rloc;
            float* __restrict__ yW = yL + rloc;
            const int t0 = dir ? 31 : 0, dt = dir ? -1 : 1;
            f32x4 n0 = *(const f32x4*)(nkR + t0 * 64), wa = *(const f32x4*)(wR + t0 * 64), ba = *(const f32x4*)(bR + t0 * 64);
            f32x4 ka = *(const f32x4*)(kR + t0 * 64), ra = *(const f32x4*)(rR + t0 * 64);
            float vv = vR[t0 * 16], iv2 = invn[t0];
            f32x2_t S01 = {S[0], S[1]}, S23 = {S[2], S[3]};
            float yprev = 0.f; int tprev = t0;
#pragma unroll 2
            for (int j = 0; j < 32; ++j) {
                const int tt = t0 + dt * j;
                const int tn = (j < 31) ? tt + dt : tt;
                const f32x4 n0n = *(const f32x4*)(nkR + tn * 64), wan = *(const f32x4*)(wR + tn * 64), ban = *(const f32x4*)(bR + tn * 64);
                const f32x4 kan = *(const f32x4*)(kR + tn * 64), ran = *(const f32x4*)(rR + tn * 64);
                const float vvn = vR[tn * 16], iv2n = invn[tn];
                f32x2_t pp2 = S01 * (f32x2_t){n0.x, n0.y};
                pp2 = __builtin_elementwise_fma(S23, (f32x2_t){n0.z, n0.w}, pp2);
                float ra_ = pp2.x + pp2.y, rb_ = yprev;
                ra_ += dppf<0xB1>(ra_); rb_ += dppf<0xB1>(rb_);
                ra_ += dppf<0x4E>(ra_); rb_ += dppf<0x4E>(rb_);
                ra_ += dppf<0x141>(ra_); rb_ += dppf<0x141>(rb_);
                ra_ += dppf<0x140>(ra_); rb_ += dppf<0x140>(rb_);
                if (kq == 0 && j > 0) yW[tprev * 16] = rb_;
                const float sa = ra_ * iv2;
                const f32x2_t sav = {sa, sa}, vvv = {vv, vv};
                f32x2_t t01 = vvv * (f32x2_t){ka.x, ka.y}, t23 = vvv * (f32x2_t){ka.z, ka.w};
                t01 = __builtin_elementwise_fma(sav, (f32x2_t){ba.x, ba.y}, t01);
                t23 = __builtin_elementwise_fma(sav, (f32x2_t){ba.z, ba.w}, t23);
                S01 = __builtin_elementwise_fma(S01, (f32x2_t){wa.x, wa.y}, t01);
                S23 = __builtin_elementwise_fma(S23, (f32x2_t){wa.z, wa.w}, t23);
                f32x2_t qq = S01 * (f32x2_t){ra.x, ra.y};
                qq = __builtin_elementwise_fma(S23, (f32x2_t){ra.z, ra.w}, qq);
                yprev = qq.x + qq.y; tprev = tt;
                n0 = n0n; wa = wan; ba = ban; ka = kan; ra = ran; vv = vvn; iv2 = iv2n;
            }
            { const float y = red16(yprev); if (kq == 0) yW[tprev * 16] = y; }
            S[0] = S01.x; S[1] = S01.y; S[2] = S23.x; S[3] = S23.y;
        }
        __syncthreads();
        {
            const float y0 = yL[t2 * 16 + part2 * 2], y1 = yL[t2 * 16 + part2 * 2 + 1];
            *(unsigned*)pp = pk2(bflo(pv) + y0, bfhi(pv) + y1);
        }
        if (tau == 3 || tau == 135) __syncthreads();
    }
#undef RW_PREFETCH
}

__device__ __forceinline__ void scan_phase(CParams& p, int l, unsigned char* smem) {
    for (int it = blockIdx.x; it < 224; it += gridDim.x) {
        const int xcd = it & 7;
        if (it < 128) { const int j = it >> 3;
            rwkv_scan_item(p, l, ((xcd * 4 + (j >> 2)) << 2) | (j & 3), smem); }
        else if (it < 192) { const int j = (it - 128) >> 3;
            ssd_scan_item(p, l, ((xcd >> 1) << 4) | ((xcd & 1) << 3) | j, smem); }
        else { const int j = (it - 192) >> 3;
            ret_scan_item(p, l, ((xcd >> 1) << 3) | ((((xcd & 1) << 1) | (j >> 1)) << 1) | (j & 1), smem); }
        __syncthreads();
    }
    int cb = (int)blockIdx.x - 224, cn = (int)gridDim.x - 224;
    if (cn <= 0) { cb = blockIdx.x; cn = gridDim.x; }
    if (cb >= 0) cvt_mix(p, l, smem, cb, cn);
}

__device__ __forceinline__ void post_phase(CParams& p_in, int l_in, int nrows, unsigned char* smem) {
    CParams* pq_ = &p_in; asm volatile("" : "+s"(pq_)); CParams& p = *pq_;
    int l = l_in; asm volatile("" : "+s"(l));
    const int tidx = opaque_tid();
    const int lane = tidx & 63, gw = blockIdx.x * 8 + (tidx >> 6), ngw = gridDim.x * 8;
    unsigned char* ws = p.ws;
    const float* MOD = (const float*)(ws + OFF_MOD);
    for (int row = gw; row < nrows; row += ngw) {
        {
            const bf16_t* yp = (const bf16_t*)(ws + OFF_H) + (size_t)row * 1024 + lane * 16;
            bf16_t* zp = (bf16_t*)(ws + OFF_Z) + (size_t)row * 1024 + lane * 16;
            const float* nw = p.in[13] + (size_t)l * 1024 + lane * 16;
            float v[16]; float ss = 0.f;
#pragma unroll
            for (int q = 0; q < 2; ++q) {
                const u32x4 yr = *(const u32x4*)(yp + q * 8), zr = *(const u32x4*)(zp + q * 8);
                const unsigned ya[4] = {yr.x, yr.y, yr.z, yr.w}, za[4] = {zr.x, zr.y, zr.z, zr.w};
#pragma unroll
                for (int e = 0; e < 4; ++e) {
                    const float y0 = bflo(ya[e]), y1 = bfhi(ya[e]), z0 = bflo(za[e]), z1 = bfhi(za[e]);
                    const float a = y0 * siluf_(z0), c = y1 * siluf_(z1);
                    v[q * 8 + e * 2] = a; v[q * 8 + e * 2 + 1] = c; ss += a * a + c * c;
                }
            }
            ss = red16(ss); ss += __shfl_xor(ss, 16);
            const float rs = rsqrtf(ss * (1.f / 512.f) + 1e-6f);
#pragma unroll
            for (int q = 0; q < 2; ++q) {
                const f32x4 wa = *(const f32x4*)(nw + q * 8), wb = *(const f32x4*)(nw + q * 8 + 4);
                u32x4 o;
                o.x = pk2(v[q * 8 + 0] * rs * wa.x, v[q * 8 + 1] * rs * wa.y); o.y = pk2(v[q * 8 + 2] * rs * wa.z, v[q * 8 + 3] * rs * wa.w);
                o.z = pk2(v[q * 8 + 4] * rs * wb.x, v[q * 8 + 5] * rs * wb.y); o.w = pk2(v[q * 8 + 6] * rs * wb.z, v[q * 8 + 7] * rs * wb.w);
                *(u32x4*)(zp + q * 8) = o;
            }
        }
        {
            const bf16_t* yp = (const bf16_t*)(ws + OFF_PRET) + (size_t)row * 512 + lane * 8;
            bf16_t* gp = (bf16_t*)(ws + OFF_G) + (size_t)row * 512 + lane * 8;
            const u32x4 yr = *(const u32x4*)yp, gr = *(const u32x4*)gp;
            const unsigned ya[4] = {yr.x, yr.y, yr.z, yr.w}, ga[4] = {gr.x, gr.y, gr.z, gr.w};
            float v[8], gg[8]; float s = 0.f;
#pragma unroll
            for (int e = 0; e < 4; ++e) { v[2 * e] = bflo(ya[e]); v[2 * e + 1] = bfhi(ya[e]); gg[2 * e] = bflo(ga[e]); gg[2 * e + 1] = bfhi(ga[e]); s += v[2 * e] + v[2 * e + 1]; }
            s = red16(s);
            const float mean = s * (1.f / 128.f); float q2 = 0.f;
#pragma unroll
            for (int e = 0; e < 8; ++e) { v[e] -= mean; q2 += v[e] * v[e]; }
            q2 = red16(q2);
            const float rs = rsqrtf(q2 * (1.f / 128.f) + 1e-6f);
            u32x4 o;
            o.x = pk2(v[0] * rs * siluf_(gg[0]), v[1] * rs * siluf_(gg[1])); o.y = pk2(v[2] * rs * siluf_(gg[2]), v[3] * rs * siluf_(gg[3]));
            o.z = pk2(v[4] * rs * siluf_(gg[4]), v[5] * rs * siluf_(gg[5])); o.w = pk2(v[6] * rs * siluf_(gg[6]), v[7] * rs * siluf_(gg[7]));
            *(u32x4*)gp = o;
        }
        {
            const bool lat = row < RL; const int mi = lat ? (row >> 13) : 4;
            const float* xin;
            if (lat) xin = (l == 0) ? p.in[0] + (size_t)row * 1024 : p.out + (size_t)row * 1024;
            else xin = (l == 0) ? p.in[2] + (size_t)(row - RL) * 1024 : (const float*)(ws + OFF_CTXS) + (size_t)(row - RL) * 1024;
            const float* modl = MOD + (size_t)(l * 5 + mi) * 6144;
            row_pass(xin, nullptr, nullptr, nullptr, nullptr, true, p.in[4] + (l * 4 + 0) * 1024, modl, modl + 1024, (bf16_t*)(ws + OFF_XBC) + (size_t)row * 1024, lane);
        }
    }
    bf16_t* aB = (bf16_t*)smem;
    bf16_t* gB = aB + 32 * 72;
    float* asL = (float*)(smem + 13312);
    float* gsL = asL + 32 * 512;
    const bf16_t* RW = (const bf16_t*)(ws + OFF_RW);
    bf16_t* P = (bf16_t*)(ws + OFF_PRW);
    const float* mix = p.in[15] + (size_t)l * 1792;
    const int c = tidx;
    const float a0f = p.in[18][(l * 2 + 0) * 512 + c], a0b = p.in[18][(l * 2 + 1) * 512 + c];
    const float kac = p.in[22][l * 512 + c], rkc = p.in[23][l * 512 + c], lw = p.in[24][l * 512 + c], lb = p.in[25][l * 512 + c];
    const float mxr = mix[c], mxk = mix[512 + c], mxv = mix[1024 + c];
    const int wvB = tidx >> 6, frB = lane & 15, fqB = lane >> 4;
    const float* a2 = p.in[19] + (size_t)l * 64 * 512 + wvB * 64 + frB;
    const float* g2 = p.in[20] + (size_t)l * 128 * 512 + wvB * 64 + frB;
    for (int tile = blockIdx.x; tile < nrows / 32; tile += gridDim.x) {
        const int low = tile * 32;
        int s0, s1;
        if (low < RL) { s0 = low & ~8191; s1 = s0 + 8192; } else { s0 = RL + ((low - RL) & ~255); s1 = s0 + 256; }
        {
            for (int e = tidx; e < 32 * 24; e += 512) {
                const int t = e / 24, ch = e - t * 24;
                const u32x4 v = *(const u32x4*)(RW + (size_t)(low + t) * 1792 + 1600 + ch * 8);
                if (ch < 8) *(u32x4*)(aB + t * 72 + ch * 8) = v; else *(u32x4*)(gB + t * 136 + (ch - 8) * 8) = v;
            }
        }
        __syncthreads();
        {
            bf16x8 Aa[2][2], Ag[2][4];
#pragma unroll
            for (int mt = 0; mt < 2; ++mt) {
#pragma unroll
                for (int kc = 0; kc < 2; ++kc) Aa[mt][kc] = *(const bf16x8*)(aB + (mt * 16 + frB) * 72 + kc * 32 + fqB * 8);
#pragma unroll
                for (int kc = 0; kc < 4; ++kc) Ag[mt][kc] = *(const bf16x8*)(gB + (mt * 16 + frB) * 136 + kc * 32 + fqB * 8);
            }
#pragma unroll 1
            for (int nt = 0; nt < 4; ++nt) {
                bf16x8 ba[2], bg[4];
#pragma unroll
                for (int kc = 0; kc < 2; ++kc)
#pragma unroll
                    for (int e = 0; e < 8; ++e) ba[kc][e] = (short)f2bf(a2[(size_t)(kc * 32 + fqB * 8 + e) * 512 + nt * 16]);
#pragma unroll
                for (int kc = 0; kc < 4; ++kc)
#pragma unroll
                    for (int e = 0; e < 8; ++e) bg[kc][e] = (short)f2bf(g2[(size_t)(kc * 32 + fqB * 8 + e) * 512 + nt * 16]);
#pragma unroll
                for (int mt = 0; mt < 2; ++mt) {
                    f32x4 ca = (f32x4){0.f, 0.f, 0.f, 0.f}, cg = (f32x4){0.f, 0.f, 0.f, 0.f};
#pragma unroll
                    for (int kc = 0; kc < 2; ++kc) ca = __builtin_amdgcn_mfma_f32_16x16x32_bf16(Aa[mt][kc], ba[kc], ca, 0, 0, 0);
#pragma unroll
                    for (int kc = 0; kc < 4; ++kc) cg = __builtin_amdgcn_mfma_f32_16x16x32_bf16(Ag[mt][kc], bg[kc], cg, 0, 0, 0);
#pragma unroll
                    for (int r = 0; r < 4; ++r) {
                        const int idx = (mt * 16 + fqB * 4 + r) * 512 + wvB * 64 + nt * 16 + frB;
                        asL[idx] = ca[r]; gsL[idx] = cg[r];
                    }
                }
            }
        }
        __syncthreads();
        const bf16_t* u = RW + (size_t)low * 1792;
#pragma unroll 1
        for (int tb = 0; tb < 32; tb += 16) {
            bf16_t rr[16], kk8[16], vv8[16], yy[16];
#pragma unroll
            for (int i = 0; i < 16; ++i) {
                const bf16_t* un = u + (size_t)(tb + i) * 1792;
                rr[i] = un[c]; kk8[i] = un[512 + c]; vv8[i] = un[1024 + c]; yy[i] = P[(size_t)(low + tb + i) * 512 + c];
            }
#pragma unroll
            for (int i = 0; i < 16; ++i) {
                const int row = low + tb + i;
                const float r = bf2f(rr[i]), k = bf2f(kk8[i]), v = bf2f(vv8[i]), y = bf2f(yy[i]);
                const float ash = asL[(tb + i) * 512 + c];
                const float af = sigmoidf_(a0f + ash), ab = sigmoidf_(a0b + ash);
                const float ks = k * (2.f + (af + ab - 2.f) * kac);
                const float bsum = wave_sum(r * ks * rkc);
                const float mean = wave_sum(y) * (1.f / 64.f);
                const float d = y - mean;
                const float var = wave_sum(d * d) * (1.f / 64.f);
                const float yn = d * rsqrtf(var + 64e-5f) * lw + lb;
                P[(size_t)row * 512 + c] = f2bf((yn + bsum * v) * gsL[(tb + i) * 512 + c]);
            }
        }
        __syncthreads();
    }
}

__device__ __forceinline__ void flat_barrier(unsigned* cnt, unsigned target) {
    asm volatile("s_waitcnt vmcnt(0)" ::: "memory");
    __syncthreads();
    if (threadIdx.x == 0) {
        __builtin_amdgcn_fence(__ATOMIC_RELEASE, "agent");
        asm volatile("s_waitcnt vmcnt(0)" ::: "memory");
        __hip_atomic_fetch_add(cnt, 1u, __ATOMIC_RELAXED, __HIP_MEMORY_SCOPE_AGENT);
        while (__hip_atomic_load(cnt, __ATOMIC_RELAXED, __HIP_MEMORY_SCOPE_AGENT) < target) __builtin_amdgcn_s_sleep(1);
        __builtin_amdgcn_fence(__ATOMIC_ACQUIRE, "agent");
        asm volatile("s_waitcnt vmcnt(0)" ::: "memory");
    }
    __syncthreads();
}

__global__ void __launch_bounds__(512) mega(Params p_arg) {
    extern __shared__ __attribute__((aligned(16))) unsigned char smem[];
    CParams* pbase = (CParams*)__builtin_amdgcn_kernarg_segment_ptr();
    const int ph_lo = p_arg.ph_lo, ph_hi = p_arg.ph_hi;
    for (int ph = ph_lo; ph < ph_hi; ++ph) {
        CParams* pq = pbase;
        asm volatile("" : "+s"(pq));
        CParams& p = *pq;
        int gm = -1, l = 0, sub = -1;
        if (ph >= 2) { l = (ph - 2) / 11; sub = (ph - 2) % 11; }
        const int nrows = (l == 3) ? RL : R;
        if (sub == 0) gm = GM_IN; else if (sub == 5) gm = GM_MERGE; else if (sub == 6) gm = GM_OUT; else if (sub == 8) gm = GM_MLP1; else if (sub == 9) gm = GM_MLP2;
        if (gm >= 0) {
            gemm_phase(p, gm, gm == GM_IN ? 132 : nrows / 256, (LAS unsigned char*)smem);
            __syncthreads();
        } else if (ph == 0) {
            phase_mod(p, smem);
            cvt_win(p, 0, smem, blockIdx.x, gridDim.x);
        } else if (ph == 1) {
            token_phase(p, 0, 0, R);
        } else if (sub == 1) {
            shift_phase(p, l, 0, smem);
        } else if (sub == 2) {
            shift_phase(p, l, 1, smem);
        } else if (sub == 3) {
            scan_phase(p, l, smem);
        } else if (sub == 4) {
            post_phase(p, l, nrows, smem);
        } else if (sub == 7) {
            token_phase(p, l, 1, nrows);
            cvt_mlp(p, l, smem, blockIdx.x, gridDim.x);
        } else if (sub == 10) {
            token_phase(p, l, 2, nrows);
            if (l < 3) cvt_win(p, l + 1, smem, blockIdx.x, gridDim.x);
        }
        if (ph + 1 < ph_hi) {
            if (ph == ph_lo) { __threadfence(); cg::this_grid().sync(); }
            else flat_barrier((unsigned*)(p_arg.ws + OFF_BAR), (unsigned)(ph - ph_lo) * gridDim.x);
        }
    }
}

extern "C" void kernel_launch(void* const* d_in, const int* in_sizes, int n_in, void* d_out, int out_size, void* d_ws, size_t ws_size, hipStream_t stream) {
    static int grid = 0;
    if (grid == 0) {
        if (n_in != 32 || ws_size < WS_END) { fprintf(stderr, "kernel_launch: bad n_in %d or ws %zu < %zu\n", n_in, ws_size, (size_t)WS_END); grid = -1; return; }
        if (hipFuncSetAttribute((const void*)mega, hipFuncAttributeMaxDynamicSharedMemorySize, LDS_BYTES) != hipSuccess) { grid = -1; return; }
        int dev = 0, cus = 0, per_cu = 0;
        hipGetDevice(&dev);
        hipDeviceGetAttribute(&cus, hipDeviceAttributeMultiprocessorCount, dev);
        hipOccupancyMaxActiveBlocksPerMultiprocessor(&per_cu, (const void*)mega, 512, LDS_BYTES);
        (void)hipGetLastError();
        if (per_cu < 1) per_cu = 1;
        grid = cus * per_cu; if (grid > 256) grid = 256;
    }
    if (grid < 0) return;
    Params p{};
    for (int i = 0; i < 32; ++i) p.in[i] = (const float*)d_in[i];
    p.out = (float*)d_out; p.ws = (unsigned char*)d_ws;
    p.ph_lo = 0; p.ph_hi = NPH; p.coop = 1; p.pad = 0;
    if (hipMemsetAsync((char*)d_ws + OFF_BAR, 0, 64, stream) != hipSuccess) return;
    void* args[] = {&p};
    hipError_t e = hipLaunchCooperativeKernel((const void*)mega, dim3(grid), dim3(512), args, LDS_BYTES, stream);
    if (e != hipSuccess) fprintf(stderr, "cooperative launch failed: %s (grid %d)\n", hipGetErrorString(e), grid);
}
```
